# Optimizing an MI355X kernel written in HIP

```python
import math
import jax
import jax.numpy as jnp
from jax import lax
import numpy as np

D_MODEL = 1024
BATCH = 4
SEQ = 4096
DEPTH = 4

GRID_W = 64
CTX_LEN = 256

GLA_HEADS = 4
GLA_DK = 32
GLA_DV = 64
GLA_RANK = 16
GLA_TAU = 16.0
GLA_CHUNK = 32
ROPE_BASE = 10000.0
NA_HEADS = 4
NA_HD = 64
NA_WIN_R = 8
NA_WIN_C = 16
GDN_HEADS = 4
GDN_DK = 128
GDN_DV = 128
GDN_CONV = 5
GDN_CHUNK = 64
N_EXPERTS = 32
TOP_K = 4
D_EXPERT = D_MODEL
SWIGLU_LIMIT = 7.0
SWIGLU_ALPHA = 1.702
MOE_BLOCK = 256

N_MOD = 6
LN_EPS = 1e-5
RMS_EPS = 1e-6
DN_ALPHA = (2 * DEPTH) ** 0.25
DN_BETA = (8 * DEPTH) ** -0.25

IN_SPLITS = (GLA_HEADS * GLA_DK, GLA_HEADS * GLA_DK, GLA_HEADS * GLA_DV, 2 * GLA_RANK, GLA_HEADS * GLA_DV,
             NA_HEADS * NA_HD, NA_HEADS * NA_HD, NA_HEADS * NA_HD,
             GDN_HEADS * GDN_DK, GDN_HEADS * GDN_DK, GDN_HEADS * GDN_DV, 2 * GDN_HEADS, 2 * GDN_HEADS, GDN_HEADS * GDN_DV)
D_IN = sum(IN_SPLITS)
MIX_W = GLA_HEADS * GLA_DV + NA_HEADS * NA_HD + GDN_HEADS * GDN_DV

kernel_name = 'hybrid_gla_natten_gdn_moe_trunk'

F32 = jnp.float32


def _ln(t):
    tf = t.astype(F32)
    mu = tf.mean(-1, keepdims=True)
    var = jnp.mean(jnp.square(tf - mu), -1, keepdims=True)
    return ((tf - mu) * lax.rsqrt(var + LN_EPS)).astype(t.dtype)


def _post_ln(t, g, b):
    return _ln(t) * g + b


def _modulate(t, shift, scale):
    return _ln(t) * (1 + scale) + shift


def _rmsnorm(t, g):
    tf = t.astype(F32)
    y = tf * lax.rsqrt(jnp.mean(tf * tf, -1, keepdims=True) + RMS_EPS)
    return (y * g).astype(t.dtype)


def _l2norm(t):
    tf = t.astype(F32)
    return (tf * lax.rsqrt(jnp.sum(tf * tf, -1, keepdims=True) + 1e-6)).astype(t.dtype)


def _split_cols(p):
    return jnp.split(p, np.cumsum(IN_SPLITS)[:-1].tolist(), axis=-1)


def _axial_rope_tables(n_tok):
    t = jnp.arange(n_tok)
    half = GLA_DK // 2
    inv_freq = ROPE_BASE ** (-jnp.arange(0, half, 2, dtype=F32) / half)

    def cs(pos):
        ang = pos.astype(F32)[:, None] * inv_freq
        return jnp.cos(ang)[:, None, :], jnp.sin(ang)[:, None, :]

    return cs(t // GRID_W) + cs(t % GRID_W)


def _rotate(t, cos, sin):
    t1, t2 = jnp.split(t, 2, -1)
    return jnp.concatenate([t1 * cos - t2 * sin, t2 * cos + t1 * sin], -1)


def _axial_rope(t, rot):
    cos_r, sin_r, cos_c, sin_c = rot
    tr, tc = jnp.split(t, 2, -1)
    return jnp.concatenate([_rotate(tr, cos_r, sin_r), _rotate(tc, cos_c, sin_c)], -1).astype(t.dtype)


def _blocks(t, chunk):
    b_, T, H = t.shape[:3]
    return t.astype(F32).reshape(b_, T // chunk, chunk, H, -1).transpose(1, 0, 3, 2, 4)


def _unblocks(o, dtype):
    n, b_, H, C, d = o.shape
    return o.transpose(1, 0, 3, 2, 4).reshape(b_, n * C, H, d).astype(dtype)


def _gla_chunked(q, k, v, log_a, s0):
    C = GLA_CHUNK
    qc, kc, vc = _blocks(q, C), _blocks(k, C), _blocks(v, C)
    gc = jnp.cumsum(_blocks(log_a, C), axis=3)
    tril = jnp.tril(jnp.ones((C, C), dtype=bool))
    diff = jnp.where(tril[:, :, None], gc[..., :, None, :] - gc[..., None, :, :], -jnp.inf)
    attn = jnp.einsum('nbhtd,nbhsd,nbhtsd->nbhts', qc, kc, jnp.exp(diff))
    o_intra = jnp.einsum('nbhts,nbhsv->nbhtv', attn, vc)
    q_dec = qc * jnp.exp(gc)
    k_dec = kc * jnp.exp(gc[..., -1:, :] - gc)
    a_last = jnp.exp(gc[..., -1, :])

    def step(s, inp):
        qd, kd, vv, al = inp
        o = jnp.einsum('bhtk,bhkv->bhtv', qd, s)
        s = al[..., None] * s + jnp.einsum('bhtk,bhtv->bhkv', kd, vv)
        return s, o

    s_T, o_inter = lax.scan(step, s0.astype(F32), (q_dec, k_dec, vc, a_last))
    return _unblocks(o_intra + o_inter, v.dtype), s_T


def _gdn_chunked(q, k, v, g, beta, s0):
    C = GDN_CHUNK
    dv = v.shape[-1]
    qc, kc, vc = _blocks(q, C), _blocks(k, C), _blocks(v, C)
    gc = jnp.cumsum(_blocks(g[..., None], C)[..., 0], axis=-1)
    bc = _blocks(beta[..., None], C)[..., 0]
    tril = jnp.tril(jnp.ones((C, C), dtype=bool))
    strict = jnp.tril(jnp.ones((C, C), dtype=bool), -1)
    decay = jnp.exp(jnp.where(tril, gc[..., :, None] - gc[..., None, :], -jnp.inf))
    kb = kc * bc[..., None]
    a_mat = jnp.where(strict, jnp.einsum('nbhtk,nbhsk->nbhts', kb, kc) * decay, 0.0) + jnp.eye(C, dtype=F32)
    rhs = jnp.concatenate([vc * bc[..., None], kb * jnp.exp(gc)[..., None]], axis=-1)
    sol = lax.linalg.triangular_solve(a_mat, rhs, left_side=True, lower=True)
    u, w = sol[..., :dv], sol[..., dv:]
    qk = jnp.where(tril, jnp.einsum('nbhtk,nbhsk->nbhts', qc, kc) * decay, 0.0)
    q_dec = qc * jnp.exp(gc)[..., None]
    k_dec = kc * jnp.exp(gc[..., -1:] - gc)[..., None]
    a_last = jnp.exp(gc[..., -1])

    def step(s, inp):
        qd, kd, uu, ww, qkk, al = inp
        v_new = uu - jnp.einsum('bhtk,bhkv->bhtv', ww, s)
        o = jnp.einsum('bhtk,bhkv->bhtv', qd, s) + jnp.einsum('bhts,bhsv->bhtv', qkk, v_new)
        s = al[..., None, None] * s + jnp.einsum('bhtk,bhtv->bhkv', kd, v_new)
        return s, o

    s_T, o = lax.scan(step, s0.astype(F32), (q_dec, k_dec, u, w, qk, a_last))
    return _unblocks(o, v.dtype), s_T


def _bidirectional(scan, ctx_fwd, ctx_bwd, lat_fwd, lat_bwd, s0):
    flip = lambda args: tuple(jnp.flip(a, 1) for a in args)
    o_cf, s_f = scan(*ctx_fwd, s0)
    o_cb, s_b = scan(*flip(ctx_bwd), s0)
    o_lf, _ = scan(*lat_fwd, s_f)
    o_lb, _ = scan(*flip(lat_bwd), s_b)
    return o_lf + jnp.flip(o_lb, 1), o_cf + jnp.flip(o_cb, 1)


def _gla_group(cols_l, cols_c, rope, w_a2, b_a, norm_g):
    def prep(cols, rot):
        q, k, v, a_lr, g = cols
        b_, T = q.shape[:2]
        q = q.reshape(b_, T, GLA_HEADS, GLA_DK) * GLA_DK ** -0.5
        k = k.reshape(b_, T, GLA_HEADS, GLA_DK)
        if rot is not None:
            q, k = _axial_rope(q, rot), _axial_rope(k, rot)
        v = v.reshape(b_, T, GLA_HEADS, GLA_DV)
        z = jnp.einsum('btir,irk->btik', a_lr.reshape(b_, T, 2, GLA_RANK), w_a2) + b_a
        log_a = (jax.nn.log_sigmoid(z.astype(F32)) / GLA_TAU).reshape(b_, T, 2, GLA_HEADS, GLA_DK)
        return (q, k, v, log_a[:, :, 0]), (q, k, v, log_a[:, :, 1]), g

    fl, bl, g_l = prep(cols_l, rope)
    fc, bc, g_c = prep(cols_c, None)
    s0 = jnp.zeros((g_l.shape[0], GLA_HEADS, GLA_DK, GLA_DV), F32)
    o_l, o_c = _bidirectional(_gla_chunked, fc, bc, fl, bl, s0)
    out = lambda o, g: _rmsnorm(o, norm_g).reshape(g.shape) * jax.nn.silu(g)
    return out(o_l, g_l), out(o_c, g_c)


def _neighbourhood_attn(q, k, v, k_ctx, v_ctx, rpb):
    b_, S, H, hd = q.shape
    rows = S // GRID_W
    kr = min(NA_WIN_R, rows)
    scale = hd ** -0.5
    grid = lambda t: t.reshape(b_, rows, GRID_W, H, hd)
    qg, kg, vg = grid(q), grid(k), grid(v)
    r = jnp.arange(rows)
    r0 = jnp.clip(r - kr // 2, 0, rows - kr)
    key_rows = r0[:, None] + jnp.arange(kr)
    kb = kg[:, key_rows]
    vb = vg[:, key_rows].reshape(b_, rows, kr * GRID_W, H, hd)
    s_loc = jnp.einsum('brqhd,brikhd->bhrqik', qg, kb).astype(F32) * scale
    cidx = jnp.arange(GRID_W)
    c0 = jnp.clip(cidx - NA_WIN_C // 2, 0, GRID_W - NA_WIN_C)
    col_ok = (cidx[None, :] >= c0[:, None]) & (cidx[None, :] < c0[:, None] + NA_WIN_C)
    dr = key_rows - r[:, None]
    dc = jnp.clip(cidx[None, :] - cidx[:, None] + NA_WIN_C - 1, 0, 2 * NA_WIN_C - 2)
    bias = rpb[:, (dr + NA_WIN_R - 1)[:, None, :, None], dc[None, :, None, :]].astype(F32)
    s_loc = jnp.where(col_ok[:, None, :], s_loc + bias, -jnp.inf).reshape(b_, H, rows, GRID_W, kr * GRID_W)
    s_ctx = jnp.einsum('brqhd,blhd->bhrql', qg, k_ctx).astype(F32) * scale
    p = jax.nn.softmax(jnp.concatenate([s_loc, s_ctx], -1), axis=-1)
    n_loc = kr * GRID_W
    o = (jnp.einsum('bhrqj,brjhd->brqhd', p[..., :n_loc], vb.astype(F32))
         + jnp.einsum('bhrql,blhd->brqhd', p[..., n_loc:], v_ctx.astype(F32)))
    return o.reshape(b_, S, H * hd).astype(q.dtype)


def _na_group(cols_l, cols_c, rpb):
    heads = lambda t: t.reshape(t.shape[0], t.shape[1], NA_HEADS, NA_HD)
    ql, kl, vl = (heads(t) for t in cols_l)
    qc, kc, vc = (heads(t) for t in cols_c)
    o_l = _neighbourhood_attn(ql, kl, vl, kc, vc, rpb)
    s = jnp.einsum('bqhd,bkhd->bhqk', qc, kc).astype(F32) * NA_HD ** -0.5
    o_c = jnp.einsum('bhqk,bkhd->bqhd', jax.nn.softmax(s, axis=-1), vc.astype(F32))
    return o_l, o_c.reshape(qc.shape[0], qc.shape[1], -1).astype(qc.dtype)


def _dwconv_centred(t, w):
    pad = w.shape[0] // 2
    return lax.conv_general_dilated(t, w[:, None, :].astype(t.dtype), window_strides=(1,), padding=[(pad, pad)],
                                    dimension_numbers=('NWC', 'WIO', 'NWC'), feature_group_count=t.shape[-1])


def _gdn_group(cols_l, cols_c, conv_w, a_log, dt_bias, norm_g):
    def prep(cols):
        q, k, v, b_lr, a_lr, z = cols
        b_, T = q.shape[:2]
        qkv = jax.nn.silu(_dwconv_centred(jnp.concatenate([q, k, v], -1), conv_w))
        q, k, v = jnp.split(qkv, [GDN_HEADS * GDN_DK, 2 * GDN_HEADS * GDN_DK], axis=-1)
        q = _l2norm(q.reshape(b_, T, GDN_HEADS, GDN_DK)) * GDN_DK ** -0.5
        k = _l2norm(k.reshape(b_, T, GDN_HEADS, GDN_DK))
        v = v.reshape(b_, T, GDN_HEADS, GDN_DV)
        beta = jax.nn.sigmoid(b_lr.astype(F32)).reshape(b_, T, 2, GDN_HEADS)
        g = -jnp.exp(a_log.astype(F32)) * jax.nn.softplus(a_lr.astype(F32).reshape(b_, T, 2, GDN_HEADS) + dt_bias)
        return (q, k, v, g[:, :, 0], beta[:, :, 0]), (q, k, v, g[:, :, 1], beta[:, :, 1]), z

    fl, bl, z_l = prep(cols_l)
    fc, bc, z_c = prep(cols_c)
    s0 = jnp.zeros((z_l.shape[0], GDN_HEADS, GDN_DK, GDN_DV), F32)
    o_l, o_c = _bidirectional(_gdn_chunked, fc, bc, fl, bl, s0)
    out = lambda o, z: _rmsnorm(o, norm_g).reshape(z.shape) * jax.nn.silu(z)
    return out(o_l, z_l), out(o_c, z_c)


def _mixer(h_lat, h_ctx, rope, w_in, gla_w_a2, gla_b_a, gla_norm, na_rpb, gdn_conv, gdn_a_log, gdn_dt_bias, gdn_norm, w_out):
    cols_l = _split_cols(h_lat @ w_in)
    cols_c = _split_cols(h_ctx @ w_in)
    gla_l, gla_c = _gla_group(cols_l[0:5], cols_c[0:5], rope, gla_w_a2, gla_b_a, gla_norm)
    na_l, na_c = _na_group(cols_l[5:8], cols_c[5:8], na_rpb)
    gdn_l, gdn_c = _gdn_group(cols_l[8:], cols_c[8:], gdn_conv, gdn_a_log, gdn_dt_bias, gdn_norm)
    out_l = jnp.concatenate([gla_l, na_l, gdn_l], -1) @ w_out
    out_c = jnp.concatenate([gla_c, na_c, gdn_c], -1) @ w_out
    return out_l, out_c


def _moe(h, w_router, b_router, w_gate_up, b_gate_up, w_down, b_down):
    n_tok, d = h.shape
    logits = (h @ w_router + b_router).astype(F32)
    top_logit, top_e = lax.top_k(logits, TOP_K)
    gate = jax.nn.softmax(top_logit, axis=-1)
    nk = n_tok * TOP_K
    flat_e = top_e.reshape(-1).astype(jnp.int32)
    flat_tok = jnp.arange(nk, dtype=jnp.int32) // TOP_K
    order = jnp.argsort(flat_e)
    sorted_e = flat_e[order]
    counts = jnp.bincount(flat_e, length=N_EXPERTS)
    padded = (counts + MOE_BLOCK - 1) // MOE_BLOCK * MOE_BLOCK
    pad_end = jnp.cumsum(padded)
    pad_start = pad_end - padded
    start = jnp.cumsum(counts) - counts
    dest = pad_start[sorted_e] + jnp.arange(nk, dtype=jnp.int32) - start[sorted_e]
    n_blocks = -(-(nk + N_EXPERTS * (MOE_BLOCK - 1)) // MOE_BLOCK)
    buf_tok = jnp.full((n_blocks * MOE_BLOCK,), n_tok, jnp.int32).at[dest].set(flat_tok[order])
    block_e = jnp.minimum(jnp.searchsorted(pad_end, jnp.arange(n_blocks) * MOE_BLOCK, side='right'), N_EXPERTS - 1)
    h_pad = jnp.concatenate([h, jnp.zeros((1, d), h.dtype)], 0)
    xb = h_pad[buf_tok].reshape(n_blocks, MOE_BLOCK, d)

    def expert_block(args):
        xblk, e = args
        gu = xblk @ w_gate_up[e] + b_gate_up[e]
        gt, up = jnp.split(gu, 2, axis=-1)
        gt = jnp.minimum(gt, SWIGLU_LIMIT)
        up = jnp.clip(up, -SWIGLU_LIMIT, SWIGLU_LIMIT)
        act = (up + 1) * gt * jax.nn.sigmoid(SWIGLU_ALPHA * gt)
        return act @ w_down[e] + b_down[e]

    yb = lax.map(expert_block, (xb, block_e)).reshape(n_blocks * MOE_BLOCK, d)
    slot_pos = jnp.zeros((nk,), jnp.int32).at[order].set(dest)
    y = yb[slot_pos].reshape(n_tok, TOP_K, d)
    return jnp.einsum('nkd,nk->nd', y, gate.astype(y.dtype))


def setup_inputs(seed: int = 0) -> dict:
    key = jax.random.key(seed)
    ks = jax.random.split(key, 26)
    it = iter([ks[i] for i in range(26)])
    nrm = lambda shape, std: jax.random.normal(next(it), shape, F32) * std
    L, D, E, F = DEPTH, D_MODEL, N_EXPERTS, D_EXPERT
    x = nrm((BATCH, SEQ, D), 1.0)
    c = nrm((BATCH, D), 1.0)
    ctx = nrm((BATCH, CTX_LEN, D), 1.0)
    c_ctx = nrm((D,), 1.0)
    w_ada = nrm((L, D, N_MOD * D), 0.5 * D ** -0.5)
    b_ada = nrm((L, N_MOD * D), 0.02)
    w_in = nrm((L, D, D_IN), D ** -0.5)
    gla_w_a2 = nrm((L, 2, GLA_RANK, GLA_HEADS * GLA_DK), GLA_RANK ** -0.5)
    gla_b_a = nrm((L, 2, GLA_HEADS * GLA_DK), 0.1)
    gla_norm = 1.0 + nrm((L, GLA_DV), 0.02)
    na_rpb = nrm((L, NA_HEADS, 2 * NA_WIN_R - 1, 2 * NA_WIN_C - 1), 0.02)
    gdn_conv = nrm((L, GDN_CONV, GDN_HEADS * (2 * GDN_DK + GDN_DV)), GDN_CONV ** -0.5)
    gdn_a_log = jnp.log(jax.random.uniform(next(it), (L, 2, GDN_HEADS), F32, 1.0, 16.0))
    dt = jnp.exp(jax.random.uniform(next(it), (L, 2, GDN_HEADS), F32, math.log(1e-3), math.log(1e-1)))
    gdn_dt_bias = dt + jnp.log(-jnp.expm1(-dt))
    gdn_norm = 1.0 + nrm((L, GDN_DV), 0.02)
    w_out = nrm((L, MIX_W, D), DN_BETA * MIX_W ** -0.5)
    ln1_g = 1.0 + nrm((L, D), 0.02)
    ln1_b = nrm((L, D), 0.02)
    w_router = nrm((L, D, E), D ** -0.5)
    b_router = nrm((L, E), 0.01)
    w_gate_up = nrm((L, E, D, 2 * F), D ** -0.5)
    b_gate_up = nrm((L, E, 2 * F), 0.02)
    w_down = nrm((L, E, F, D), DN_BETA * F ** -0.5)
    b_down = nrm((L, E, D), 0.02)
    ln2_g = 1.0 + nrm((L, D), 0.02)
    ln2_b = nrm((L, D), 0.02)
    return {'x': x, 'c': c, 'ctx': ctx, 'c_ctx': c_ctx, 'w_ada': w_ada, 'b_ada': b_ada, 'w_in': w_in,
            'gla_w_a2': gla_w_a2, 'gla_b_a': gla_b_a, 'gla_norm': gla_norm, 'na_rpb': na_rpb,
            'gdn_conv': gdn_conv, 'gdn_a_log': gdn_a_log, 'gdn_dt_bias': gdn_dt_bias, 'gdn_norm': gdn_norm,
            'w_out': w_out, 'ln1_g': ln1_g, 'ln1_b': ln1_b, 'w_router': w_router, 'b_router': b_router,
            'w_gate_up': w_gate_up, 'b_gate_up': b_gate_up, 'w_down': w_down, 'b_down': b_down,
            'ln2_g': ln2_g, 'ln2_b': ln2_b}


def reference(x, c, ctx, c_ctx, w_ada, b_ada, w_in, gla_w_a2, gla_b_a, gla_norm, na_rpb,
              gdn_conv, gdn_a_log, gdn_dt_bias, gdn_norm, w_out, ln1_g, ln1_b,
              w_router, b_router, w_gate_up, b_gate_up, w_down, b_down, ln2_g, ln2_b):
    b_, S, D = x.shape
    rope = _axial_rope_tables(S)
    sc = jax.nn.silu(c)
    scc = jax.nn.silu(c_ctx)
    for l in range(DEPTH):
        m_lat = jnp.split((sc @ w_ada[l] + b_ada[l])[:, None, :], N_MOD, axis=-1)
        m_ctx = jnp.split(scc @ w_ada[l] + b_ada[l], N_MOD, axis=-1)
        a_lat, a_ctx = _mixer(_modulate(x, m_lat[0], m_lat[1]), _modulate(ctx, m_ctx[0], m_ctx[1]), rope,
                              w_in[l], gla_w_a2[l], gla_b_a[l], gla_norm[l], na_rpb[l], gdn_conv[l],
                              gdn_a_log[l], gdn_dt_bias[l], gdn_norm[l], w_out[l])
        x = _post_ln(DN_ALPHA * x + m_lat[2] * a_lat, ln1_g[l], ln1_b[l])
        moe_w = (w_router[l], b_router[l], w_gate_up[l], b_gate_up[l], w_down[l], b_down[l])
        h_lat = _modulate(x, m_lat[3], m_lat[4]).reshape(b_ * S, D)
        if l == DEPTH - 1:
            f_lat = _moe(h_lat, *moe_w)
        else:
            ctx = _post_ln(DN_ALPHA * ctx + m_ctx[2] * a_ctx, ln1_g[l], ln1_b[l])
            h_ctx = _modulate(ctx, m_ctx[3], m_ctx[4]).reshape(-1, D)
            f = _moe(jnp.concatenate([h_lat, h_ctx], 0), *moe_w)
            f_lat = f[:b_ * S]
            ctx = _post_ln(DN_ALPHA * ctx + m_ctx[5] * f[b_ * S:].reshape(ctx.shape), ln2_g[l], ln2_b[l])
        x = _post_ln(DN_ALPHA * x + m_lat[5] * f_lat.reshape(b_, S, D), ln2_g[l], ln2_b[l])
    return x
```

```cpp
#include <hip/hip_runtime.h>
#include <cstdio>
#include <cstdint>

namespace pg8 {
#define PG8_LAS __attribute__((address_space(3)))
typedef unsigned short bf16_t;
typedef short bf16x8 __attribute__((ext_vector_type(8)));
typedef float f32x4 __attribute__((ext_vector_type(4)));
typedef unsigned u32x4 __attribute__((ext_vector_type(4)));
constexpr int BM = 256, BK = 64, HALF = 128, HTB = HALF * BK * 2  , STAGE_BYTES = 8 * HTB, NXCD = 8, WGM = 8;

__host__ __device__ __forceinline__ int lds_byte(int r, int c) { const int st = (r >> 4) * 2 + (c >> 5), rr = r & 15, cc = c & 31, ob = rr * 64 + cc * 2; return st * 1024 + (ob ^ (((ob >> 9) & 1) << 5)); }
__host__ __device__ __forceinline__ void stage_rc(int b, int& R, int& C) { const int st = b / 1024, sb = b % 1024, swz = sb ^ (((sb >> 9) & 1) << 5); R = (st >> 1) * 16 + swz / 64; C = (st & 1) * 32 + (swz % 64) / 2; }
__host__ __device__ __forceinline__ int perm32(int rho) { const int n = rho >> 4, i = rho & 15; return 8 * (i >> 2) + 4 * n + (i & 3); }

struct Unit { int pm, pn; };
struct Gemm { const bf16_t* A; const bf16_t* Bt; int M, N, K; };

struct StaticOrder {
    int nM, nN, nwg, G, c;
    __host__ __device__ void init(int M, int N, int G_, int c_) { nM = M / BM; nN = N / BM; nwg = nM * nN; G = G_; c = c_; }
    __host__ __device__ bool next(int i, Unit& u) const {
        const long L = (long)i * G + c; if (L >= nwg) return false;
        int wgid = (int)L; { const int q = nwg / NXCD, r = nwg % NXCD, xcd = wgid % NXCD, off = wgid / NXCD; wgid = (xcd < r ? xcd * (q + 1) : r * (q + 1) + (xcd - r) * q) + off; }
        const int nig = WGM * nN, gid = wgid / nig, fm = gid * WGM, gsz = (nM - fm) < WGM ? (nM - fm) : WGM;
        u.pm = fm + ((wgid % nig) % gsz); u.pn = (wgid % nig) / gsz; return true;
    }
    __device__ __forceinline__ void a_ready(const Unit&) const {}
    __device__ __forceinline__ void done(const Unit&) const {}
};
__device__ __forceinline__ unsigned cvt_pk_bf16(float lo, float hi) { unsigned r; asm volatile("v_cvt_pk_bf16_f32 %0, %1, %2" : "=v"(r) : "v"(lo), "v"(hi)); return r; }
template <class Epi, class Sched, bool STAMP = false>
__device__ __forceinline__ void gemm_phase(PG8_LAS unsigned char* lds, const Gemm g, const Sched& S, const Epi& E, unsigned long long* stamps, const int tid) {
    const int wid = __builtin_amdgcn_readfirstlane(tid >> 6), lane = tid & 63, wr = wid >> 2, wc = wid & 3, fr = lane & 15, fq = lane >> 4;
    const int K = g.K, nt = K / BK;
    int ts_lo = 0, ts_hi = 0, nts = 0; const unsigned long long rt_entry = STAMP ? (unsigned long long)wall_clock64() : 0ull;
#define PG8_STAMP() do { if (STAMP && wid == 0 && nts < 64) { const unsigned long long _c = (unsigned long long)clock64(); \
        ts_lo = (lane == nts) ? (int)(unsigned)_c : ts_lo; ts_hi = (lane == nts) ? (int)(unsigned)(_c >> 32) : ts_hi; ++nts; } } while (0)
    PG8_STAMP();
    unsigned voffA[2], voffB[2];
#pragma unroll
    for (int i = 0; i < 2; ++i) { int R, C; stage_rc(tid * 16 + i * 8192, R, C); const int Rb = Epi::PERM ? ((R & ~31) + perm32(R & 31)) : R;
        voffA[i] = (unsigned)(R * K + C) * 2u; voffB[i] = (unsigned)(Rb * K + C) * 2u; }
    const size_t kstep = (size_t)(BK * 2);
    const size_t hstep = (size_t)HALF * K * 2;
    const size_t tstep = 2 * hstep;
    const unsigned ldsw = (unsigned)wid * 1024u;
    const int aoff = lds_byte(wr * 64 + fr, fq * 8), boff = lds_byte(wc * 32 + fr, fq * 8);
#define PG8_SA(b, h) (((b) * 2 + (h)) * HTB)
#define PG8_SB(b, h) ((4 + (b) * 2 + (h)) * HTB)
#define PG8_STAGE(bufoff, gbase, voff) do { _Pragma("unroll") for (int _i = 0; _i < 2; ++_i) \
        __builtin_amdgcn_global_load_lds((const unsigned*)((const char*)(gbase) + (voff)[_i]), (PG8_LAS unsigned*)(lds + (bufoff) + ldsw + _i * 8192), 16, 0, 0); } while (0)
#define PG8_LDA(dst, b, h) do { _Pragma("unroll") for (int m = 0; m < 4; ++m) _Pragma("unroll") for (int k = 0; k < 2; ++k) dst[m][k] = *(const PG8_LAS bf16x8*)(lds + PG8_SA(b, h) + aoff + m * 2048 + k * 1024); } while (0)
#define PG8_LDB(dst, b, h) do { _Pragma("unroll") for (int n = 0; n < 2; ++n) _Pragma("unroll") for (int k = 0; k < 2; ++k) dst[n][k] = *(const PG8_LAS bf16x8*)(lds + PG8_SB(b, h) + boff + n * 2048 + k * 1024); } while (0)
#define PG8_MMA(ai, bj, At, Bt) do { __builtin_amdgcn_s_setprio(1); _Pragma("unroll") for (int m = 0; m < 4; ++m) _Pragma("unroll") for (int n = 0; n < 2; ++n) _Pragma("unroll") for (int k = 0; k < 2; ++k) \
        acc[ai][bj][m][n] = __builtin_amdgcn_mfma_f32_16x16x32_bf16(Bt[n][k], At[m][k], acc[ai][bj][m][n], 0, 0, 0); __builtin_amdgcn_s_setprio(0); } while (0)
#define PG8_WAIT_V(n) asm volatile("s_waitcnt vmcnt(" #n ")" ::: "memory")
#define PG8_WAIT_L(n) asm volatile("s_waitcnt lgkmcnt(" #n ")" ::: "memory")
#define PG8_BAR __builtin_amdgcn_s_barrier()
#define PG8_SCHED __builtin_amdgcn_sched_barrier(0)
    Unit cur, nxt; int ui = 0;
    if (!S.next(0, cur)) return;
    f32x4 acc[2][2][4][2];
#pragma unroll
    for (int a = 0; a < 2; ++a)
#pragma unroll
        for (int b = 0; b < 2; ++b)
#pragma unroll
            for (int m = 0; m < 4; ++m)
#pragma unroll
                for (int n = 0; n < 2; ++n) acc[a][b][m][n] = (f32x4){0.f, 0.f, 0.f, 0.f};
    bf16x8 At[4][2], B0[2][2], B1[2][2];
    const char* cA = (const char*)g.A + (size_t)cur.pm * tstep; const char* cB = (const char*)g.Bt + (size_t)cur.pn * tstep;
    S.a_ready(cur);
    PG8_STAGE(PG8_SB(0, 0), cB, voffB); PG8_STAGE(PG8_SA(0, 0), cA, voffA); PG8_STAGE(PG8_SB(0, 1), cB + hstep, voffB); PG8_STAGE(PG8_SA(0, 1), cA + hstep, voffA);
    if (wr == 1) PG8_BAR;
    PG8_WAIT_V(4); PG8_BAR;
    PG8_STAGE(PG8_SB(1, 0), cB + kstep, voffB); PG8_STAGE(PG8_SA(1, 0), cA + kstep, voffA); PG8_STAGE(PG8_SB(1, 1), cB + hstep + kstep, voffB);
    PG8_WAIT_V(6); PG8_BAR;
    PG8_STAMP();
    for (;;) {
        const bool has_next = S.next(ui + 1, nxt);
        const char* nA = has_next ? (const char*)g.A + (size_t)nxt.pm * tstep : cA; const char* nB = has_next ? (const char*)g.Bt + (size_t)nxt.pn * tstep : cB;
        for (int t = 0; t < nt; t += 2) {
            const bool last = (t == nt - 2);
            const char* a1 = cA + (size_t)(t + 1) * kstep;
            const char* a2 = last ? nA : cA + (size_t)(t + 2) * kstep; const char* b2 = last ? nB : cB + (size_t)(t + 2) * kstep;
            const char* a3 = a2 + kstep; const char* b3 = b2 + kstep;
            if (last && has_next) S.a_ready(nxt);
            PG8_LDB(B0, 0, 0); PG8_SCHED; PG8_LDA(At, 0, 0); PG8_STAGE(PG8_SA(1, 1), a1 + hstep, voffA);
            PG8_WAIT_L(8); PG8_BAR; PG8_WAIT_L(0); PG8_MMA(0, 0, At, B0); PG8_BAR; PG8_SCHED;
            PG8_LDB(B1, 0, 1); PG8_STAGE(PG8_SB(0, 0), b2, voffB);
            PG8_BAR; PG8_WAIT_L(0); PG8_MMA(0, 1, At, B1); PG8_BAR;
            PG8_LDA(At, 0, 1); PG8_STAGE(PG8_SA(0, 0), a2, voffA);
            PG8_BAR; PG8_WAIT_L(0); PG8_MMA(1, 0, At, B0); PG8_BAR; PG8_SCHED;
            PG8_STAGE(PG8_SB(0, 1), b2 + hstep, voffB);
            PG8_WAIT_V(6); PG8_BAR; PG8_MMA(1, 1, At, B1); PG8_BAR;
            PG8_LDB(B0, 1, 0); PG8_SCHED; PG8_LDA(At, 1, 0); PG8_STAGE(PG8_SA(0, 1), a2 + hstep, voffA);
            PG8_WAIT_L(8); PG8_BAR; PG8_WAIT_L(0); PG8_MMA(0, 0, At, B0); PG8_BAR; PG8_SCHED;
            PG8_LDB(B1, 1, 1); PG8_STAGE(PG8_SB(1, 0), b3, voffB);
            PG8_BAR; PG8_WAIT_L(0); PG8_MMA(0, 1, At, B1); PG8_BAR;
            PG8_LDA(At, 1, 1); PG8_STAGE(PG8_SA(1, 0), a3, voffA);
            PG8_BAR; PG8_WAIT_L(0); PG8_MMA(1, 0, At, B0); PG8_BAR; PG8_SCHED;
            PG8_STAGE(PG8_SB(1, 1), b3 + hstep, voffB);
            PG8_WAIT_V(6); PG8_BAR; PG8_MMA(1, 1, At, B1); PG8_BAR;
        }
        PG8_STAMP();
        if constexpr (!Epi::AFTER_DRAIN) { E(acc, cur, wr, wc, fr, fq); S.done(cur); }
        PG8_STAMP();
        if (!has_next) break;
#pragma unroll
        for (int a = 0; a < 2; ++a)
#pragma unroll
            for (int b = 0; b < 2; ++b)
#pragma unroll
                for (int m = 0; m < 4; ++m)
#pragma unroll
                    for (int n = 0; n < 2; ++n) acc[a][b][m][n] = (f32x4){0.f, 0.f, 0.f, 0.f};
        cur = nxt; cA = nA; cB = nB; ++ui;
    }
    PG8_WAIT_V(0);
    if (wr == 0) PG8_BAR;
    PG8_BAR;
    if constexpr (Epi::AFTER_DRAIN) { E.fused(acc, cur, wr, wc, fr, fq, lds, wid, lane); S.done(cur); }
    PG8_STAMP();
    if (STAMP && wid == 0) { stamps[lane] = lane < nts ? (((unsigned long long)(unsigned)ts_hi << 32) | (unsigned)ts_lo) : 0ull;
        if (lane == 62) stamps[62] = rt_entry; if (lane == 63) stamps[63] = (unsigned long long)wall_clock64(); }
#undef PG8_STAMP
#undef PG8_SA
#undef PG8_SB
#undef PG8_STAGE
#undef PG8_LDA
#undef PG8_LDB
#undef PG8_MMA
#undef PG8_WAIT_V
#undef PG8_WAIT_L
#undef PG8_BAR
#undef PG8_SCHED
}
}
#define XB_TMO      128
#define XB_XCNT(j)  (256  + 64 * (j))
#define XB_XSUB(j)  (1280 + 64 * (j))
#define XB_XGEN(j)  (2304 + 64 * (j))
#define XB_TOP      3328
#define XB_TOPGEN   3392
#define XCD_BAR_WORDS 3456
#define XB_SPIN_CAP (1u << 18)
#define LAS __attribute__((address_space(3)))

__device__ __forceinline__ unsigned xb_ld(unsigned* p)              { return __hip_atomic_load(p, __ATOMIC_RELAXED, __HIP_MEMORY_SCOPE_AGENT); }
__device__ __forceinline__ unsigned xb_add(unsigned* p, unsigned v) { return __hip_atomic_fetch_add(p, v, __ATOMIC_RELAXED, __HIP_MEMORY_SCOPE_AGENT); }
__device__ __forceinline__ unsigned xb_xcc_id() { return (unsigned)__builtin_amdgcn_s_getreg((3 << 11) | 20) & 0xFu; }
#define XB_SPIN(cond, bar) do { unsigned _sp = 0; while (cond) { __builtin_amdgcn_s_sleep(1); \
    if ((++_sp & 255u) == 0u) { if (xb_ld(&(bar)[XB_TMO])) break; if (_sp > XB_SPIN_CAP) { atomicAdd(&(bar)[XB_TMO], 1u); break; } } } } while (0)

struct XcdBarrier {
    unsigned* bar; unsigned x;
    volatile LAS unsigned* st;
};

__device__ __forceinline__ XcdBarrier xcd_barrier_post(unsigned* bar, volatile LAS unsigned* st) {
    XcdBarrier b; b.bar = bar; b.x = xb_xcc_id(); b.st = st;
    if (threadIdx.x == 0) (void)xb_add(&bar[XB_XCNT(b.x)], 1u);
    return b;
}
__device__ __forceinline__ void xcd_barrier_complete(unsigned* bar, unsigned x, unsigned& nloc, unsigned& nx) {
    const unsigned G = gridDim.x * gridDim.y * gridDim.z;
    unsigned sum, cnt, mine, sp = 0u;
    for (;;) {
        sum = 0u; cnt = 0u; mine = 0u;
#pragma unroll
        for (unsigned j = 0; j < 16; ++j) { const unsigned c = xb_ld(&bar[XB_XCNT(j)]); sum += c; cnt += (c > 0u) ? 1u : 0u; mine = (j == x) ? c : mine; }
        if (sum == G) break;
        __builtin_amdgcn_s_sleep(1);
        if ((++sp & 255u) == 0u) { if (xb_ld(&bar[XB_TMO])) break; if (sp > XB_SPIN_CAP) { atomicAdd(&bar[XB_TMO], 1u); break; } }
    }
    nloc = mine > 0u ? mine : 1u; nx = cnt > 0u ? cnt : 1u;
}

__device__ __forceinline__ void xcd_barrier(const XcdBarrier& b) {
    asm volatile("s_waitcnt vmcnt(0)" ::: "memory");
    __syncthreads();
    if (threadIdx.x == 0) {
        unsigned* bar = b.bar;
        __builtin_amdgcn_s_waitcnt(0);
        unsigned nloc = b.st[0], nx = b.st[1];
        if (nloc == 0u) { xcd_barrier_complete(bar, b.x, nloc, nx); b.st[0] = nloc; b.st[1] = nx; }
        const unsigned old = xb_add(&bar[XB_XSUB(b.x)], 1u);
        const unsigned gen = old / nloc;
        if (old + 1u == (gen + 1u) * nloc) {
            __builtin_amdgcn_fence(__ATOMIC_RELEASE, "agent");
            asm volatile("s_waitcnt vmcnt(0)" ::: "memory");
            const unsigned og = xb_add(&bar[XB_TOP], 1u);
            const unsigned tg = og / nx;
            if (og + 1u == (tg + 1u) * nx) xb_add(&bar[XB_TOPGEN], 1u);
            else XB_SPIN(xb_ld(&bar[XB_TOPGEN]) == tg, bar);
            __builtin_amdgcn_fence(__ATOMIC_ACQUIRE, "agent");
            xb_add(&bar[XB_XGEN(b.x)], 1u);
            asm volatile("s_waitcnt vmcnt(0)" ::: "memory");
        } else {
            XB_SPIN(xb_ld(&bar[XB_XGEN(b.x)]) == gen, bar);
            __builtin_amdgcn_fence(__ATOMIC_ACQUIRE, "agent");
            asm volatile("s_waitcnt vmcnt(0)" ::: "memory");
        }
    }
    __syncthreads();
}


#define GAS __attribute__((address_space(1)))
typedef unsigned short bf16;
typedef short bf16x8 __attribute__((ext_vector_type(8)));
typedef float f32x4 __attribute__((ext_vector_type(4)));
typedef unsigned u32x4 __attribute__((ext_vector_type(4)));
typedef unsigned u32x2 __attribute__((ext_vector_type(2)));

constexpr int D = 1024, NB = 4, SEQ = 4096, CTXL = 256, DEPTH = 4;
constexpr int NLAT = NB * SEQ, NCTX = NB * CTXL, NTOK = NLAT + NCTX;
constexpr int DIN = 3632, DINP = 3840;
constexpr int C_GLA_Q = 0, C_GLA_K = 128, C_GLA_V = 256, C_GLA_A = 512, C_GLA_G = 544;
constexpr int C_NA_Q = 800, C_NA_K = 1056, C_NA_V = 1312;
constexpr int C_GDN_Q = 1568, C_GDN_K = 2080, C_GDN_V = 2592, C_GDN_B = 3104, C_GDN_A = 3112, C_GDN_Z = 3120;
constexpr int NE = 32, TOPK = 4, MAXRB = 304;
constexpr float DN_ALPHA = 1.681792830507429f;
constexpr float LN_EPS = 1e-5f, RMS_EPS = 1e-6f;
constexpr int NWAVES = 8, NTHR = 512;

enum { IX = 0, IC, ICTX, ICCTX, IWADA, IBADA, IWIN, IGLAW, IGLAB, IGLAN, IRPB, ICONV, IALOG, IDTB, IGDNN, IWOUT, ILN1G, ILN1B, IWR, IBR, IWGU, IBGU, IWD, IBD, ILN2G, ILN2B, NIN };

constexpr size_t MiB = 1u << 20;
constexpr size_t WS_CTL = 0, CTL_BYTES = 1 * MiB;
constexpr size_t WS_MODS = 1 * MiB;
constexpr size_t WS_WIN = 2 * MiB;
constexpr size_t WS_WOUT = 32 * MiB;
constexpr size_t WS_WGU = 40 * MiB;
constexpr size_t WS_WD = 552 * MiB;
constexpr size_t WS_X = 808 * MiB;
constexpr size_t WS_H = 876 * MiB;
constexpr size_t WS_COLS = 910 * MiB;
constexpr size_t WS_GATES = 1032 * MiB;
constexpr size_t WS_GQ = 1036 * MiB, WS_GK = 1053 * MiB, WS_GV = 1070 * MiB;
constexpr size_t WS_GG = 1087 * MiB, WS_GB = 1088 * MiB;
constexpr size_t WS_MIX = 1089 * MiB;
constexpr size_t WS_SD = 1123 * MiB;
constexpr size_t WS_SA = 1157 * MiB;
constexpr size_t WS_GU = 1158 * MiB, WS_GW = 1192 * MiB, WS_GQD = 1226 * MiB, WS_GKDT = 1260 * MiB;
constexpr size_t WS_GQKM = 1294 * MiB;
constexpr size_t WS_GCB = 1311 * MiB;
constexpr size_t WS_OG = 1313 * MiB;
constexpr size_t WS_TOKE = 1381 * MiB, WS_TOKP = 1382 * MiB, WS_TOKG = 1383 * MiB, WS_TOKS = 1384 * MiB;
constexpr size_t WS_LG = 1385 * MiB;
constexpr size_t WS_TG = 1419 * MiB;
constexpr size_t WS_XB = 1436 * MiB;
constexpr size_t WS_ACT = 1588 * MiB;
constexpr size_t WS_YB = 1740 * MiB;
constexpr size_t WS_END = 1892 * MiB;
constexpr int CW_BAR = 4096;
constexpr int CW_CNT = 16384;

constexpr int LDS_BYTES = 147456;
constexpr int MISC_OFF = 143360;

struct Args { const float* in[NIN]; float* out; unsigned char* ws; int l_lo, l_hi, ph_lo, ph_hi; };
struct Ctx { const Args* a; int z;
    __device__ __forceinline__ const float* in(int i) const { return a->in[i + z]; }
    __device__ __forceinline__ unsigned char* ws() const { return a->ws + z; }
    __device__ __forceinline__ float* out() const { return a->out + z; } };

__device__ __forceinline__ float bf2f(unsigned u) { return __uint_as_float(u << 16); }
__device__ __forceinline__ unsigned f2bf(float f) { unsigned u = __float_as_uint(f); return (u + 0x7fffu + ((u >> 16) & 1u)) >> 16; }
__device__ __forceinline__ unsigned pk2(float lo, float hi) { return f2bf(lo) | (f2bf(hi) << 16); }
__device__ __forceinline__ float wsum(float v) {
#pragma unroll
    for (int o = 1; o < 64; o <<= 1) v += __shfl_xor(v, o);
    return v;
}
__device__ __forceinline__ float wmax(float v) {
#pragma unroll
    for (int o = 1; o < 64; o <<= 1) v = fmaxf(v, __shfl_xor(v, o));
    return v;
}
__device__ __forceinline__ float sigmoidf_(float x) { return 1.f / (1.f + __expf(-x)); }
__device__ __forceinline__ float siluf_(float x) { return x / (1.f + __expf(-x)); }
__device__ __forceinline__ float softplusf_(float x) { return fmaxf(x, 0.f) + log1pf(__expf(-fabsf(x))); }
__device__ __forceinline__ float logsigmoidf_(float x) { return fminf(x, 0.f) - log1pf(__expf(-fabsf(x))); }
#define WAVE_SYNC() do { asm volatile("s_waitcnt lgkmcnt(0)" ::: "memory"); __builtin_amdgcn_wave_barrier(); } while (0)
#define BLOCK_SYNC() do { __threadfence_block(); __syncthreads(); } while (0)

__device__ __forceinline__ bf16x8 lds_frag(const LAS bf16* base, int stride, int row0, int k0, int lane) {
    return *(const LAS bf16x8*)(base + (row0 + (lane & 15)) * stride + k0 + 8 * (lane >> 4));
}
__device__ __forceinline__ f32x4 mma(bf16x8 a, bf16x8 b, f32x4 c) { return __builtin_amdgcn_mfma_f32_16x16x32_bf16(a, b, c, 0, 0, 0); }

__device__ __forceinline__ int mod_row(int m) { return m < NLAT ? (m >> 12) : 4; }

__device__ __forceinline__ void row_ln(f32x4 (&v)[4]) {
    float s = 0.f;
#pragma unroll
    for (int j = 0; j < 4; ++j) s += (v[j].x + v[j].y) + (v[j].z + v[j].w);
    const float mean = wsum(s) * (1.f / D);
    float s2 = 0.f;
#pragma unroll
    for (int j = 0; j < 4; ++j) { v[j] = v[j] - mean; s2 += (v[j].x * v[j].x + v[j].y * v[j].y) + (v[j].z * v[j].z + v[j].w * v[j].w); }
    const float rstd = 1.f / sqrtf(wsum(s2) * (1.f / D) + LN_EPS);
#pragma unroll
    for (int j = 0; j < 4; ++j) v[j] = v[j] * rstd;
}
__device__ __forceinline__ void row_store_bf16(bf16* row, const f32x4 (&v)[4], int lane) {
    u32x2* o = (u32x2*)row + lane;
#pragma unroll
    for (int j = 0; j < 4; ++j) { u32x2 w; w.x = pk2(v[j].x, v[j].y); w.y = pk2(v[j].z, v[j].w); o[64 * j] = w; }
}

__device__ __forceinline__ void ph_mods(const Ctx& A, LAS unsigned char* lds, int tid, int G) {
    LAS float* sc = (LAS float*)lds;
    LAS float* red = (LAS float*)(lds + 20480);
    const float* c = A.in(IC); const float* cc = A.in(ICCTX);
    for (int i = tid; i < 5 * D; i += NTHR) { const int r = i >> 10, k = i & 1023; const float v = r < 4 ? c[r * D + k] : cc[k]; sc[i] = siluf_(v); }
    __syncthreads();
    float* mods = (float*)(A.ws() + WS_MODS);
    const int col = tid & 63, kg = tid >> 6;
    for (int item = blockIdx.x; item < DEPTH * 96; item += G) {
        const int l = item / 96, n0 = (item % 96) * 64;
        const float* w = A.in(IWADA) + ((size_t)l * D + kg * 128) * 6144 + n0 + col;
        float a0 = 0.f, a1 = 0.f, a2 = 0.f, a3 = 0.f, a4 = 0.f;
#pragma unroll 8
        for (int k = 0; k < 128; ++k) { const float wv = w[(size_t)k * 6144]; const int kk = kg * 128 + k;
            a0 += sc[kk] * wv; a1 += sc[D + kk] * wv; a2 += sc[2 * D + kk] * wv; a3 += sc[3 * D + kk] * wv; a4 += sc[4 * D + kk] * wv; }
        red[(kg * 5 + 0) * 64 + col] = a0; red[(kg * 5 + 1) * 64 + col] = a1; red[(kg * 5 + 2) * 64 + col] = a2; red[(kg * 5 + 3) * 64 + col] = a3; red[(kg * 5 + 4) * 64 + col] = a4;
        __syncthreads();
        if (tid < 320) { const int r = tid >> 6, cl = tid & 63; float s = 0.f;
#pragma unroll
            for (int g = 0; g < 8; ++g) s += red[(g * 5 + r) * 64 + cl];
            mods[((size_t)l * 5 + r) * 6144 + n0 + cl] = s + A.in(IBADA)[l * 6144 + n0 + cl]; }
        __syncthreads();
    }
}

__device__ __forceinline__ void cvt_item(const float* W, int N, int k0, int src0, int nvalid, bf16* dst, int K, LAS float* scr, int lane) {
    const bool ok = (src0 + lane) < nvalid;
#pragma unroll 8
    for (int kk = 0; kk < 64; ++kk) scr[kk * 65 + lane] = ok ? W[(size_t)(k0 + kk) * N + src0 + lane] : 0.f;
    WAVE_SYNC();
    const int c = lane & 7;
#pragma unroll
    for (int j = 0; j < 8; ++j) { const int n = (lane >> 3) + 8 * j; const LAS float* s = scr + (8 * c) * 65 + n;
        u32x4 o; o.x = pk2(s[0], s[65]); o.y = pk2(s[2 * 65], s[3 * 65]); o.z = pk2(s[4 * 65], s[5 * 65]); o.w = pk2(s[6 * 65], s[7 * 65]);
        *(u32x4*)(dst + (size_t)n * K + k0 + 8 * c) = o; }
    WAVE_SYNC();
}
__device__ __forceinline__ void ph_convert(const Ctx& A, LAS unsigned char* lds, int lane, int wave, int G) {
    LAS float* scr = (LAS float*)(lds + wave * 16640);
    const int gw = blockIdx.x * NWAVES + wave, NGW = G * NWAVES;
    constexpr int I_IN = DEPTH * 16 * 60, I_OUT = DEPTH * 16 * 16, I_GU = DEPTH * NE * 16 * 32, I_D = DEPTH * NE * 16 * 16;
    for (int it = gw; it < I_IN + I_OUT + I_GU + I_D; it += NGW) {
        int r = it;
        if (r < I_IN) { const int nb = r % 60, kb = (r / 60) % 16, l = r / 960;
            cvt_item(A.in(IWIN) + (size_t)l * D * DIN, DIN, kb * 64, nb * 64, DIN, (bf16*)(A.ws() + WS_WIN) + ((size_t)l * DINP + nb * 64) * D, D, scr, lane); continue; }
        r -= I_IN;
        if (r < I_OUT) { const int nb = r % 16, kb = (r / 16) % 16, l = r / 256;
            cvt_item(A.in(IWOUT) + (size_t)l * D * D, D, kb * 64, nb * 64, D, (bf16*)(A.ws() + WS_WOUT) + ((size_t)l * D + nb * 64) * D, D, scr, lane); continue; }
        r -= I_OUT;
        if (r < I_GU) { const int nb = r % 32, kb = (r / 32) % 16, le = r / 512; const int j = nb >> 2, q = nb & 3;
            const int src0 = (q < 2) ? (128 * j + 64 * q) : (1024 + 128 * j + 64 * (q - 2));
            cvt_item(A.in(IWGU) + (size_t)le * D * 2048, 2048, kb * 64, src0, 2048, (bf16*)(A.ws() + WS_WGU) + ((size_t)le * 2048 + nb * 64) * D, D, scr, lane); continue; }
        r -= I_GU;
        { const int nb = r % 16, kb = (r / 16) % 16, le = r / 256;
            cvt_item(A.in(IWD) + (size_t)le * D * D, D, kb * 64, nb * 64, D, (bf16*)(A.ws() + WS_WD) + ((size_t)le * D + nb * 64) * D, D, scr, lane); }
    }
}

__device__ __forceinline__ void ph_init(const Ctx& A, int lane, int wave, int G) {
    const int gw = blockIdx.x * NWAVES + wave, NGW = G * NWAVES;
    float* X = (float*)(A.ws() + WS_X); bf16* H = (bf16*)(A.ws() + WS_H); const float* mods = (const float*)(A.ws() + WS_MODS);
    for (int m = gw; m < NTOK; m += NGW) {
        const float* src = m < NLAT ? A.in(IX) + (size_t)m * D : A.in(ICTX) + (size_t)(m - NLAT) * D;
        const f32x4* xr = (const f32x4*)src + lane; f32x4* xo = (f32x4*)(X + (size_t)m * D) + lane;
        f32x4 v[4];
#pragma unroll
        for (int j = 0; j < 4; ++j) { v[j] = xr[64 * j]; xo[64 * j] = v[j]; }
        row_ln(v);
        const float* md = mods + (size_t)(0 * 5 + mod_row(m)) * 6144;
#pragma unroll
        for (int j = 0; j < 4; ++j) { const f32x4 sh = ((const f32x4*)md)[lane + 64 * j], scl = ((const f32x4*)(md + D))[lane + 64 * j]; v[j] = v[j] * (scl + 1.f) + sh; }
        row_store_bf16(H + (size_t)m * D, v, lane);
    }
}

struct EpiCols {
    static constexpr bool PERM = true, AFTER_DRAIN = false;
    bf16* C; float* gates;
    __device__ __forceinline__ void operator()(const f32x4 (&acc)[2][2][4][2], const pg8::Unit& u, int wr, int wc, int fr, int fq) const {
        const int row0 = u.pm * 256 + wr * 64 + fr, colb = u.pn * 256 + wc * 32 + 8 * fq;
#pragma unroll
        for (int ai = 0; ai < 2; ++ai)
#pragma unroll
            for (int m = 0; m < 4; ++m) { const int row = row0 + ai * 128 + m * 16;
#pragma unroll
                for (int bj = 0; bj < 2; ++bj) { const int col = colb + bj * 128; const f32x4 v0 = acc[ai][bj][m][0], v1 = acc[ai][bj][m][1];
                    if (col < DIN) { u32x4 w; w.x = pk2(v0[0], v0[1]); w.y = pk2(v0[2], v0[3]); w.z = pk2(v1[0], v1[1]); w.w = pk2(v1[2], v1[3]);
                        *(u32x4*)(C + (size_t)row * DIN + col) = w; }
                    int gc = -1;
                    if (col >= C_GLA_A && col < C_GLA_A + 32) gc = col - C_GLA_A; else if (col >= C_GDN_B && col < C_GDN_B + 16) gc = 32 + col - C_GDN_B;
                    if (gc >= 0) { float* gp = gates + (size_t)row * 48 + gc; *(f32x4*)gp = v0; *(f32x4*)(gp + 4) = v1; } } }
    }
};
struct EpiOut {
    static constexpr bool PERM = false, AFTER_DRAIN = false;
    float* X; const float* mods;
    __device__ __forceinline__ void operator()(const f32x4 (&acc)[2][2][4][2], const pg8::Unit& u, int wr, int wc, int fr, int fq) const {
        const int row0 = u.pm * 256 + wr * 64 + fr, col0 = u.pn * 256 + wc * 32 + 4 * fq;
#pragma unroll
        for (int ai = 0; ai < 2; ++ai)
#pragma unroll
            for (int m = 0; m < 4; ++m) { const int row = row0 + ai * 128 + m * 16; float* xr = X + (size_t)row * D + col0; const float* g = mods + (size_t)mod_row(row) * 6144 + 2 * D + col0;
#pragma unroll
                for (int bj = 0; bj < 2; ++bj)
#pragma unroll
                    for (int n = 0; n < 2; ++n) { const int o = bj * 128 + n * 16; const f32x4 xv = *(const f32x4*)(xr + o), gv = *(const f32x4*)(g + o);
                        *(f32x4*)(xr + o) = xv * DN_ALPHA + gv * acc[ai][bj][m][n]; } }
    }
};
struct EpiAct {
    static constexpr bool PERM = true, AFTER_DRAIN = false;
    bf16* O; const float* bias;
    __device__ __forceinline__ void operator()(const f32x4 (&acc)[2][2][4][2], const pg8::Unit& u, int wr, int wc, int fr, int fq) const {
        const int e = u.pn >> 3, j = u.pn & 7;
        const int row0 = u.pm * 256 + wr * 64 + fr, col = j * 128 + wc * 32 + 8 * fq;
        const float* bg = bias + (size_t)e * 2048 + col; const float* bu = bg + 1024;
        const f32x4 bg0 = *(const f32x4*)bg, bg1 = *(const f32x4*)(bg + 4), bu0 = *(const f32x4*)bu, bu1 = *(const f32x4*)(bu + 4);
#pragma unroll
        for (int ai = 0; ai < 2; ++ai)
#pragma unroll
            for (int m = 0; m < 4; ++m) { const int row = row0 + ai * 128 + m * 16;
                f32x4 g0 = acc[ai][0][m][0] + bg0, g1 = acc[ai][0][m][1] + bg1, u0 = acc[ai][1][m][0] + bu0, u1 = acc[ai][1][m][1] + bu1; float a[8];
#pragma unroll
                for (int i = 0; i < 4; ++i) { float gt = fminf(g0[i], 7.f), up = fminf(fmaxf(u0[i], -7.f), 7.f); a[i] = (up + 1.f) * gt * sigmoidf_(1.702f * gt);
                    gt = fminf(g1[i], 7.f); up = fminf(fmaxf(u1[i], -7.f), 7.f); a[4 + i] = (up + 1.f) * gt * sigmoidf_(1.702f * gt); }
                u32x4 w; w.x = pk2(a[0], a[1]); w.y = pk2(a[2], a[3]); w.z = pk2(a[4], a[5]); w.w = pk2(a[6], a[7]);
                *(u32x4*)(O + (size_t)row * D + col) = w; }
    }
};
struct EpiY {
    static constexpr bool PERM = true, AFTER_DRAIN = false;
    bf16* O; const float* bias;
    __device__ __forceinline__ void operator()(const f32x4 (&acc)[2][2][4][2], const pg8::Unit& u, int wr, int wc, int fr, int fq) const {
        const int e = u.pn >> 2, j = u.pn & 3;
        const int row0 = u.pm * 256 + wr * 64 + fr, colb = j * 256 + wc * 32 + 8 * fq;
#pragma unroll
        for (int bj = 0; bj < 2; ++bj) { const int col = colb + bj * 128; const float* b = bias + (size_t)e * D + col; const f32x4 b0 = *(const f32x4*)b, b1 = *(const f32x4*)(b + 4);
#pragma unroll
            for (int ai = 0; ai < 2; ++ai)
#pragma unroll
                for (int m = 0; m < 4; ++m) { const int row = row0 + ai * 128 + m * 16; const f32x4 v0 = acc[ai][bj][m][0] + b0, v1 = acc[ai][bj][m][1] + b1;
                    u32x4 w; w.x = pk2(v0[0], v0[1]); w.y = pk2(v0[2], v0[3]); w.z = pk2(v1[0], v1[1]); w.w = pk2(v1[2], v1[3]);
                    *(u32x4*)(O + (size_t)row * D + col) = w; } }
    }
};
struct MoeOrder {
    const LAS int* blk_e; int n_units, NT, G, c;
    __device__ __forceinline__ bool next(int i, pg8::Unit& u) const {
        const int L = i * G + c; if (L >= n_units) return false;
        const int rb = L / NT, j = L - rb * NT; u.pm = rb; u.pn = __builtin_amdgcn_readfirstlane(blk_e[rb]) * NT + j; return true;
    }
    __device__ __forceinline__ void a_ready(const pg8::Unit&) const {}
    __device__ __forceinline__ void done(const pg8::Unit&) const {}
};
__device__ __forceinline__ void moe_tables(const unsigned* cnt, LAS int* tab, int tid) {
    if (tid == 0) { int ps = 0, rb = 0;
        for (int e = 0; e < NE; ++e) { const int c = (int)__hip_atomic_load(cnt + e, __ATOMIC_RELAXED, __HIP_MEMORY_SCOPE_AGENT); tab[e] = ps; tab[400 + e] = c; const int nb = (c + 255) >> 8;
            for (int q = 0; q < nb; ++q) tab[64 + rb + q] = e; rb += nb; ps += nb * 256; }
        tab[32] = ps; tab[40] = rb; }
    __syncthreads();
}

__device__ __forceinline__ void ph_ln1_route(const Ctx& A, int l, LAS unsigned char* lds, int tid, int lane, int wave, int nrows_total) {
    LAS float* wT = (LAS float*)lds; LAS int* msc = (LAS int*)(lds + MISC_OFF + 1024);
    const float* wr = A.in(IWR) + (size_t)l * D * NE;
    for (int i = tid; i < D * NE / 4; i += NTHR) { const f32x4 v = ((const f32x4*)wr)[i]; const int k = i >> 3, e0 = (i & 7) * 4;
        wT[(e0 + 0) * D + k] = v.x; wT[(e0 + 1) * D + k] = v.y; wT[(e0 + 2) * D + k] = v.z; wT[(e0 + 3) * D + k] = v.w; }
    if (tid < 64) msc[tid] = 0;
    __syncthreads();
    const int RPB = nrows_total / (int)gridDim.x;
    const int rbase = blockIdx.x * RPB;
    float* X = (float*)(A.ws() + WS_X); bf16* H = (bf16*)(A.ws() + WS_H); const float* mods = (const float*)(A.ws() + WS_MODS) + (size_t)l * 5 * 6144;
    float* tokg = (float*)(A.ws() + WS_TOKG);
    const float* g1 = A.in(ILN1G) + l * D; const float* b1 = A.in(ILN1B) + l * D;
    for (int rl = wave; rl < RPB; rl += NWAVES) {
        const int m = rbase + rl;
        f32x4* xr = (f32x4*)(X + (size_t)m * D) + lane; f32x4 v[4];
#pragma unroll
        for (int j = 0; j < 4; ++j) v[j] = xr[64 * j];
        row_ln(v);
#pragma unroll
        for (int j = 0; j < 4; ++j) { v[j] = v[j] * ((const f32x4*)g1)[lane + 64 * j] + ((const f32x4*)b1)[lane + 64 * j]; xr[64 * j] = v[j]; }
        row_ln(v);
        const float* md = mods + (size_t)mod_row(m) * 6144;
#pragma unroll
        for (int j = 0; j < 4; ++j) { const f32x4 sh = ((const f32x4*)(md + 3 * D))[lane + 64 * j], scl = ((const f32x4*)(md + 4 * D))[lane + 64 * j]; v[j] = v[j] * (scl + 1.f) + sh; }
        row_store_bf16(H + (size_t)m * D, v, lane);
        float p[NE];
#pragma unroll
        for (int e = 0; e < NE; ++e) { float s = 0.f;
#pragma unroll
            for (int j = 0; j < 4; ++j) { const f32x4 w = *(const LAS f32x4*)(wT + e * D + 4 * (lane + 64 * j)); s += v[j].x * w.x + v[j].y * w.y + v[j].z * w.z + v[j].w * w.w; }
            p[e] = s; }
#pragma unroll
        for (int st = 0; st < 5; ++st) { const int off = 32 >> st, n = 16 >> st; const bool hi = (lane & off) != 0;
#pragma unroll
            for (int i = 0; i < n; ++i) { const float keep = hi ? p[i + n] : p[i], send = hi ? p[i] : p[i + n]; p[i] = keep + __shfl_xor(send, off); } }
        float val = p[0] + __shfl_xor(p[0], 1);
        const int me = lane >> 1;
        val += A.in(IBR)[l * NE + me];
        float tv[4]; int te[4];
#pragma unroll
        for (int k = 0; k < 4; ++k) { const float mx = wmax(val); int cand = (val == mx) ? me : 99;
#pragma unroll
            for (int o = 1; o < 64; o <<= 1) cand = min(cand, __shfl_xor(cand, o));
            tv[k] = mx; te[k] = cand; if (me == cand) val = -INFINITY; }
        const float e1 = __expf(tv[1] - tv[0]), e2 = __expf(tv[2] - tv[0]), e3 = __expf(tv[3] - tv[0]); const float inv = 1.f / (1.f + e1 + e2 + e3);
        if (lane == 0) {
            *(f32x4*)(tokg + (size_t)m * 4) = (f32x4){inv, e1 * inv, e2 * inv, e3 * inv};
#pragma unroll
            for (int k = 0; k < 4; ++k) { const int pos = atomicAdd((int*)(msc + te[k]), 1); msc[64 + rl * 4 + k] = te[k] | (pos << 8); }
        }
    }
    __syncthreads();
    unsigned* gcnt = (unsigned*)(A.ws() + WS_CTL) + CW_CNT + l * 64;
    if (tid < NE) msc[32 + tid] = (int)atomicAdd(gcnt + tid, (unsigned)msc[tid]);
    __syncthreads();
    int* toke = (int*)(A.ws() + WS_TOKE); int* tokp = (int*)(A.ws() + WS_TOKP);
    for (int i = tid; i < RPB * 4; i += NTHR) { const int s = msc[64 + i], e = s & 255, pos = s >> 8; toke[(size_t)rbase * 4 + i] = e; tokp[(size_t)rbase * 4 + i] = msc[32 + e] + pos; }
    __syncthreads();
}

__device__ __forceinline__ void ph_gather(const Ctx& A, int l, LAS unsigned char* lds, int tid, int lane, int wave, int G, int nrows_total) {
    LAS int* tab = (LAS int*)(lds + MISC_OFF + 1024);
    moe_tables((const unsigned*)(A.ws() + WS_CTL) + CW_CNT + l * 64, tab, tid);
    const int gw = blockIdx.x * NWAVES + wave, NGW = G * NWAVES;
    const int* toke = (const int*)(A.ws() + WS_TOKE); const int* tokp = (const int*)(A.ws() + WS_TOKP); int* toks = (int*)(A.ws() + WS_TOKS);
    const bf16* H = (const bf16*)(A.ws() + WS_H); bf16* XB = (bf16*)(A.ws() + WS_XB);
    for (int p = gw; p < nrows_total * 4; p += NGW) {
        const int e = toke[p], slot = tab[e] + tokp[p]; if (lane == 0) toks[p] = slot;
        const u32x4* s = (const u32x4*)(H + (size_t)(p >> 2) * D) + lane; u32x4* d = (u32x4*)(XB + (size_t)slot * D) + lane;
        d[0] = s[0]; d[64] = s[64];
    }
    for (int q = gw; q < NE * 256; q += NGW) { const int e = q >> 8, i = q & 255; const int c = tab[400 + e], pad = ((c + 255) & ~255) - c;
        if (i < pad) { u32x4* d = (u32x4*)(XB + (size_t)(tab[e] + c + i) * D) + lane; const u32x4 z = {0u, 0u, 0u, 0u}; d[0] = z; d[64] = z; } }
}

__device__ __forceinline__ void ph_combine(const Ctx& A, int l, int lane, int wave, int G, int nrows_total) {
    const int gw = blockIdx.x * NWAVES + wave, NGW = G * NWAVES;
    float* X = (float*)(A.ws() + WS_X); bf16* H = (bf16*)(A.ws() + WS_H); const bf16* YB = (const bf16*)(A.ws() + WS_YB);
    const float* mods = (const float*)(A.ws() + WS_MODS) + (size_t)l * 5 * 6144;
    const int* toks = (const int*)(A.ws() + WS_TOKS); const float* tokg = (const float*)(A.ws() + WS_TOKG);
    const float* g2 = A.in(ILN2G) + l * D; const float* b2 = A.in(ILN2B) + l * D;
    for (int m = gw; m < nrows_total; m += NGW) {
        f32x4 f[4];
#pragma unroll
        for (int j = 0; j < 4; ++j) f[j] = (f32x4){0.f, 0.f, 0.f, 0.f};
#pragma unroll
        for (int k = 0; k < 4; ++k) { const int slot = toks[m * 4 + k]; const float g = tokg[m * 4 + k]; const u32x2* y = (const u32x2*)(YB + (size_t)slot * D) + lane;
#pragma unroll
            for (int j = 0; j < 4; ++j) { const u32x2 w = y[64 * j]; f[j].x += g * bf2f(w.x & 0xffffu); f[j].y += g * bf2f(w.x >> 16); f[j].z += g * bf2f(w.y & 0xffffu); f[j].w += g * bf2f(w.y >> 16); } }
        f32x4* xr = (f32x4*)(X + (size_t)m * D) + lane; const float* md = mods + (size_t)mod_row(m) * 6144; f32x4 v[4];
#pragma unroll
        for (int j = 0; j < 4; ++j) v[j] = xr[64 * j] * DN_ALPHA + ((const f32x4*)(md + 5 * D))[lane + 64 * j] * f[j];
        row_ln(v);
#pragma unroll
        for (int j = 0; j < 4; ++j) v[j] = v[j] * ((const f32x4*)g2)[lane + 64 * j] + ((const f32x4*)b2)[lane + 64 * j];
        if (l == DEPTH - 1) { f32x4* o = (f32x4*)(A.out() + (size_t)m * D) + lane;
#pragma unroll
            for (int j = 0; j < 4; ++j) o[64 * j] = v[j];
        } else {
#pragma unroll
            for (int j = 0; j < 4; ++j) xr[64 * j] = v[j];
            row_ln(v);
            const float* mn = mods + 5 * 6144 + (size_t)mod_row(m) * 6144;
#pragma unroll
            for (int j = 0; j < 4; ++j) { const f32x4 sh = ((const f32x4*)mn)[lane + 64 * j], scl = ((const f32x4*)(mn + D))[lane + 64 * j]; v[j] = v[j] * (scl + 1.f) + sh; }
            row_store_bf16(H + (size_t)m * D, v, lane);
        }
    }
}

__device__ __forceinline__ void ph_gdn_conv(const Ctx& A, int l, int lane, int wave, int G) {
    const int gw = blockIdx.x * NWAVES + wave, NGW = G * NWAVES;
    const bf16* cols = (const bf16*)(A.ws() + WS_COLS); const float* gates = (const float*)(A.ws() + WS_GATES);
    bf16* GQ = (bf16*)(A.ws() + WS_GQ); bf16* GK = (bf16*)(A.ws() + WS_GK); bf16* GV = (bf16*)(A.ws() + WS_GV);
    float* GG = (float*)(A.ws() + WS_GG); float* GB = (float*)(A.ws() + WS_GB);
    const float* cw = A.in(ICONV) + (size_t)l * 5 * 1536;
    for (int m = gw; m < NTOK; m += NGW) {
        int t, slen, sbase;
        if (m < NLAT) { t = m & (SEQ - 1); slen = SEQ; sbase = m - t; } else { t = (m - NLAT) & (CTXL - 1); slen = CTXL; sbase = m - t; }
#pragma unroll
        for (int part = 0; part < 3; ++part) {
            const int ch0 = part * 512 + 8 * lane;
            float a[8];
#pragma unroll
            for (int i = 0; i < 8; ++i) a[i] = 0.f;
#pragma unroll
            for (int j = 0; j < 5; ++j) { const int tt = t + j - 2;
                if (tt >= 0 && tt < slen) { const u32x4 w = *(const u32x4*)(cols + (size_t)(sbase + tt) * DIN + C_GDN_Q + ch0);
                    const f32x4 c0 = *(const f32x4*)(cw + j * 1536 + ch0), c1 = *(const f32x4*)(cw + j * 1536 + ch0 + 4);
                    a[0] += bf2f(w.x & 0xffffu) * c0.x; a[1] += bf2f(w.x >> 16) * c0.y; a[2] += bf2f(w.y & 0xffffu) * c0.z; a[3] += bf2f(w.y >> 16) * c0.w;
                    a[4] += bf2f(w.z & 0xffffu) * c1.x; a[5] += bf2f(w.z >> 16) * c1.y; a[6] += bf2f(w.w & 0xffffu) * c1.z; a[7] += bf2f(w.w >> 16) * c1.w; } }
            float ss = 0.f;
#pragma unroll
            for (int i = 0; i < 8; ++i) { a[i] = siluf_(a[i]); ss += a[i] * a[i]; }
            float scale = 1.f;
            if (part < 2) { ss += __shfl_xor(ss, 1); ss += __shfl_xor(ss, 2); ss += __shfl_xor(ss, 4); ss += __shfl_xor(ss, 8);
                scale = rsqrtf(ss + 1e-6f) * (part == 0 ? 0.08838834764831845f : 1.f); }
            u32x4 o; o.x = pk2(a[0] * scale, a[1] * scale); o.y = pk2(a[2] * scale, a[3] * scale); o.z = pk2(a[4] * scale, a[5] * scale); o.w = pk2(a[6] * scale, a[7] * scale);
            bf16* dst = part == 0 ? GQ : (part == 1 ? GK : GV);
            *(u32x4*)(dst + (size_t)m * 512 + 8 * lane) = o;
        }
        if (lane < 8) { const float blr = gates[(size_t)m * 48 + 32 + lane], alr = gates[(size_t)m * 48 + 40 + lane];
            GB[(size_t)m * 8 + lane] = sigmoidf_(blr);
            GG[(size_t)m * 8 + lane] = -__expf(A.in(IALOG)[l * 8 + lane]) * softplusf_(alr + A.in(IDTB)[l * 8 + lane]); }
    }
}

template <bool CTXQ>
__device__ __forceinline__ void na_unit(const Ctx& A, int l, LAS unsigned char* lds, int unit, int tid, int lane, int wave) {
    constexpr int NKT = CTXQ ? 16 : 48, NTW = NKT / 2, NKEYS = NKT * 16, KST = 72, VST = NKEYS + 8;
    const bf16* cols = (const bf16*)(A.ws() + WS_COLS); bf16* MIX = (bf16*)(A.ws() + WS_MIX);
    int b, h, r = 0, r0 = 0, qbase;
    if (!CTXQ) { b = unit >> 8; h = (unit >> 6) & 3; r = unit & 63; r0 = min(max(r - 4, 0), 56); qbase = b * SEQ + r * 64; }
    else { b = unit >> 4; h = (unit >> 2) & 3; qbase = NLAT + b * CTXL + (unit & 3) * 64; }
    LAS bf16* Kimg = (LAS bf16*)lds; LAS bf16* VT = (LAS bf16*)lds;
    const int mt = wave & 3, kq = wave >> 2, qi = lane & 15, g = lane >> 4;
    for (int q = tid; q < NKEYS * 8; q += NTHR) { const int n = q >> 3, part = q & 7;
        const int krow = (!CTXQ && n < 512) ? (b * SEQ + (r0 + (n >> 6)) * 64 + (n & 63)) : (NLAT + b * CTXL + (CTXQ ? n : n - 512));
        *(LAS u32x4*)(Kimg + n * KST + part * 8) = *(const u32x4*)(cols + (size_t)krow * DIN + C_NA_K + h * 64 + part * 8); }
    const int qrow = qbase + mt * 16 + qi;
    const bf16x8 qf0 = *(const bf16x8*)(cols + (size_t)qrow * DIN + C_NA_Q + h * 64 + g * 8), qf1 = *(const bf16x8*)(cols + (size_t)qrow * DIN + C_NA_Q + h * 64 + 32 + g * 8);
    __syncthreads();
    f32x4 s[NTW];
#pragma unroll
    for (int t = 0; t < NTW; ++t) { const int kt = kq * NTW + t; f32x4 acc = {0.f, 0.f, 0.f, 0.f};
        acc = mma(lds_frag(Kimg, KST, kt * 16, 0, lane), qf0, acc); acc = mma(lds_frag(Kimg, KST, kt * 16, 32, lane), qf1, acc); s[t] = acc; }
    const int cq = mt * 16 + qi, c0 = min(max(cq - 8, 0), 48);
    const float* rpb = A.in(IRPB) + (size_t)(l * 4 + h) * 15 * 31;
    float mloc = -INFINITY;
#pragma unroll
    for (int t = 0; t < NTW; ++t) { const int kt = kq * NTW + t;
        if (!CTXQ && kt < 32) { const int kr = kt >> 2, dr = r0 + kr - r + 7;
#pragma unroll
            for (int i = 0; i < 4; ++i) { const int ck = (kt & 3) * 16 + 4 * g + i; const bool ok = ck >= c0 && ck < c0 + 16;
                const int dc = min(max(ck - cq + 15, 0), 30);
                const float v = ok ? s[t][i] * 0.125f + rpb[dr * 31 + dc] : -INFINITY; s[t][i] = v; mloc = fmaxf(mloc, v); }
        } else {
#pragma unroll
            for (int i = 0; i < 4; ++i) { const float v = s[t][i] * 0.125f; s[t][i] = v; mloc = fmaxf(mloc, v); } } }
    mloc = fmaxf(mloc, __shfl_xor(mloc, 16)); mloc = fmaxf(mloc, __shfl_xor(mloc, 32));
    float lsum = 0.f; bf16x8 pb[NTW / 2];
#pragma unroll
    for (int tt = 0; tt < NTW / 2; ++tt) { float p[8];
#pragma unroll
        for (int i = 0; i < 4; ++i) { p[i] = __expf(s[2 * tt][i] - mloc); p[4 + i] = __expf(s[2 * tt + 1][i] - mloc); }
#pragma unroll
        for (int i = 0; i < 8; ++i) lsum += p[i];
        u32x4 w; w.x = pk2(p[0], p[1]); w.y = pk2(p[2], p[3]); w.z = pk2(p[4], p[5]); w.w = pk2(p[6], p[7]);
        pb[tt] = __builtin_bit_cast(bf16x8, w); }
    lsum += __shfl_xor(lsum, 16); lsum += __shfl_xor(lsum, 32);
    __syncthreads();
    for (int q = tid; q < NKEYS * 8; q += NTHR) { const int n = q >> 3, part = q & 7;
        const int krow = (!CTXQ && n < 512) ? (b * SEQ + (r0 + (n >> 6)) * 64 + (n & 63)) : (NLAT + b * CTXL + (CTXQ ? n : n - 512));
        const u32x4 w = *(const u32x4*)(cols + (size_t)krow * DIN + C_NA_V + h * 64 + part * 8);
        LAS bf16* d = VT + (part * 8) * VST + n;
        d[0] = (bf16)(w.x & 0xffffu); d[VST] = (bf16)(w.x >> 16); d[2 * VST] = (bf16)(w.y & 0xffffu); d[3 * VST] = (bf16)(w.y >> 16);
        d[4 * VST] = (bf16)(w.z & 0xffffu); d[5 * VST] = (bf16)(w.z >> 16); d[6 * VST] = (bf16)(w.w & 0xffffu); d[7 * VST] = (bf16)(w.w >> 16); }
    __syncthreads();
    f32x4 o[4];
#pragma unroll
    for (int dt = 0; dt < 4; ++dt) { f32x4 acc = {0.f, 0.f, 0.f, 0.f};
#pragma unroll
        for (int tt = 0; tt < NTW / 2; ++tt) { const int key0 = (kq * NTW + 2 * tt) * 16 + 4 * g; const LAS bf16* vp = VT + (dt * 16 + qi) * VST + key0;
            const u32x2 lo = *(const LAS u32x2*)vp, hi = *(const LAS u32x2*)(vp + 16); u32x4 w; w.x = lo.x; w.y = lo.y; w.z = hi.x; w.w = hi.y;
            acc = mma(__builtin_bit_cast(bf16x8, w), pb[tt], acc); }
        o[dt] = acc; }
    __syncthreads();
    LAS float* mrg = (LAS float*)lds + mt * 1088;
    if (kq == 1) {
#pragma unroll
        for (int dt = 0; dt < 4; ++dt)
#pragma unroll
            for (int i = 0; i < 4; ++i) mrg[(dt * 16 + 4 * g + i) * 16 + qi] = o[dt][i];
        if (g == 0) { mrg[1024 + qi] = mloc; mrg[1040 + qi] = lsum; } }
    __syncthreads();
    if (kq == 0) { const float m1 = mrg[1024 + qi], l1 = mrg[1040 + qi], mm = fmaxf(mloc, m1), f0 = __expf(mloc - mm), f1 = __expf(m1 - mm), inv = 1.f / (lsum * f0 + l1 * f1);
#pragma unroll
        for (int dt = 0; dt < 4; ++dt) { float y[4];
#pragma unroll
            for (int i = 0; i < 4; ++i) y[i] = (o[dt][i] * f0 + mrg[(dt * 16 + 4 * g + i) * 16 + qi] * f1) * inv;
            u32x2 w; w.x = pk2(y[0], y[1]); w.y = pk2(y[2], y[3]);
            *(u32x2*)(MIX + (size_t)qrow * D + 256 + h * 64 + dt * 16 + 4 * g) = w; } }
    __syncthreads();
}

__device__ __forceinline__ void gla_item_info(int item, int& b, int& h, int& cc, int& m0, bool& isctx) {
    const int cidx = item >> 2; h = item & 3;
    if (cidx < 512) { b = cidx >> 7; cc = cidx & 127; m0 = b * SEQ + cc * 32; isctx = false; } else { const int j = cidx - 512; b = j >> 3; cc = j & 7; m0 = NLAT + b * CTXL + cc * 32; isctx = true; }
}
__device__ __forceinline__ int gla_cpos(bool isctx, int cc, int dir) { return isctx ? (dir ? 7 - cc : cc) : 8 + (dir ? 127 - cc : cc); }
__device__ __forceinline__ void gla_cumdecay(const Ctx& A, int l, int h, int m0, int dir, LAS float* Gs, int lane) {
    const int d = lane & 31, th = lane >> 5;
    const float* gates = (const float*)(A.ws() + WS_GATES);
    const float* w2 = A.in(IGLAW) + ((size_t)(l * 2 + dir) * 16) * 128 + h * 32 + d;
    float w[16];
#pragma unroll
    for (int r = 0; r < 16; ++r) w[r] = w2[r * 128];
    const float bias = A.in(IGLAB)[(l * 2 + dir) * 128 + h * 32 + d];
#pragma unroll 4
    for (int tt = 0; tt < 16; ++tt) { const int t = th * 16 + tt; const f32x4* ap = (const f32x4*)(gates + (size_t)(m0 + t) * 48 + dir * 16);
        const f32x4 a0 = ap[0], a1 = ap[1], a2 = ap[2], a3 = ap[3];
        float z = bias + a0.x * w[0] + a0.y * w[1] + a0.z * w[2] + a0.w * w[3] + a1.x * w[4] + a1.y * w[5] + a1.z * w[6] + a1.w * w[7]
                       + a2.x * w[8] + a2.y * w[9] + a2.z * w[10] + a2.w * w[11] + a3.x * w[12] + a3.y * w[13] + a3.z * w[14] + a3.w * w[15];
        Gs[t * 32 + d] = logsigmoidf_(z) * (1.f / 16.f); }
    WAVE_SYNC();
    if (lane < 32) { float acc = 0.f;
        if (dir == 0) { for (int t = 0; t < 32; ++t) { acc += Gs[t * 32 + d]; Gs[t * 32 + d] = acc; } }
        else { for (int t = 31; t >= 0; --t) { acc += Gs[t * 32 + d]; Gs[t * 32 + d] = acc; } } }
    WAVE_SYNC();
}
__device__ __forceinline__ float gla_rope(float x, bool isctx, int cc, int t, int d) {
    const float y = __shfl_xor(x, 8);
    if (isctx) return x;
    const int tpos = cc * 32 + t, pos = (d & 16) ? (tpos & 63) : (tpos >> 6);
    const float invf = __expf(-(float)(d & 7) * 1.1512925464970229f);
    float sn, cs; sincosf((float)pos * invf, &sn, &cs);
    return (d & 8) ? (x * cs + y * sn) : (x * cs - y * sn);
}
__device__ __forceinline__ void gla_stage_vt(const bf16* cols, int h, int m0, LAS bf16* VT, int lane) {
#pragma unroll 8
    for (int t = 0; t < 32; ++t) VT[lane * 40 + t] = cols[(size_t)(m0 + t) * DIN + C_GLA_V + h * 64 + lane];
}
__device__ __forceinline__ void ph_gla_a(const Ctx& A, int l, LAS unsigned char* lds, int lane, int wave, int G) {
    LAS unsigned char* base = lds + wave * 14336;
    LAS float* Gs = (LAS float*)base; LAS bf16* KT = (LAS bf16*)(base + 6656); LAS bf16* VT = (LAS bf16*)(base + 9216);
    const bf16* cols = (const bf16*)(A.ws() + WS_COLS); float* SD = (float*)(A.ws() + WS_SD); float* SA = (float*)(A.ws() + WS_SA);
    const int gw = blockIdx.x * NWAVES + wave, NGW = G * NWAVES; const int d = lane & 31, th = lane >> 5, g = lane >> 4;
    for (int item = gw; item < 544 * 4; item += NGW) {
        int b, h, cc, m0; bool isctx; gla_item_info(item, b, h, cc, m0, isctx);
        gla_stage_vt(cols, h, m0, VT, lane);
#pragma unroll 1
        for (int dir = 0; dir < 2; ++dir) {
            gla_cumdecay(A, l, h, m0, dir, Gs, lane);
            const float glast = Gs[(dir ? 0 : 31) * 32 + d];
#pragma unroll 4
            for (int tt = 0; tt < 16; ++tt) { const int t = th * 16 + tt;
                float k = bf2f(cols[(size_t)(m0 + t) * DIN + C_GLA_K + h * 32 + d]); k = gla_rope(k, isctx, cc, t, d);
                KT[d * 40 + t] = (bf16)f2bf(k * __expf(glast - Gs[t * 32 + d])); }
            WAVE_SYNC();
            const int chain = (b * 4 + h) * 2 + dir, cpos = gla_cpos(isctx, cc, dir);
            float* sd = SD + ((size_t)chain * 136 + cpos) * 2048;
#pragma unroll
            for (int i = 0; i < 2; ++i) { const bf16x8 a = lds_frag(KT, 40, 16 * i, 0, lane);
#pragma unroll
                for (int j = 0; j < 4; ++j) { f32x4 acc = {0.f, 0.f, 0.f, 0.f}; acc = mma(a, lds_frag(VT, 40, 16 * j, 0, lane), acc);
#pragma unroll
                    for (int r = 0; r < 4; ++r) sd[(16 * i + 4 * g + r) * 64 + 16 * j + (lane & 15)] = acc[r]; } }
            if (lane < 32) SA[((size_t)chain * 136 + cpos) * 32 + d] = __expf(glast);
            WAVE_SYNC();
        }
    }
}
__device__ __forceinline__ void ph_gla_b(const Ctx& A, int tid, int G) {
    float* SD = (float*)(A.ws() + WS_SD); const float* SA = (const float*)(A.ws() + WS_SA);
    for (int idx = blockIdx.x * NTHR + tid; idx < 32 * 2048; idx += G * NTHR) {
        const int chain = idx >> 11, e = idx & 2047, d = e >> 6;
        float* sd = SD + (size_t)chain * 136 * 2048 + e; const float* sa = SA + (size_t)chain * 136 * 32 + d;
        float S = 0.f;
#pragma unroll 8
        for (int p = 0; p < 136; ++p) { const float inc = sd[(size_t)p * 2048], a = sa[p * 32]; sd[(size_t)p * 2048] = S; S = a * S + inc; }
    }
}
__device__ __forceinline__ void ph_gla_c(const Ctx& A, int l, LAS unsigned char* lds, int lane, int wave, int G, int nitems) {
    LAS unsigned char* base = lds + wave * 14336;
    LAS float* Gs = (LAS float*)base; LAS bf16* Pm = (LAS bf16*)base; LAS bf16* QT = (LAS bf16*)(base + 4096); LAS bf16* KT = (LAS bf16*)(base + 6656); LAS bf16* VT = (LAS bf16*)(base + 9216);
    const bf16* cols = (const bf16*)(A.ws() + WS_COLS); const float* SD = (const float*)(A.ws() + WS_SD); bf16* MIX = (bf16*)(A.ws() + WS_MIX);
    const int gw = blockIdx.x * NWAVES + wave, NGW = G * NWAVES; const int d = lane & 31, th = lane >> 5, g = lane >> 4, c16 = lane & 15;
    for (int item = gw; item < nitems; item += NGW) {
        int b, h, cc, m0; bool isctx; gla_item_info(item, b, h, cc, m0, isctx);
        gla_stage_vt(cols, h, m0, VT, lane);
        f32x4 o[2][4];
#pragma unroll
        for (int i = 0; i < 2; ++i)
#pragma unroll
            for (int j = 0; j < 4; ++j) o[i][j] = (f32x4){0.f, 0.f, 0.f, 0.f};
#pragma unroll 1
        for (int dir = 0; dir < 2; ++dir) {
            gla_cumdecay(A, l, h, m0, dir, Gs, lane);
#pragma unroll 4
            for (int tt = 0; tt < 16; ++tt) { const int t = th * 16 + tt; const float gv = Gs[t * 32 + d];
                float q = bf2f(cols[(size_t)(m0 + t) * DIN + C_GLA_Q + h * 32 + d]) * 0.17677669529663687f; q = gla_rope(q, isctx, cc, t, d);
                float k = bf2f(cols[(size_t)(m0 + t) * DIN + C_GLA_K + h * 32 + d]); k = gla_rope(k, isctx, cc, t, d);
                QT[t * 40 + d] = (bf16)f2bf(q * __expf(gv)); KT[t * 40 + d] = (bf16)f2bf(k * __expf(-gv)); }
            WAVE_SYNC();
#pragma unroll
            for (int ti = 0; ti < 2; ++ti) { const bf16x8 a = lds_frag(QT, 40, 16 * ti, 0, lane);
#pragma unroll
                for (int sj = 0; sj < 2; ++sj) { f32x4 acc = {0.f, 0.f, 0.f, 0.f}; acc = mma(a, lds_frag(KT, 40, 16 * sj, 0, lane), acc);
#pragma unroll
                    for (int r = 0; r < 4; ++r) { const int t = 16 * ti + 4 * g + r, s = 16 * sj + c16; const bool keep = dir ? (s >= t) : (s <= t);
                        Pm[t * 40 + s] = (bf16)f2bf(keep ? acc[r] : 0.f); } } }
            WAVE_SYNC();
            const int chain = (b * 4 + h) * 2 + dir, cpos = gla_cpos(isctx, cc, dir);
            const float* sd = SD + ((size_t)chain * 136 + cpos) * 2048;
#pragma unroll
            for (int j = 0; j < 4; ++j) {
                float sv[8];
#pragma unroll
                for (int jj = 0; jj < 8; ++jj) sv[jj] = sd[(8 * g + jj) * 64 + 16 * j + c16];
                u32x4 w; w.x = pk2(sv[0], sv[1]); w.y = pk2(sv[2], sv[3]); w.z = pk2(sv[4], sv[5]); w.w = pk2(sv[6], sv[7]);
                const bf16x8 sb = __builtin_bit_cast(bf16x8, w), vb = lds_frag(VT, 40, 16 * j, 0, lane);
#pragma unroll
                for (int ti = 0; ti < 2; ++ti) { o[ti][j] = mma(lds_frag(Pm, 40, 16 * ti, 0, lane), vb, o[ti][j]); o[ti][j] = mma(lds_frag(QT, 40, 16 * ti, 0, lane), sb, o[ti][j]); } }
            WAVE_SYNC();
        }
        const float* ng = A.in(IGLAN) + l * 64;
#pragma unroll
        for (int ti = 0; ti < 2; ++ti)
#pragma unroll
            for (int r = 0; r < 4; ++r) { float ss = 0.f;
#pragma unroll
                for (int j = 0; j < 4; ++j) ss += o[ti][j][r] * o[ti][j][r];
                ss += __shfl_xor(ss, 1); ss += __shfl_xor(ss, 2); ss += __shfl_xor(ss, 4); ss += __shfl_xor(ss, 8);
                const float rs = rsqrtf(ss * (1.f / 64.f) + RMS_EPS); const int t = 16 * ti + 4 * g + r;
#pragma unroll
                for (int j = 0; j < 4; ++j) { const int dv = 16 * j + c16; const float gt = bf2f(cols[(size_t)(m0 + t) * DIN + C_GLA_G + h * 64 + dv]);
                    MIX[(size_t)(m0 + t) * D + h * 64 + dv] = (bf16)f2bf(o[ti][j][r] * rs * ng[dv] * siluf_(gt)); } }
    }
}

__device__ __forceinline__ int gdn_m0(int ci) { return ci < 256 ? ((ci >> 6) * SEQ + (ci & 63) * 64) : (NLAT + ((ci - 256) >> 2) * CTXL + ((ci - 256) & 3) * 64); }

__device__ __forceinline__ void gdn_prep_a(const Ctx& A, LAS unsigned char* lds, int item, int tid, int lane, int wave) {
    LAS bf16* QN = (LAS bf16*)lds; LAS bf16* KN = (LAS bf16*)(lds + 17408);
    LAS float* KK = (LAS float*)(lds + 36864); LAS float* QK = (LAS float*)(lds + 53504); LAS float* GC = (LAS float*)(lds + 70144); LAS float* BE = GC + 64;
    const int ci = item >> 2, h = item & 3, m0 = gdn_m0(ci);
    const bf16* GQ = (const bf16*)(A.ws() + WS_GQ); const bf16* GK = (const bf16*)(A.ws() + WS_GK);
    const float* GG = (const float*)(A.ws() + WS_GG); const float* GB = (const float*)(A.ws() + WS_GB);
    for (int q = tid; q < 2048; q += NTHR) { const int mat = q >> 10, r = (q >> 4) & 63, part = q & 15;
        const u32x4 w = *(const u32x4*)((mat ? GK : GQ) + (size_t)(m0 + r) * 512 + h * 128 + part * 8);
        *(LAS u32x4*)((mat ? KN : QN) + r * 136 + part * 8) = w; }
    __syncthreads();
    const int g = lane >> 4, c16 = lane & 15;
#pragma unroll
    for (int x = 0; x < 4; ++x) { const int id = wave * 4 + x, ti = (id >> 2) & 3, tj = id & 3; const bool isq = id >= 16;
        f32x4 acc = {0.f, 0.f, 0.f, 0.f};
#pragma unroll
        for (int ks = 0; ks < 4; ++ks) acc = mma(lds_frag(isq ? QN : KN, 136, 16 * ti, 32 * ks, lane), lds_frag(KN, 136, 16 * tj, 32 * ks, lane), acc);
        LAS float* dst = isq ? QK : KK;
#pragma unroll
        for (int r = 0; r < 4; ++r) dst[(16 * ti + 4 * g + r) * 65 + 16 * tj + c16] = acc[r]; }
    __syncthreads();
#pragma unroll 1
    for (int dir = 0; dir < 2; ++dir) {
        const int oi = item * 2 + dir;
        if (tid < 64) { const int t = dir ? 63 - tid : tid; GC[tid] = GG[(size_t)(m0 + t) * 8 + dir * 4 + h]; BE[tid] = GB[(size_t)(m0 + t) * 8 + dir * 4 + h]; }
        __syncthreads();
        float myg = 0.f;
        if (tid < 64) { for (int i = 0; i <= tid; ++i) myg += GC[i]; }
        __syncthreads();
        if (tid < 64) { GC[tid] = myg; float* gcb = (float*)(A.ws() + WS_GCB) + (size_t)oi * 128; gcb[tid] = myg; gcb[64 + tid] = BE[tid]; }
        __syncthreads();
        float* LG = (float*)(A.ws() + WS_LG) + (size_t)oi * 4096; bf16* QKM = (bf16*)(A.ws() + WS_GQKM) + (size_t)oi * 4096;
        for (int idx = tid; idx < 4096; idx += NTHR) { const int i = idx >> 6, j = idx & 63, ti = dir ? 63 - i : i, tj = dir ? 63 - j : j;
            const float dec = __expf(fminf(GC[i] - GC[j], 0.f));
            LG[idx] = (j < i) ? BE[i] * KK[ti * 65 + tj] * dec : 0.f;
            QKM[idx] = (bf16)f2bf((j <= i) ? QK[ti * 65 + tj] * dec : 0.f); }
        bf16* QD = (bf16*)(A.ws() + WS_GQD) + (size_t)oi * 8192; bf16* KDT = (bf16*)(A.ws() + WS_GKDT) + (size_t)oi * 8192;
        const float glast = GC[63];
        for (int idx = tid; idx < 8192; idx += NTHR) { const int i = idx >> 7, dk = idx & 127, ti = dir ? 63 - i : i;
            QD[idx] = (bf16)f2bf(bf2f(QN[ti * 136 + dk]) * __expf(GC[i])); }
        for (int idx = tid; idx < 8192; idx += NTHR) { const int dk = idx >> 6, j = idx & 63, tj = dir ? 63 - j : j;
            KDT[idx] = (bf16)f2bf(bf2f(KN[tj * 136 + dk]) * __expf(glast - GC[j])); }
        __syncthreads();
    }
}
__device__ __forceinline__ void gdn_prep_b(const Ctx& A, LAS unsigned char* lds, int oi, int lane, int wave) {
    LAS float* T = (LAS float*)(lds + wave * 16640);
    const float* LG = (const float*)(A.ws() + WS_LG) + (size_t)oi * 4096;
#pragma unroll 8
    for (int i = 0; i < 64; ++i) T[i * 65 + lane] = LG[i * 64 + lane];
    WAVE_SYNC();
    if (lane == 0) T[0] = 1.f;
    WAVE_SYNC();
    for (int i = 1; i < 64; ++i) { float acc = (lane == i) ? 1.f : 0.f;
        for (int j = 0; j < i; ++j) acc -= T[i * 65 + j] * T[j * 65 + lane];
        WAVE_SYNC();
        T[i * 65 + lane] = acc;
        WAVE_SYNC(); }
    bf16* TG = (bf16*)(A.ws() + WS_TG) + (size_t)oi * 4096;
#pragma unroll 8
    for (int i = 0; i < 64; ++i) TG[i * 64 + lane] = (bf16)f2bf(T[i * 65 + lane]);
    WAVE_SYNC();
}
__device__ __forceinline__ void gdn_prep_c(const Ctx& A, LAS unsigned char* lds, int oi, int tid, int lane, int wave) {
    LAS bf16* TB = (LAS bf16*)lds; LAS bf16* BVT = (LAS bf16*)(lds + 9216); LAS bf16* BKT = (LAS bf16*)(lds + 9216 + 18432);
    const int item = oi >> 1, dir = oi & 1, ci = item >> 2, h = item & 3, m0 = gdn_m0(ci);
    const bf16* TG = (const bf16*)(A.ws() + WS_TG) + (size_t)oi * 4096; const float* gcb = (const float*)(A.ws() + WS_GCB) + (size_t)oi * 128;
    const bf16* GK = (const bf16*)(A.ws() + WS_GK); const bf16* GV = (const bf16*)(A.ws() + WS_GV);
    { const int r = tid >> 3, part = tid & 7; *(LAS u32x4*)(TB + r * 72 + part * 8) = *(const u32x4*)(TG + r * 64 + part * 8); }
    for (int idx = tid; idx < 8192; idx += NTHR) { const int j = idx >> 7, c = idx & 127, tj = dir ? 63 - j : j; const float be = gcb[64 + j], eg = __expf(gcb[j]);
        BVT[c * 72 + j] = (bf16)f2bf(be * bf2f(GV[(size_t)(m0 + tj) * 512 + h * 128 + c]));
        BKT[c * 72 + j] = (bf16)f2bf(-be * eg * bf2f(GK[(size_t)(m0 + tj) * 512 + h * 128 + c])); }
    __syncthreads();
    bf16* GU = (bf16*)(A.ws() + WS_GU) + (size_t)oi * 8192; bf16* GW = (bf16*)(A.ws() + WS_GW) + (size_t)oi * 8192;
    const int g = lane >> 4, c16 = lane & 15, mt = wave & 3, nh = wave >> 2;
    const bf16x8 a0 = lds_frag(TB, 72, 16 * mt, 0, lane), a1 = lds_frag(TB, 72, 16 * mt, 32, lane);
    LAS bf16* Bt = nh ? BKT : BVT; bf16* O = nh ? GW : GU;
#pragma unroll
    for (int nt = 0; nt < 8; ++nt) { f32x4 acc = {0.f, 0.f, 0.f, 0.f};
        acc = mma(a0, lds_frag(Bt, 72, 16 * nt, 0, lane), acc); acc = mma(a1, lds_frag(Bt, 72, 16 * nt, 32, lane), acc);
#pragma unroll
        for (int r = 0; r < 4; ++r) O[(16 * mt + 4 * g + r) * 128 + 16 * nt + c16] = (bf16)f2bf(acc[r]); }
    __syncthreads();
}
__device__ __forceinline__ void ph_gdn_prep(const Ctx& A, LAS unsigned char* lds, int tid, int lane, int wave, int G) {
    for (int item = blockIdx.x; item < 272 * 4; item += G) gdn_prep_a(A, lds, item, tid, lane, wave);
    BLOCK_SYNC();
    int nmine = 0; for (int item = blockIdx.x; item < 272 * 4; item += G) ++nmine;
    for (int s = wave; s < nmine * 2; s += NWAVES) gdn_prep_b(A, lds, (blockIdx.x + (s >> 1) * G) * 2 + (s & 1), lane, wave);
    BLOCK_SYNC();
    for (int s = 0; s < nmine * 2; ++s) gdn_prep_c(A, lds, (blockIdx.x + (s >> 1) * G) * 2 + (s & 1), tid, lane, wave);
}

__device__ __forceinline__ void ph_gdn_scan(const Ctx& A, LAS unsigned char* lds, int tid, int lane, int wave, int G) {
    LAS bf16* ST = (LAS bf16*)lds;
    LAS bf16* VN = (LAS bf16*)(lds + 4352);
    const bf16* GU = (const bf16*)(A.ws() + WS_GU); const bf16* GW = (const bf16*)(A.ws() + WS_GW); const bf16* QD = (const bf16*)(A.ws() + WS_GQD);
    const bf16* KDT = (const bf16*)(A.ws() + WS_GKDT); const bf16* QKM = (const bf16*)(A.ws() + WS_GQKM); const float* GCB = (const float*)(A.ws() + WS_GCB);
    float* OG = (float*)(A.ws() + WS_OG);
    const int g = lane >> 4, c16 = lane & 15;
    for (int item = blockIdx.x; item < 256; item += G) {
        const int chain = item >> 3, sl = item & 7, b = chain >> 3, h = (chain >> 1) & 3, dir = chain & 1;
        for (int i = tid; i < 16 * 136; i += NTHR) ST[i] = 0;
        f32x4 accs[2] = {{0.f, 0.f, 0.f, 0.f}, {0.f, 0.f, 0.f, 0.f}};
        __syncthreads();
#pragma unroll 1
        for (int p = 0; p < 68; ++p) {
            int ci; if (p < 4) ci = 256 + b * 4 + (dir ? 3 - p : p); else { const int q = p - 4; ci = b * 64 + (dir ? 63 - q : q); }
            const int oi = (ci * 4 + h) * 2 + dir, m0 = gdn_m0(ci);
            f32x4 acc;
            if (wave < 4) {
                const bf16* up = GU + (size_t)oi * 8192 + (16 * wave + 4 * g) * 128 + 16 * sl + c16;
                acc = (f32x4){bf2f(up[0]), bf2f(up[128]), bf2f(up[256]), bf2f(up[384])};
                const bf16* wp = GW + (size_t)oi * 8192 + (16 * wave + c16) * 128 + 8 * g;
#pragma unroll
                for (int ks = 0; ks < 4; ++ks) acc = mma(*(const bf16x8*)(wp + 32 * ks), lds_frag(ST, 136, 0, 32 * ks, lane), acc);
                u32x2 w; w.x = pk2(acc[0], acc[1]); w.y = pk2(acc[2], acc[3]);
                *(LAS u32x2*)(VN + c16 * 72 + 16 * wave + 4 * g) = w;
            } else {
                const int wq = wave - 4; acc = (f32x4){0.f, 0.f, 0.f, 0.f};
                const bf16* qp = QD + (size_t)oi * 8192 + (16 * wq + c16) * 128 + 8 * g;
#pragma unroll
                for (int ks = 0; ks < 4; ++ks) acc = mma(*(const bf16x8*)(qp + 32 * ks), lds_frag(ST, 136, 0, 32 * ks, lane), acc);
            }
            __syncthreads();
            if (wave < 4) {
                const float al = __expf(GCB[(size_t)oi * 128 + 63]);
#pragma unroll
                for (int x = 0; x < 2; ++x) { const bf16* kp = KDT + (size_t)oi * 8192 + (32 * wave + 16 * x + c16) * 64 + 8 * g;
                    f32x4 s = accs[x] * al;
                    s = mma(*(const bf16x8*)kp, lds_frag(VN, 72, 0, 0, lane), s); s = mma(*(const bf16x8*)(kp + 32), lds_frag(VN, 72, 0, 32, lane), s);
                    accs[x] = s; }
            } else {
                const int wq = wave - 4; const bf16* pp = QKM + (size_t)oi * 4096 + (16 * wq + c16) * 64 + 8 * g;
                acc = mma(*(const bf16x8*)pp, lds_frag(VN, 72, 0, 0, lane), acc); acc = mma(*(const bf16x8*)(pp + 32), lds_frag(VN, 72, 0, 32, lane), acc);
#pragma unroll
                for (int r = 0; r < 4; ++r) { const int i = 16 * wq + 4 * g + r, t = dir ? 63 - i : i;
                    OG[((size_t)dir * NTOK + m0 + t) * 512 + h * 128 + 16 * sl + c16] = acc[r]; }
            }
            __syncthreads();
            if (wave < 4) {
#pragma unroll
                for (int x = 0; x < 2; ++x) { u32x2 w; w.x = pk2(accs[x][0], accs[x][1]); w.y = pk2(accs[x][2], accs[x][3]);
                    *(LAS u32x2*)(ST + c16 * 136 + 32 * wave + 16 * x + 4 * g) = w; } }
            __syncthreads();
        }
    }
}
__device__ __forceinline__ void ph_gdn_finish(const Ctx& A, int l, int lane, int wave, int G, int nrows) {
    const int gw = blockIdx.x * NWAVES + wave, NGW = G * NWAVES;
    const float* OG = (const float*)(A.ws() + WS_OG); const bf16* cols = (const bf16*)(A.ws() + WS_COLS); bf16* MIX = (bf16*)(A.ws() + WS_MIX);
    const float* ng = A.in(IGDNN) + l * 128 + (lane & 15) * 8;
    const f32x4 n0 = *(const f32x4*)ng, n1 = *(const f32x4*)(ng + 4);
    for (int m = gw; m < nrows; m += NGW) {
        const f32x4* pf = (const f32x4*)(OG + (size_t)m * 512 + 8 * lane); const f32x4* pb = (const f32x4*)(OG + ((size_t)NTOK + m) * 512 + 8 * lane);
        const f32x4 v0 = pf[0] + pb[0], v1 = pf[1] + pb[1];
        float ss = v0.x * v0.x + v0.y * v0.y + v0.z * v0.z + v0.w * v0.w + v1.x * v1.x + v1.y * v1.y + v1.z * v1.z + v1.w * v1.w;
        ss += __shfl_xor(ss, 1); ss += __shfl_xor(ss, 2); ss += __shfl_xor(ss, 4); ss += __shfl_xor(ss, 8);
        const float rs = rsqrtf(ss * (1.f / 128.f) + RMS_EPS);
        const u32x4 zw = *(const u32x4*)(cols + (size_t)m * DIN + C_GDN_Z + 8 * lane);
        float y[8];
        y[0] = v0.x * rs * n0.x * siluf_(bf2f(zw.x & 0xffffu)); y[1] = v0.y * rs * n0.y * siluf_(bf2f(zw.x >> 16));
        y[2] = v0.z * rs * n0.z * siluf_(bf2f(zw.y & 0xffffu)); y[3] = v0.w * rs * n0.w * siluf_(bf2f(zw.y >> 16));
        y[4] = v1.x * rs * n1.x * siluf_(bf2f(zw.z & 0xffffu)); y[5] = v1.y * rs * n1.y * siluf_(bf2f(zw.z >> 16));
        y[6] = v1.z * rs * n1.z * siluf_(bf2f(zw.w & 0xffffu)); y[7] = v1.w * rs * n1.w * siluf_(bf2f(zw.w >> 16));
        u32x4 o; o.x = pk2(y[0], y[1]); o.y = pk2(y[2], y[3]); o.z = pk2(y[4], y[5]); o.w = pk2(y[6], y[7]);
        *(u32x4*)(MIX + (size_t)m * D + 512 + 8 * lane) = o;
    }
}

constexpr int NPH = 13;
#ifndef MK_MULTI
#define MK_MULTI 1
#endif
#if MK_MULTI
#define NOLOOP 1
#endif
__global__ void __launch_bounds__(NTHR, 2) fwd(Args A) {
    extern __shared__ __attribute__((aligned(16))) unsigned char lds_raw[];
    LAS unsigned char* lds = (LAS unsigned char*)lds_raw;
    const int tid0 = threadIdx.x, G = gridDim.x;
    volatile LAS unsigned* misc = (volatile LAS unsigned*)(lds + MISC_OFF);
    if (tid0 < 64) misc[tid0] = 0u;
    __syncthreads();
    unsigned* ctl = (unsigned*)(A.ws + WS_CTL);
    XcdBarrier bar = xcd_barrier_post(ctl + CW_BAR, misc + 8);
    const bool fused = (A.ph_hi - A.ph_lo) > 1;
    const int vcu = (G % 8 == 0) ? ((int)(blockIdx.x % 8) * (G / 8) + (int)(blockIdx.x / 8)) : (int)blockIdx.x;
#ifndef PHMASK
#define PHMASK 0x1fff
#endif
#define IN(k) (((PHMASK >> (k)) & 1) && A.ph_lo <= (k) && (k) < A.ph_hi)
#define SEAM() do { if (fused) xcd_barrier(bar); } while (0)
#define PH_BEGIN() int tid = tid0; asm volatile("" : "+v"(tid)); int zz = 0; asm volatile("" : "+s"(zz)); const int lane = tid & 63, wave = __builtin_amdgcn_readfirstlane(tid >> 6); const Ctx C{&A, zz}; (void)lane; (void)wave
#ifdef NOLOOP
    { int l = A.l_lo;
#else
    for (int l = A.l_lo; l < A.l_hi; ++l) {
#endif
        const bool last = (l == DEPTH - 1);
        if (l == 0) {
            if (IN(0)) { PH_BEGIN(); ph_mods(C, lds, tid, G); ph_convert(C, lds, lane, wave, G); SEAM(); }
            if (IN(1)) { PH_BEGIN(); ph_init(C, lane, wave, G); SEAM(); }
        }
        if (IN(2)) { PH_BEGIN();
            pg8::Gemm g{(const bf16*)(C.ws() + WS_H), (const bf16*)(C.ws() + WS_WIN) + (size_t)l * DINP * D, NTOK, DINP, D};
            pg8::StaticOrder S; S.init(NTOK, DINP, G, (int)blockIdx.x);
            EpiCols E{(bf16*)(C.ws() + WS_COLS), (float*)(C.ws() + WS_GATES)};
            pg8::gemm_phase<EpiCols, pg8::StaticOrder>(lds, g, S, E, nullptr, tid);
            SEAM();
        }
        if (IN(3)) { PH_BEGIN();
            ph_gdn_conv(C, l, lane, wave, G);
            for (int u = blockIdx.x; u < 1024; u += G) na_unit<false>(C, l, lds, u, tid, lane, wave);
            if (!last) for (int u = blockIdx.x; u < 64; u += G) na_unit<true>(C, l, lds, u, tid, lane, wave);
            SEAM();
        }
        if (IN(4)) { PH_BEGIN();
            ph_gla_a(C, l, lds, lane, wave, G);
            __syncthreads();
            ph_gdn_prep(C, lds, tid, lane, wave, G);
            SEAM();
        }
        if (IN(5)) { PH_BEGIN();
            ph_gdn_scan(C, lds, tid, lane, wave, G);
            ph_gla_b(C, tid, G);
            SEAM();
        }
        if (IN(6)) { PH_BEGIN();
            ph_gla_c(C, l, lds, lane, wave, G, last ? 2048 : 2176);
            ph_gdn_finish(C, l, lane, wave, G, last ? NLAT : NTOK);
            SEAM();
        }
        const int nrows = last ? NLAT : NTOK;
        if (IN(7)) { PH_BEGIN();
            pg8::Gemm g{(const bf16*)(C.ws() + WS_MIX), (const bf16*)(C.ws() + WS_WOUT) + (size_t)l * D * D, nrows, D, D};
            pg8::StaticOrder S; S.init(nrows, D, G, (int)blockIdx.x);
            EpiOut E{(float*)(C.ws() + WS_X), (const float*)(C.ws() + WS_MODS) + (size_t)l * 5 * 6144};
            pg8::gemm_phase<EpiOut, pg8::StaticOrder>(lds, g, S, E, nullptr, tid);
            SEAM();
        }
        if (IN(8)) { PH_BEGIN(); ph_ln1_route(C, l, lds, tid, lane, wave, nrows); SEAM(); }
        if (IN(9)) { PH_BEGIN(); ph_gather(C, l, lds, tid, lane, wave, G, nrows); SEAM(); }
        if (IN(10)) { PH_BEGIN();
            LAS int* tab = (LAS int*)(lds + MISC_OFF + 1024);
            moe_tables((const unsigned*)(C.ws() + WS_CTL) + CW_CNT + l * 64, tab, tid);
            pg8::Gemm g{(const bf16*)(C.ws() + WS_XB), (const bf16*)(C.ws() + WS_WGU) + (size_t)l * NE * 2048 * D, 0, 0, D};
            MoeOrder S{tab + 64, tab[40] * 8, 8, G, vcu};
            EpiAct E{(bf16*)(C.ws() + WS_ACT), C.in(IBGU) + (size_t)l * NE * 2048};
            pg8::gemm_phase<EpiAct, MoeOrder>(lds, g, S, E, nullptr, tid);
            SEAM();
        }
        if (IN(11)) { PH_BEGIN();
            LAS int* tab = (LAS int*)(lds + MISC_OFF + 1024);
            moe_tables((const unsigned*)(C.ws() + WS_CTL) + CW_CNT + l * 64, tab, tid);
            pg8::Gemm g{(const bf16*)(C.ws() + WS_ACT), (const bf16*)(C.ws() + WS_WD) + (size_t)l * NE * D * D, 0, 0, D};
            MoeOrder S{tab + 64, tab[40] * 4, 4, G, vcu};
            EpiY E{(bf16*)(C.ws() + WS_YB), C.in(IBD) + (size_t)l * NE * D};
            pg8::gemm_phase<EpiY, MoeOrder>(lds, g, S, E, nullptr, tid);
            SEAM();
        }
        if (IN(12)) { PH_BEGIN(); ph_combine(C, l, lane, wave, G, nrows); if (!last) SEAM(); }
    }
#undef IN
#undef SEAM
}

extern "C" void kernel_launch(void* const* d_in, const int* in_sizes, int n_in, void* d_out, int out_size, void* d_ws, size_t ws_size, hipStream_t stream) {
    static int grid = 0;
    if (grid == 0) {
        if (n_in != NIN || out_size != NLAT * D || ws_size < WS_END) { fprintf(stderr, "kernel_launch: unexpected problem (n_in %d, out %d, ws %zu)\n", n_in, out_size, ws_size); grid = -1; return; }
        int dev = 0, cus = 0, per_cu = 0;
        if (hipGetDevice(&dev) != hipSuccess || hipDeviceGetAttribute(&cus, hipDeviceAttributeMultiprocessorCount, dev) != hipSuccess) { grid = -1; return; }
        if (hipFuncSetAttribute((const void*)fwd, hipFuncAttributeMaxDynamicSharedMemorySize, LDS_BYTES) != hipSuccess) { fprintf(stderr, "kernel_launch: hipFuncSetAttribute failed\n"); grid = -1; return; }
        if (hipOccupancyMaxActiveBlocksPerMultiprocessor(&per_cu, (const void*)fwd, NTHR, LDS_BYTES) != hipSuccess || per_cu < 1) fprintf(stderr, "kernel_launch: occupancy query says %d\n", per_cu);
        (void)hipGetLastError();
        grid = cus;
    }
    if (grid < 0) return;
    (void)hipMemsetAsync((char*)d_ws + WS_CTL, 0, CTL_BYTES, stream);
    Args a{};
    for (int i = 0; i < NIN; ++i) a.in[i] = (const float*)d_in[i];
    a.out = (float*)d_out; a.ws = (unsigned char*)d_ws;
#if MK_MULTI
    for (int l = 0; l < DEPTH; ++l)
        for (int ph = (l == 0 ? 0 : 2); ph < NPH; ++ph) { a.l_lo = l; a.l_hi = l + 1; a.ph_lo = ph; a.ph_hi = ph + 1;
            hipLaunchKernelGGL(fwd, dim3(grid), dim3(NTHR), LDS_BYTES, stream, a); }
#else
    a.l_lo = 0; a.l_hi = DEPTH; a.ph_lo = 0; a.ph_hi = NPH;
    hipLaunchKernelGGL(fwd, dim3(grid), dim3(NTHR), LDS_BYTES, stream, a);
#endif
}
```

```cpp
#include <hip/hip_runtime.h>
#include <cstdio>
#include <cstdint>

namespace pg8 {
#define PG8_LAS __attribute__((address_space(3)))
typedef unsigned short bf16_t;
typedef short bf16x8 __attribute__((ext_vector_type(8)));
typedef float f32x4 __attribute__((ext_vector_type(4)));
typedef unsigned u32x4 __attribute__((ext_vector_type(4)));
constexpr int BM = 256, BK = 64, HALF = 128, HTB = HALF * BK * 2  , STAGE_BYTES = 8 * HTB, NXCD = 8, WGM = 8;

__host__ __device__ __forceinline__ int lds_byte(int r, int c) { const int st = (r >> 4) * 2 + (c >> 5), rr = r & 15, cc = c & 31, ob = rr * 64 + cc * 2; return st * 1024 + (ob ^ (((ob >> 9) & 1) << 5)); }
__host__ __device__ __forceinline__ void stage_rc(int b, int& R, int& C) { const int st = b / 1024, sb = b % 1024, swz = sb ^ (((sb >> 9) & 1) << 5); R = (st >> 1) * 16 + swz / 64; C = (st & 1) * 32 + (swz % 64) / 2; }
__host__ __device__ __forceinline__ int perm32(int rho) { const int n = rho >> 4, i = rho & 15; return 8 * (i >> 2) + 4 * n + (i & 3); }

struct Unit { int pm, pn; };
struct Gemm { const bf16_t* A; const bf16_t* Bt; int M, N, K; };

struct StaticOrder {
    int nM, nN, nwg, G, c;
    __host__ __device__ void init(int M, int N, int G_, int c_) { nM = M / BM; nN = N / BM; nwg = nM * nN; G = G_; c = c_; }
    __host__ __device__ bool next(int i, Unit& u) const {
        const long L = (long)i * G + c; if (L >= nwg) return false;
        int wgid = (int)L; { const int q = nwg / NXCD, r = nwg % NXCD, xcd = wgid % NXCD, off = wgid / NXCD; wgid = (xcd < r ? xcd * (q + 1) : r * (q + 1) + (xcd - r) * q) + off; }
        const int nig = WGM * nN, gid = wgid / nig, fm = gid * WGM, gsz = (nM - fm) < WGM ? (nM - fm) : WGM;
        u.pm = fm + ((wgid % nig) % gsz); u.pn = (wgid % nig) / gsz; return true;
    }
    __device__ __forceinline__ void a_ready(const Unit&) const {}
    __device__ __forceinline__ void done(const Unit&) const {}
};
__device__ __forceinline__ unsigned cvt_pk_bf16(float lo, float hi) { unsigned r; asm volatile("v_cvt_pk_bf16_f32 %0, %1, %2" : "=v"(r) : "v"(lo), "v"(hi)); return r; }
template <class Epi, class Sched, bool GATHER = false, bool STAMP = false>
__device__ __forceinline__ void gemm_phase(PG8_LAS unsigned char* lds, const Gemm g, const Sched& S, const Epi& E, unsigned long long* stamps, const int tid) {
    const int wid = __builtin_amdgcn_readfirstlane(tid >> 6), lane = tid & 63, wr = wid >> 2, wc = wid & 3, fr = lane & 15, fq = lane >> 4;
    const int K = g.K, nt = K / BK;
    int ts_lo = 0, ts_hi = 0, nts = 0; const unsigned long long rt_entry = STAMP ? (unsigned long long)wall_clock64() : 0ull;
#define PG8_STAMP() do { if (STAMP && wid == 0 && nts < 64) { const unsigned long long _c = (unsigned long long)clock64(); \
        ts_lo = (lane == nts) ? (int)(unsigned)_c : ts_lo; ts_hi = (lane == nts) ? (int)(unsigned)(_c >> 32) : ts_hi; ++nts; } } while (0)
    PG8_STAMP();
    unsigned voffA[2], voffB[2]; int rowA[2];
#pragma unroll
    for (int i = 0; i < 2; ++i) { int R, C; stage_rc(tid * 16 + i * 8192, R, C); const int Rb = Epi::PERM ? ((R & ~31) + perm32(R & 31)) : R;
        voffA[i] = (unsigned)(R * K + C) * 2u; voffB[i] = (unsigned)(Rb * K + C) * 2u; rowA[i] = R; }
    unsigned vAc[2][2], vAn[2][2];
    const size_t kstep = (size_t)(BK * 2);
    const size_t hstep = (size_t)HALF * K * 2;
    const size_t tstep = 2 * hstep;
    const unsigned ldsw = (unsigned)wid * 1024u;
    const int aoff = lds_byte(wr * 64 + fr, fq * 8), boff = lds_byte(wc * 32 + fr, fq * 8);
#define PG8_SA(b, h) (((b) * 2 + (h)) * HTB)
#define PG8_SB(b, h) ((4 + (b) * 2 + (h)) * HTB)
#define PG8_STAGE(bufoff, gbase, voff) do { _Pragma("unroll") for (int _i = 0; _i < 2; ++_i) \
        __builtin_amdgcn_global_load_lds((const unsigned*)((const char*)(gbase) + (voff)[_i]), (PG8_LAS unsigned*)(lds + (bufoff) + ldsw + _i * 8192), 16, 0, 0); } while (0)
#define PG8_GOFF(dstv, u) do { _Pragma("unroll") for (int _h = 0; _h < 2; ++_h) _Pragma("unroll") for (int _i = 0; _i < 2; ++_i) \
        dstv[_h][_i] = (unsigned)S.a_row(u, _h * HALF + rowA[_i]) * (unsigned)(K * 2) + (voffA[_i] - (unsigned)(rowA[_i] * K * 2)); } while (0)
#define PG8_STAGE_A(bufoff, usenext, h, kb) do { if constexpr (GATHER) { const unsigned _o0 = (usenext) ? vAn[h][0] : vAc[h][0], _o1 = (usenext) ? vAn[h][1] : vAc[h][1]; const char* _gb = (const char*)g.A + (kb); \
        __builtin_amdgcn_global_load_lds((const unsigned*)(_gb + _o0), (PG8_LAS unsigned*)(lds + (bufoff) + ldsw), 16, 0, 0); \
        __builtin_amdgcn_global_load_lds((const unsigned*)(_gb + _o1), (PG8_LAS unsigned*)(lds + (bufoff) + ldsw + 8192), 16, 0, 0); } \
    else { const char* _gb = ((usenext) ? nA : cA) + (h) * hstep + (kb); PG8_STAGE(bufoff, _gb, voffA); } } while (0)
#define PG8_LDA(dst, b, h) do { _Pragma("unroll") for (int m = 0; m < 4; ++m) _Pragma("unroll") for (int k = 0; k < 2; ++k) dst[m][k] = *(const PG8_LAS bf16x8*)(lds + PG8_SA(b, h) + aoff + m * 2048 + k * 1024); } while (0)
#define PG8_LDB(dst, b, h) do { _Pragma("unroll") for (int n = 0; n < 2; ++n) _Pragma("unroll") for (int k = 0; k < 2; ++k) dst[n][k] = *(const PG8_LAS bf16x8*)(lds + PG8_SB(b, h) + boff + n * 2048 + k * 1024); } while (0)
#define PG8_MMA(ai, bj, At, Bt) do { __builtin_amdgcn_s_setprio(1); _Pragma("unroll") for (int m = 0; m < 4; ++m) _Pragma("unroll") for (int n = 0; n < 2; ++n) _Pragma("unroll") for (int k = 0; k < 2; ++k) \
        acc[ai][bj][m][n] = __builtin_amdgcn_mfma_f32_16x16x32_bf16(Bt[n][k], At[m][k], acc[ai][bj][m][n], 0, 0, 0); __builtin_amdgcn_s_setprio(0); } while (0)
#define PG8_WAIT_V(n) asm volatile("s_waitcnt vmcnt(" #n ")" ::: "memory")
#define PG8_WAIT_L(n) asm volatile("s_waitcnt lgkmcnt(" #n ")" ::: "memory")
#define PG8_BAR __builtin_amdgcn_s_barrier()
#define PG8_SCHED __builtin_amdgcn_sched_barrier(0)
    Unit cur, nxt; int ui = 0;
    if (!S.next(0, cur)) return;
    f32x4 acc[2][2][4][2];
#pragma unroll
    for (int a = 0; a < 2; ++a)
#pragma unroll
        for (int b = 0; b < 2; ++b)
#pragma unroll
            for (int m = 0; m < 4; ++m)
#pragma unroll
                for (int n = 0; n < 2; ++n) acc[a][b][m][n] = (f32x4){0.f, 0.f, 0.f, 0.f};
    bf16x8 At[4][2], B0[2][2], B1[2][2];
    const char* cA = (const char*)g.A + (size_t)cur.pm * tstep; const char* cB = (const char*)g.Bt + (size_t)cur.pn * tstep; const char* nA = cA;
    S.a_ready(cur);
    if constexpr (GATHER) { PG8_GOFF(vAc, cur); PG8_GOFF(vAn, cur); }
    PG8_STAGE(PG8_SB(0, 0), cB, voffB); PG8_STAGE_A(PG8_SA(0, 0), false, 0, (size_t)0); PG8_STAGE(PG8_SB(0, 1), cB + hstep, voffB); PG8_STAGE_A(PG8_SA(0, 1), false, 1, (size_t)0);
    if (wr == 1) PG8_BAR;
    PG8_WAIT_V(4); PG8_BAR;
    PG8_STAGE(PG8_SB(1, 0), cB + kstep, voffB); PG8_STAGE_A(PG8_SA(1, 0), false, 0, kstep); PG8_STAGE(PG8_SB(1, 1), cB + hstep + kstep, voffB);
    PG8_WAIT_V(6); PG8_BAR;
    PG8_STAMP();
    for (;;) {
        const bool has_next = S.next(ui + 1, nxt);
        nA = has_next ? (const char*)g.A + (size_t)nxt.pm * tstep : cA;
        if constexpr (GATHER) { if (has_next) PG8_GOFF(vAn, nxt); }
        const char* nB = has_next ? (const char*)g.Bt + (size_t)nxt.pn * tstep : cB;
        for (int t = 0; t < nt; t += 2) {
            const bool last = (t == nt - 2);
            const size_t k1 = (size_t)(t + 1) * kstep, k2 = last ? (size_t)0 : (size_t)(t + 2) * kstep;
            const char* b2 = last ? nB : cB + (size_t)(t + 2) * kstep; const char* b3 = b2 + kstep;
            if (last && has_next) S.a_ready(nxt);
            PG8_LDB(B0, 0, 0); PG8_SCHED; PG8_LDA(At, 0, 0); PG8_STAGE_A(PG8_SA(1, 1), false, 1, k1);
            PG8_WAIT_L(8); PG8_BAR; PG8_WAIT_L(0); PG8_MMA(0, 0, At, B0); PG8_BAR; PG8_SCHED;
            PG8_LDB(B1, 0, 1); PG8_STAGE(PG8_SB(0, 0), b2, voffB);
            PG8_BAR; PG8_WAIT_L(0); PG8_MMA(0, 1, At, B1); PG8_BAR;
            PG8_LDA(At, 0, 1); PG8_STAGE_A(PG8_SA(0, 0), last, 0, k2);
            PG8_BAR; PG8_WAIT_L(0); PG8_MMA(1, 0, At, B0); PG8_BAR; PG8_SCHED;
            PG8_STAGE(PG8_SB(0, 1), b2 + hstep, voffB);
            PG8_WAIT_V(6); PG8_BAR; PG8_MMA(1, 1, At, B1); PG8_BAR;
            PG8_LDB(B0, 1, 0); PG8_SCHED; PG8_LDA(At, 1, 0); PG8_STAGE_A(PG8_SA(0, 1), last, 1, k2);
            PG8_WAIT_L(8); PG8_BAR; PG8_WAIT_L(0); PG8_MMA(0, 0, At, B0); PG8_BAR; PG8_SCHED;
            PG8_LDB(B1, 1, 1); PG8_STAGE(PG8_SB(1, 0), b3, voffB);
            PG8_BAR; PG8_WAIT_L(0); PG8_MMA(0, 1, At, B1); PG8_BAR;
            PG8_LDA(At, 1, 1); PG8_STAGE_A(PG8_SA(1, 0), last, 0, k2 + kstep);
            PG8_BAR; PG8_WAIT_L(0); PG8_MMA(1, 0, At, B0); PG8_BAR; PG8_SCHED;
            PG8_STAGE(PG8_SB(1, 1), b3 + hstep, voffB);
            PG8_WAIT_V(6); PG8_BAR; PG8_MMA(1, 1, At, B1); PG8_BAR;
        }
        PG8_STAMP();
        if constexpr (!Epi::AFTER_DRAIN) { E(acc, cur, wr, wc, fr, fq); S.done(cur); }
        PG8_STAMP();
        if (!has_next) break;
#pragma unroll
        for (int a = 0; a < 2; ++a)
#pragma unroll
            for (int b = 0; b < 2; ++b)
#pragma unroll
                for (int m = 0; m < 4; ++m)
#pragma unroll
                    for (int n = 0; n < 2; ++n) acc[a][b][m][n] = (f32x4){0.f, 0.f, 0.f, 0.f};
        cur = nxt; cA = nA; cB = nB; ++ui;
        if constexpr (GATHER) { _Pragma("unroll") for (int _h = 0; _h < 2; ++_h) _Pragma("unroll") for (int _i = 0; _i < 2; ++_i) vAc[_h][_i] = vAn[_h][_i]; }
    }
    PG8_WAIT_V(0);
    if (wr == 0) PG8_BAR;
    PG8_BAR;
    if constexpr (Epi::AFTER_DRAIN) { E.fused(acc, cur, wr, wc, fr, fq, lds, wid, lane); S.done(cur); }
    PG8_STAMP();
    if (STAMP && wid == 0) { stamps[lane] = lane < nts ? (((unsigned long long)(unsigned)ts_hi << 32) | (unsigned)ts_lo) : 0ull;
        if (lane == 62) stamps[62] = rt_entry; if (lane == 63) stamps[63] = (unsigned long long)wall_clock64(); }
#undef PG8_STAMP
#undef PG8_SA
#undef PG8_SB
#undef PG8_STAGE
#undef PG8_GOFF
#undef PG8_STAGE_A
#undef PG8_LDA
#undef PG8_LDB
#undef PG8_MMA
#undef PG8_WAIT_V
#undef PG8_WAIT_L
#undef PG8_BAR
#undef PG8_SCHED
}
}
#define XB_TMO      128
#define XB_XCNT(j)  (256  + 64 * (j))
#define XB_XSUB(j)  (1280 + 64 * (j))
#define XB_XGEN(j)  (2304 + 64 * (j))
#define XB_TOP      3328
#define XB_TOPGEN   3392
#define XCD_BAR_WORDS 3456
#define XB_SPIN_CAP (1u << 18)
#define LAS __attribute__((address_space(3)))

__device__ __forceinline__ unsigned xb_ld(unsigned* p)              { return __hip_atomic_load(p, __ATOMIC_RELAXED, __HIP_MEMORY_SCOPE_AGENT); }
__device__ __forceinline__ unsigned xb_add(unsigned* p, unsigned v) { return __hip_atomic_fetch_add(p, v, __ATOMIC_RELAXED, __HIP_MEMORY_SCOPE_AGENT); }
__device__ __forceinline__ unsigned xb_xcc_id() { return (unsigned)__builtin_amdgcn_s_getreg((3 << 11) | 20) & 0xFu; }
#define XB_SPIN(cond, bar) do { unsigned _sp = 0; while (cond) { __builtin_amdgcn_s_sleep(1); \
    if ((++_sp & 255u) == 0u) { if (xb_ld(&(bar)[XB_TMO])) break; if (_sp > XB_SPIN_CAP) { atomicAdd(&(bar)[XB_TMO], 1u); break; } } } } while (0)

struct XcdBarrier {
    unsigned* bar; unsigned x;
    volatile LAS unsigned* st;
};

__device__ __forceinline__ XcdBarrier xcd_barrier_post(unsigned* bar, volatile LAS unsigned* st) {
    XcdBarrier b; b.bar = bar; b.x = xb_xcc_id(); b.st = st;
    if (threadIdx.x == 0) (void)xb_add(&bar[XB_XCNT(b.x)], 1u);
    return b;
}
__device__ __forceinline__ void xcd_barrier_complete(unsigned* bar, unsigned x, unsigned& nloc, unsigned& nx) {
    const unsigned G = gridDim.x * gridDim.y * gridDim.z;
    unsigned sum, cnt, mine, sp = 0u;
    for (;;) {
        sum = 0u; cnt = 0u; mine = 0u;
#pragma unroll
        for (unsigned j = 0; j < 16; ++j) { const unsigned c = xb_ld(&bar[XB_XCNT(j)]); sum += c; cnt += (c > 0u) ? 1u : 0u; mine = (j == x) ? c : mine; }
        if (sum == G) break;
        __builtin_amdgcn_s_sleep(1);
        if ((++sp & 255u) == 0u) { if (xb_ld(&bar[XB_TMO])) break; if (sp > XB_SPIN_CAP) { atomicAdd(&bar[XB_TMO], 1u); break; } }
    }
    nloc = mine > 0u ? mine : 1u; nx = cnt > 0u ? cnt : 1u;
}

__device__ __forceinline__ void xcd_barrier(const XcdBarrier& b) {
    asm volatile("s_waitcnt vmcnt(0)" ::: "memory");
    __syncthreads();
    if (threadIdx.x == 0) {
        unsigned* bar = b.bar;
        __builtin_amdgcn_s_waitcnt(0);
        unsigned nloc = b.st[0], nx = b.st[1];
        if (nloc == 0u) { xcd_barrier_complete(bar, b.x, nloc, nx); b.st[0] = nloc; b.st[1] = nx; }
        const unsigned old = xb_add(&bar[XB_XSUB(b.x)], 1u);
        const unsigned gen = old / nloc;
        if (old + 1u == (gen + 1u) * nloc) {
            __builtin_amdgcn_fence(__ATOMIC_RELEASE, "agent");
            asm volatile("s_waitcnt vmcnt(0)" ::: "memory");
            const unsigned og = xb_add(&bar[XB_TOP], 1u);
            const unsigned tg = og / nx;
            if (og + 1u == (tg + 1u) * nx) xb_add(&bar[XB_TOPGEN], 1u);
            else XB_SPIN(xb_ld(&bar[XB_TOPGEN]) == tg, bar);
            __builtin_amdgcn_fence(__ATOMIC_ACQUIRE, "agent");
            xb_add(&bar[XB_XGEN(b.x)], 1u);
            asm volatile("s_waitcnt vmcnt(0)" ::: "memory");
        } else {
            XB_SPIN(xb_ld(&bar[XB_XGEN(b.x)]) == gen, bar);
            __builtin_amdgcn_fence(__ATOMIC_ACQUIRE, "agent");
            asm volatile("s_waitcnt vmcnt(0)" ::: "memory");
        }
    }
    __syncthreads();
}


#define GAS __attribute__((address_space(1)))
typedef unsigned short bf16;
typedef short bf16x8 __attribute__((ext_vector_type(8)));
typedef float f32x4 __attribute__((ext_vector_type(4)));
typedef unsigned u32x4 __attribute__((ext_vector_type(4)));
typedef unsigned u32x2 __attribute__((ext_vector_type(2)));

constexpr int D = 1024, NB = 4, SEQ = 4096, CTXL = 256, DEPTH = 4;
constexpr int NLAT = NB * SEQ, NCTX = NB * CTXL, NTOK = NLAT + NCTX;
constexpr int DIN = 3632, DINP = 3840;
constexpr int C_GLA_Q = 0, C_GLA_K = 128, C_GLA_V = 256, C_GLA_A = 512, C_GLA_G = 544;
constexpr int C_NA_Q = 800, C_NA_K = 1056, C_NA_V = 1312;
constexpr int C_GDN_Q = 1568, C_GDN_K = 2080, C_GDN_V = 2592, C_GDN_B = 3104, C_GDN_A = 3112, C_GDN_Z = 3120;
constexpr int NE = 32, TOPK = 4, MAXRB = 304;
constexpr float DN_ALPHA = 1.681792830507429f;
constexpr float LN_EPS = 1e-5f, RMS_EPS = 1e-6f;
constexpr int NWAVES = 8, NTHR = 512;

enum { IX = 0, IC, ICTX, ICCTX, IWADA, IBADA, IWIN, IGLAW, IGLAB, IGLAN, IRPB, ICONV, IALOG, IDTB, IGDNN, IWOUT, ILN1G, ILN1B, IWR, IBR, IWGU, IBGU, IWD, IBD, ILN2G, ILN2B, NIN };

constexpr size_t MiB = 1u << 20;
constexpr size_t WS_CTL = 0, CTL_BYTES = 1 * MiB;
constexpr size_t WS_MODS = 1 * MiB;
constexpr size_t WS_WIN = 2 * MiB;
constexpr size_t WS_WOUT = 32 * MiB;
constexpr size_t WS_WGU = 40 * MiB;
constexpr size_t WS_WD = 552 * MiB;
constexpr size_t WS_X = 808 * MiB;
constexpr size_t WS_H = 876 * MiB;
constexpr size_t WS_COLS = 910 * MiB;
constexpr size_t WS_GATES = 1032 * MiB;
constexpr size_t WS_GQ = 1036 * MiB, WS_GK = 1053 * MiB, WS_GV = 1070 * MiB;
constexpr size_t WS_GG = 1087 * MiB, WS_GB = 1088 * MiB;
constexpr size_t WS_MIX = 1089 * MiB;
constexpr size_t WS_SD = 1123 * MiB;
constexpr size_t WS_SA = 1157 * MiB;
constexpr size_t WS_GU = 1158 * MiB, WS_GW = 1192 * MiB;
constexpr size_t WS_GKT = 1226 * MiB;
constexpr size_t WS_GQKM = 1294 * MiB;
constexpr size_t WS_GCB = 1311 * MiB;
constexpr size_t WS_OG = 1313 * MiB;
constexpr size_t WS_TOKE = 1381 * MiB, WS_TOKP = 1382 * MiB, WS_TOKG = 1383 * MiB, WS_TOKS = 1384 * MiB;
constexpr size_t WS_LG = 1385 * MiB;
constexpr size_t WS_TG = 1419 * MiB;
constexpr size_t WS_XB = 1436 * MiB;
constexpr size_t WS_ACT = 1588 * MiB;
constexpr size_t WS_YB = 1740 * MiB;
constexpr size_t WS_SS = 1892 * MiB;
constexpr size_t WS_OI = 1926 * MiB;
constexpr size_t WS_QTG = 1944 * MiB;
constexpr size_t WS_ROPE = 1953 * MiB;
constexpr size_t WS_WRT = 1953 * MiB + 65536;
constexpr size_t WS_ETOK = 1954 * MiB;
constexpr size_t WS_WRH = 1993 * MiB, WS_WRL = 1993 * MiB + 262144;
constexpr size_t WS_HL = 1959 * MiB;
constexpr size_t WS_DUMMY = 1957 * MiB;
constexpr size_t WS_END = 1994 * MiB;
constexpr int CW_BAR = 4096;
constexpr int CW_NAQ = 20480;
constexpr int CW_PQ = 24576;
constexpr int CW_CQ = 28672;
constexpr int CW_CNT = 16384;

constexpr int LDS_BYTES = 147456;
constexpr int MISC_OFF = 143360;

struct Args { const float* in[NIN]; float* out; unsigned char* ws; int l_lo, l_hi, ph_lo, ph_hi; };
struct Ctx { const Args* a; int z;
    __device__ __forceinline__ const float* in(int i) const { return a->in[i + z]; }
    __device__ __forceinline__ unsigned char* ws() const { return a->ws + z; }
    __device__ __forceinline__ float* out() const { return a->out + z; } };

__device__ __forceinline__ float bf2f(unsigned u) { return __uint_as_float(u << 16); }
typedef __bf16 bf16x2_t __attribute__((ext_vector_type(2)));
typedef float f32x2_t __attribute__((ext_vector_type(2)));
__device__ __forceinline__ unsigned f2bf(float f) { return (unsigned)__builtin_bit_cast(unsigned short, (__bf16)f); }
__device__ __forceinline__ unsigned pk2(float lo, float hi) { const f32x2_t f = {lo, hi}; return __builtin_bit_cast(unsigned, __builtin_convertvector(f, bf16x2_t)); }
template <int CTRL> __device__ __forceinline__ float dppf(float v) { return __int_as_float(__builtin_amdgcn_update_dpp(0, __float_as_int(v), CTRL, 0xF, 0xF, true)); }
__device__ __forceinline__ float row16_sum(float v) { v += dppf<0xB1>(v); v += dppf<0x4E>(v); v += dppf<0x141>(v); v += dppf<0x140>(v); return v; }
__device__ __forceinline__ float row16_max(float v) { v = fmaxf(v, dppf<0xB1>(v)); v = fmaxf(v, dppf<0x4E>(v)); v = fmaxf(v, dppf<0x141>(v)); v = fmaxf(v, dppf<0x140>(v)); return v; }
__device__ __forceinline__ float rows_sum(float v) { return __int_as_float(__builtin_amdgcn_readlane(__float_as_int(v), 0)) + __int_as_float(__builtin_amdgcn_readlane(__float_as_int(v), 16))
                                                          + __int_as_float(__builtin_amdgcn_readlane(__float_as_int(v), 32)) + __int_as_float(__builtin_amdgcn_readlane(__float_as_int(v), 48)); }
__device__ __forceinline__ float wsum(float v) { return rows_sum(row16_sum(v)); }
__device__ __forceinline__ float wmax(float v) { v = row16_max(v); return fmaxf(fmaxf(__int_as_float(__builtin_amdgcn_readlane(__float_as_int(v), 0)), __int_as_float(__builtin_amdgcn_readlane(__float_as_int(v), 16))),
                                                                                   fmaxf(__int_as_float(__builtin_amdgcn_readlane(__float_as_int(v), 32)), __int_as_float(__builtin_amdgcn_readlane(__float_as_int(v), 48)))); }
__device__ __forceinline__ float sigmoidf_(float x) { return __builtin_amdgcn_rcpf(1.f + __expf(-x)); }
__device__ __forceinline__ float siluf_(float x) { return x * __builtin_amdgcn_rcpf(1.f + __expf(-x)); }
__device__ __forceinline__ float softplusf_(float x) { return fmaxf(x, 0.f) + log1pf(__expf(-fabsf(x))); }
__device__ __forceinline__ float logsigmoidf_(float x) { return fminf(x, 0.f) - log1pf(__expf(-fabsf(x))); }
#define WAVE_SYNC() do { asm volatile("s_waitcnt lgkmcnt(0)" ::: "memory"); __builtin_amdgcn_wave_barrier(); } while (0)
#define BLOCK_SYNC() do { __threadfence_block(); __syncthreads(); } while (0)
#define LBAR() do { asm volatile("s_waitcnt lgkmcnt(0)" ::: "memory"); __builtin_amdgcn_s_barrier(); asm volatile("" ::: "memory"); } while (0)

__device__ __forceinline__ bf16x8 lds_frag(const LAS bf16* base, int stride, int row0, int k0, int lane) {
    return *(const LAS bf16x8*)(base + (row0 + (lane & 15)) * stride + k0 + 8 * (lane >> 4));
}
__device__ __forceinline__ f32x4 mma(bf16x8 a, bf16x8 b, f32x4 c) { return __builtin_amdgcn_mfma_f32_16x16x32_bf16(a, b, c, 0, 0, 0); }

__device__ __forceinline__ int mod_row(int m) { return m < NLAT ? (m >> 12) : 4; }

__device__ __forceinline__ void row_ln(f32x4 (&v)[4]) {
    float s = 0.f;
#pragma unroll
    for (int j = 0; j < 4; ++j) s += (v[j].x + v[j].y) + (v[j].z + v[j].w);
    const float mean = wsum(s) * (1.f / D);
    float s2 = 0.f;
#pragma unroll
    for (int j = 0; j < 4; ++j) { v[j] = v[j] - mean; s2 += (v[j].x * v[j].x + v[j].y * v[j].y) + (v[j].z * v[j].z + v[j].w * v[j].w); }
    const float rstd = rsqrtf(wsum(s2) * (1.f / D) + LN_EPS);
#pragma unroll
    for (int j = 0; j < 4; ++j) v[j] = v[j] * rstd;
}
__device__ __forceinline__ void row_store_bf16(bf16* row, const f32x4 (&v)[4], int lane) {
    u32x2* o = (u32x2*)row + lane;
#pragma unroll
    for (int j = 0; j < 4; ++j) { u32x2 w; w.x = pk2(v[j].x, v[j].y); w.y = pk2(v[j].z, v[j].w); o[64 * j] = w; }
}

__device__ __forceinline__ void ph_mods(const Ctx& A, LAS unsigned char* lds, int tid, int G) {
    LAS float* sc = (LAS float*)lds;
    LAS float* red = (LAS float*)(lds + 20480);
    const float* c = A.in(IC); const float* cc = A.in(ICCTX);
    for (int i = tid; i < 5 * D; i += NTHR) { const int r = i >> 10, k = i & 1023; const float v = r < 4 ? c[r * D + k] : cc[k]; sc[i] = siluf_(v); }
    __syncthreads();
    float* mods = (float*)(A.ws() + WS_MODS);
    if (blockIdx.x == 0) { float* rope = (float*)(A.ws() + WS_ROPE); const int pos = tid >> 3, j = tid & 7; float sn, cs;
        sincosf((float)pos * expf(-(float)j * 1.1512925464970229f), &sn, &cs); rope[tid * 2] = cs; rope[tid * 2 + 1] = sn; }
    { bf16* wrh = (bf16*)(A.ws() + WS_WRH); bf16* wrl = (bf16*)(A.ws() + WS_WRL);
      for (int i = blockIdx.x * NTHR + tid; i < DEPTH * D * NE; i += G * NTHR) { const int ll = i >> 15, e = (i >> 10) & 31, k = i & 1023; const float w = A.in(IWR)[((size_t)ll * D + k) * NE + e];
          const unsigned hi = f2bf(w); wrh[i] = (bf16)hi; wrl[i] = (bf16)f2bf(w - bf2f(hi)); } }
    const int col = tid & 63, kg = tid >> 6;
    for (int item = blockIdx.x; item < DEPTH * 96; item += G) {
        const int l = item / 96, n0 = (item % 96) * 64;
        const float* w = A.in(IWADA) + ((size_t)l * D + kg * 128) * 6144 + n0 + col;
        float a0 = 0.f, a1 = 0.f, a2 = 0.f, a3 = 0.f, a4 = 0.f;
#pragma unroll 32
        for (int k = 0; k < 128; ++k) { const float wv = __builtin_nontemporal_load(w + (size_t)k * 6144); const int kk = kg * 128 + k;
            a0 += sc[kk] * wv; a1 += sc[D + kk] * wv; a2 += sc[2 * D + kk] * wv; a3 += sc[3 * D + kk] * wv; a4 += sc[4 * D + kk] * wv; }
        red[(kg * 5 + 0) * 64 + col] = a0; red[(kg * 5 + 1) * 64 + col] = a1; red[(kg * 5 + 2) * 64 + col] = a2; red[(kg * 5 + 3) * 64 + col] = a3; red[(kg * 5 + 4) * 64 + col] = a4;
        __syncthreads();
        if (tid < 320) { const int r = tid >> 6, cl = tid & 63; float s = 0.f;
#pragma unroll
            for (int g = 0; g < 8; ++g) s += red[(g * 5 + r) * 64 + cl];
            mods[((size_t)l * 5 + r) * 6144 + n0 + cl] = s + A.in(IBADA)[l * 6144 + n0 + cl]; }
        __syncthreads();
    }
}

constexpr int CV_IN = 16 * 60, CV_OUT = 16 * 16, CV_GU = NE * 16 * 32, CV_D = NE * 16 * 16, CV_ITEMS = CV_IN + CV_OUT + CV_GU + CV_D, CV_TICKETS = CV_ITEMS / 8;
struct CvtJob { const float* wp; bf16* dst; int N; bool ok; };
__device__ __forceinline__ CvtJob cvt_decode(const Ctx& A, int l, int r, int lane) {
    const float* W; int N, k0, src0; bf16* dst;
    if (r < CV_IN) { const int nb = r % 60, kb = r / 60; W = A.in(IWIN) + (size_t)l * D * DIN; N = DIN; k0 = kb * 64; src0 = nb * 64; dst = (bf16*)(A.ws() + WS_WIN) + ((size_t)l * DINP + nb * 64) * D; }
    else if (r < CV_IN + CV_OUT) { r -= CV_IN; const int nb = r % 16, kb = r / 16; W = A.in(IWOUT) + (size_t)l * D * D; N = D; k0 = kb * 64; src0 = nb * 64; dst = (bf16*)(A.ws() + WS_WOUT) + ((size_t)l * D + nb * 64) * D; }
    else if (r < CV_IN + CV_OUT + CV_GU) { r -= CV_IN + CV_OUT; const int nb = r % 32, kb = (r / 32) % 16, le = l * NE + r / 512; const int j = nb >> 2, q = nb & 3;
        W = A.in(IWGU) + (size_t)le * D * 2048; N = 2048; k0 = kb * 64; src0 = (q < 2) ? (128 * j + 64 * q) : (1024 + 128 * j + 64 * (q - 2)); dst = (bf16*)(A.ws() + WS_WGU) + ((size_t)le * 2048 + nb * 64) * D; }
    else { r -= CV_IN + CV_OUT + CV_GU; const int nb = r % 16, kb = (r / 16) % 16, le = l * NE + r / 256; W = A.in(IWD) + (size_t)le * D * D; N = D; k0 = kb * 64; src0 = nb * 64; dst = (bf16*)(A.ws() + WS_WD) + ((size_t)le * D + nb * 64) * D; }
    CvtJob j; j.ok = (src0 + lane) < N; j.N = N; j.dst = dst + k0;
    j.wp = W + (size_t)k0 * N + (j.ok ? src0 + lane : 0);
    return j;
}
__device__ __forceinline__ void cvt_drain(const Ctx& A, LAS unsigned char* lds, int l, int t0, int nt, unsigned* ctr, int tid, int lane, int wave) {
    LAS int* wq = (LAS int*)(lds + MISC_OFF + 512); LAS float* scr = (LAS float*)(lds + wave * 16640);
    __syncthreads(); if (tid == 0) { const int f = (int)atomicAdd(ctr, 2u); wq[0] = f; wq[1] = f + 1; } __syncthreads();
    int cur = __builtin_amdgcn_readfirstlane(wq[0]), nxt = __builtin_amdgcn_readfirstlane(wq[1]);
    int zv = 0; asm volatile("" : "+v"(zv)); unsigned* ctrv = ctr + zv;
    float v[64]; CvtJob jc = cvt_decode(A, l, (t0 + min(cur, nt - 1)) * 8 + wave, lane);
    if (cur < nt) {
#pragma unroll
        for (int kk = 0; kk < 64; ++kk) v[kk] = jc.wp[(size_t)kk * jc.N]; }
    while (cur < nt) {
        int nn = 0; if (tid == 0) nn = (int)atomicAdd(ctrv, 1u);
#pragma unroll
        for (int kk = 0; kk < 64; ++kk) scr[kk * 65 + lane] = jc.ok ? v[kk] : 0.f;
        bf16* dst = jc.dst;
        if (nxt < nt) { jc = cvt_decode(A, l, (t0 + nxt) * 8 + wave, lane);
#pragma unroll
            for (int kk = 0; kk < 64; ++kk) v[kk] = jc.wp[(size_t)kk * jc.N]; }
        WAVE_SYNC();
        const int c = lane & 7;
#pragma unroll
        for (int j = 0; j < 8; ++j) { const int n = (lane >> 3) + 8 * j; const LAS float* sp = scr + (8 * c) * 65 + n;
            u32x4 o; o.x = pk2(sp[0], sp[65]); o.y = pk2(sp[2 * 65], sp[3 * 65]); o.z = pk2(sp[4 * 65], sp[5 * 65]); o.w = pk2(sp[6 * 65], sp[7 * 65]);
            *(u32x4*)(dst + (size_t)n * D + 8 * c) = o; }
        WAVE_SYNC();
        LBAR(); if (tid == 0) wq[0] = nn; LBAR();
        cur = nxt; nxt = __builtin_amdgcn_readfirstlane(wq[0]);
    }
    __syncthreads();
}

__device__ __forceinline__ void ph_init(const Ctx& A, int lane, int wave, int G) {
    const int gw = blockIdx.x * NWAVES + wave, NGW = G * NWAVES;
    float* X = (float*)(A.ws() + WS_X); bf16* H = (bf16*)(A.ws() + WS_H); const float* mods = (const float*)(A.ws() + WS_MODS);
    for (int m = gw; m < NTOK; m += NGW) {
        const float* src = m < NLAT ? A.in(IX) + (size_t)m * D : A.in(ICTX) + (size_t)(m - NLAT) * D;
        const f32x4* xr = (const f32x4*)src + lane; f32x4* xo = (f32x4*)(X + (size_t)m * D) + lane;
        f32x4 v[4];
#pragma unroll
        for (int j = 0; j < 4; ++j) { v[j] = xr[64 * j]; xo[64 * j] = v[j]; }
        row_ln(v);
        const float* md = mods + (size_t)(0 * 5 + mod_row(m)) * 6144;
#pragma unroll
        for (int j = 0; j < 4; ++j) { const f32x4 sh = ((const f32x4*)md)[lane + 64 * j], scl = ((const f32x4*)(md + D))[lane + 64 * j]; v[j] = v[j] * (scl + 1.f) + sh; }
        row_store_bf16(H + (size_t)m * D, v, lane);
    }
}

struct EpiCols {
    static constexpr bool PERM = true, AFTER_DRAIN = false;
    bf16* C; float* gates;
    __device__ __forceinline__ void operator()(const f32x4 (&acc)[2][2][4][2], const pg8::Unit& u, int wr, int wc, int fr, int fq) const {
        const int row0 = u.pm * 256 + wr * 64 + fr, colb = u.pn * 256 + wc * 32 + 8 * fq;
#pragma unroll
        for (int ai = 0; ai < 2; ++ai)
#pragma unroll
            for (int m = 0; m < 4; ++m) { const int row = row0 + ai * 128 + m * 16;
#pragma unroll
                for (int bj = 0; bj < 2; ++bj) { const int col = colb + bj * 128; const f32x4 v0 = acc[ai][bj][m][0], v1 = acc[ai][bj][m][1];
                    if (col < DIN) { u32x4 w; w.x = pk2(v0[0], v0[1]); w.y = pk2(v0[2], v0[3]); w.z = pk2(v1[0], v1[1]); w.w = pk2(v1[2], v1[3]);
                        *(u32x4*)(C + (size_t)row * DIN + col) = w; }
                    int gc = -1;
                    if (col >= C_GLA_A && col < C_GLA_A + 32) gc = col - C_GLA_A; else if (col >= C_GDN_B && col < C_GDN_B + 16) gc = 32 + col - C_GDN_B;
                    if (gc >= 0) { float* gp = gates + (size_t)row * 48 + gc; *(f32x4*)gp = v0; *(f32x4*)(gp + 4) = v1; } } }
    }
};
struct EpiOut {
    static constexpr bool PERM = false, AFTER_DRAIN = false;
    float* X; const float* mods;
    __device__ __forceinline__ void operator()(const f32x4 (&acc)[2][2][4][2], const pg8::Unit& u, int wr, int wc, int fr, int fq) const {
        const int row0 = u.pm * 256 + wr * 64 + fr, col0 = u.pn * 256 + wc * 32 + 4 * fq;
#pragma unroll
        for (int ai = 0; ai < 2; ++ai)
#pragma unroll
            for (int m = 0; m < 4; ++m) { const int row = row0 + ai * 128 + m * 16; float* xr = X + (size_t)row * D + col0; const float* g = mods + (size_t)mod_row(row) * 6144 + 2 * D + col0;
#pragma unroll
                for (int bj = 0; bj < 2; ++bj)
#pragma unroll
                    for (int n = 0; n < 2; ++n) { const int o = bj * 128 + n * 16; const f32x4 xv = *(const f32x4*)(xr + o), gv = *(const f32x4*)(g + o);
                        *(f32x4*)(xr + o) = xv * DN_ALPHA + gv * acc[ai][bj][m][n]; } }
    }
};
__device__ __forceinline__ f32x4 act4(const f32x4 g, const f32x4 u) {
    const f32x4 lim = {7.f, 7.f, 7.f, 7.f};
    const f32x4 gt = __builtin_elementwise_min(g, lim), up = __builtin_elementwise_min(__builtin_elementwise_max(u, -lim), lim);
    const f32x4 t = gt * (-1.702f * 1.4426950408889634f);
    const f32x4 d = (f32x4){__builtin_amdgcn_exp2f(t[0]), __builtin_amdgcn_exp2f(t[1]), __builtin_amdgcn_exp2f(t[2]), __builtin_amdgcn_exp2f(t[3])} + 1.f;
    const f32x4 r = {__builtin_amdgcn_rcpf(d[0]), __builtin_amdgcn_rcpf(d[1]), __builtin_amdgcn_rcpf(d[2]), __builtin_amdgcn_rcpf(d[3])};
    return (up * gt + gt) * r;
}
struct EpiAct {
    static constexpr bool PERM = true, AFTER_DRAIN = false;
    bf16* O; const float* bias;
    __device__ __forceinline__ void operator()(const f32x4 (&acc)[2][2][4][2], const pg8::Unit& u, int wr, int wc, int fr, int fq) const {
        const int e = u.pn >> 3, j = u.pn & 7;
        const int row0 = u.pm * 256 + wr * 64 + fr, col = j * 128 + wc * 32 + 8 * fq;
        const float* bg = bias + (size_t)e * 2048 + col; const float* bu = bg + 1024;
        const f32x4 bg0 = *(const f32x4*)bg, bg1 = *(const f32x4*)(bg + 4), bu0 = *(const f32x4*)bu, bu1 = *(const f32x4*)(bu + 4);
#pragma unroll
        for (int ai = 0; ai < 2; ++ai)
#pragma unroll
            for (int m = 0; m < 4; ++m) { const int row = row0 + ai * 128 + m * 16;
                const f32x4 a0 = act4(acc[ai][0][m][0] + bg0, acc[ai][1][m][0] + bu0), a1 = act4(acc[ai][0][m][1] + bg1, acc[ai][1][m][1] + bu1);
                u32x4 w; w.x = pk2(a0[0], a0[1]); w.y = pk2(a0[2], a0[3]); w.z = pk2(a1[0], a1[1]); w.w = pk2(a1[2], a1[3]);
                *(u32x4*)(O + (size_t)row * D + col) = w; }
    }
};
struct EpiY {
    static constexpr bool PERM = true, AFTER_DRAIN = false;
    bf16* O; const float* bias;
    __device__ __forceinline__ void operator()(const f32x4 (&acc)[2][2][4][2], const pg8::Unit& u, int wr, int wc, int fr, int fq) const {
        const int e = u.pn >> 2, j = u.pn & 3;
        const int row0 = u.pm * 256 + wr * 64 + fr, colb = j * 256 + wc * 32 + 8 * fq;
#pragma unroll
        for (int bj = 0; bj < 2; ++bj) { const int col = colb + bj * 128; const float* b = bias + (size_t)e * D + col; const f32x4 b0 = *(const f32x4*)b, b1 = *(const f32x4*)(b + 4);
#pragma unroll
            for (int ai = 0; ai < 2; ++ai)
#pragma unroll
                for (int m = 0; m < 4; ++m) { const int row = row0 + ai * 128 + m * 16; const f32x4 v0 = acc[ai][bj][m][0] + b0, v1 = acc[ai][bj][m][1] + b1;
                    u32x4 w; w.x = pk2(v0[0], v0[1]); w.y = pk2(v0[2], v0[3]); w.z = pk2(v1[0], v1[1]); w.w = pk2(v1[2], v1[3]);
                    *(u32x4*)(O + (size_t)row * D + col) = w; } }
    }
};
struct MoeOrder {
    const LAS int* blk_e; int n_units, NT, G, c; const LAS int* tab; const int* etok;
    __device__ __forceinline__ bool next(int i, pg8::Unit& u) const {
        const int L = i * G + c; if (L >= n_units) return false;
        const int rb = L / NT, j = L - rb * NT; u.pm = rb; u.pn = __builtin_amdgcn_readfirstlane(blk_e[rb]) * NT + j; return true;
    }
    __device__ __forceinline__ int a_row(const pg8::Unit& u, int r) const {
        const int e = __builtin_amdgcn_readfirstlane(blk_e[u.pm]), base = u.pm * 256 - __builtin_amdgcn_readfirstlane(tab[e]), cnt = __builtin_amdgcn_readfirstlane(tab[400 + e]);
        const int idx = base + r; return idx < cnt ? etok[(size_t)e * NTOK + idx] : 0; }
    __device__ __forceinline__ void a_ready(const pg8::Unit&) const {}
    __device__ __forceinline__ void done(const pg8::Unit&) const {}
};
__device__ __forceinline__ void moe_tables(const unsigned* cnt, LAS int* tab, int tid) {
    if (tid < 64) {
        const int c = tid < NE ? (int)__hip_atomic_load(cnt + tid, __ATOMIC_RELAXED, __HIP_MEMORY_SCOPE_AGENT) : 0; const int nb = (c + 255) >> 8; int incl = nb;
#pragma unroll
        for (int o = 1; o < 32; o <<= 1) { const int t = __shfl_up(incl, o); if ((tid & 63) >= o) incl += t; }
        const int excl = incl - nb;
        if (tid < NE) { tab[tid] = excl * 256; tab[400 + tid] = c; for (int q = 0; q < nb; ++q) tab[64 + excl + q] = tid; }
        if (tid == NE - 1) { tab[32] = incl * 256; tab[40] = incl; } }
    __syncthreads();
}

__device__ __forceinline__ void wsum2(float& a, float& b) { a = wsum(a); b = wsum(b); }
__device__ __forceinline__ void row_ln1p(f32x4 (&v)[4]) {
    float s = 0.f, s2 = 0.f;
#pragma unroll
    for (int j = 0; j < 4; ++j) { s += (v[j].x + v[j].y) + (v[j].z + v[j].w); s2 += (v[j].x * v[j].x + v[j].y * v[j].y) + (v[j].z * v[j].z + v[j].w * v[j].w); }
    wsum2(s, s2);
    const float mean = s * (1.f / D), rstd = rsqrtf(fmaxf(s2 * (1.f / D) - mean * mean, 0.f) + LN_EPS);
#pragma unroll
    for (int j = 0; j < 4; ++j) v[j] = (v[j] - mean) * rstd;
}
__device__ __forceinline__ void ph_ln1_route(const Ctx& A, int l, LAS unsigned char* lds, int tid, int lane, int wave, int nrows_total) {
    LAS bf16* WH = (LAS bf16*)lds; LAS bf16* WL = (LAS bf16*)(lds + 66048); LAS float* LGT = (LAS float*)(lds + 132096); LAS int* msc = (LAS int*)(lds + MISC_OFF + 1024);
    { const u32x4* srch = (const u32x4*)((const bf16*)(A.ws() + WS_WRH) + (size_t)l * D * NE); const u32x4* srcl = (const u32x4*)((const bf16*)(A.ws() + WS_WRL) + (size_t)l * D * NE);
      for (int i = tid; i < D * NE / 8; i += NTHR) { const int e = i >> 7, part = i & 127; *(LAS u32x4*)(WH + e * 1032 + part * 8) = srch[i]; *(LAS u32x4*)(WL + e * 1032 + part * 8) = srcl[i]; } }
    if (tid < 64) msc[tid] = 0;
    const int RPB = nrows_total / (int)gridDim.x;
    const int rbase = blockIdx.x * RPB;
    float* X = (float*)(A.ws() + WS_X); bf16* H = (bf16*)(A.ws() + WS_H); bf16* HL = (bf16*)(A.ws() + WS_HL); const float* mods = (const float*)(A.ws() + WS_MODS) + (size_t)l * 5 * 6144;
    const float* g1 = A.in(ILN1G) + l * D; const float* b1 = A.in(ILN1B) + l * D;
    f32x4 nv[4], nw[4];
    { const f32x4* xr = (const f32x4*)(X + (size_t)(rbase + wave) * D) + lane; const f32x4* xs = (const f32x4*)(X + (size_t)(rbase + min(wave + NWAVES, RPB - 1)) * D) + lane;
#pragma unroll
      for (int j = 0; j < 4; ++j) { nv[j] = xr[64 * j]; nw[j] = xs[64 * j]; } }
    for (int rl = wave; rl < RPB; rl += NWAVES) {
        const int m = rbase + rl;
        f32x4 v[4];
#pragma unroll
        for (int j = 0; j < 4; ++j) { v[j] = nv[j]; nv[j] = nw[j]; }
        if (rl + 2 * NWAVES < RPB) { const f32x4* xn = (const f32x4*)(X + (size_t)(m + 2 * NWAVES) * D) + lane;
#pragma unroll
            for (int j = 0; j < 4; ++j) nw[j] = xn[64 * j]; }
        row_ln1p(v);
#pragma unroll
        for (int j = 0; j < 4; ++j) v[j] = v[j] * ((const f32x4*)g1)[lane + 64 * j] + ((const f32x4*)b1)[lane + 64 * j];
        row_ln1p(v);
        const float* md = mods + (size_t)mod_row(m) * 6144;
        u32x2* oh = (u32x2*)(H + (size_t)m * D) + lane; u32x2* ol = (u32x2*)(HL + (size_t)m * D) + lane;
#pragma unroll
        for (int j = 0; j < 4; ++j) { const f32x4 sh = ((const f32x4*)(md + 3 * D))[lane + 64 * j], scl = ((const f32x4*)(md + 4 * D))[lane + 64 * j]; const f32x4 hv = v[j] * (scl + 1.f) + sh;
            u32x2 wh; wh.x = pk2(hv.x, hv.y); wh.y = pk2(hv.z, hv.w); oh[64 * j] = wh;
            u32x2 wl; wl.x = pk2(hv.x - bf2f(wh.x & 0xffffu), hv.y - bf2f(wh.x >> 16)); wl.y = pk2(hv.z - bf2f(wh.y & 0xffffu), hv.w - bf2f(wh.y >> 16)); ol[64 * j] = wl; }
    }
    BLOCK_SYNC();
    if (wave * 16 < RPB) { const int g = lane >> 4, c16 = lane & 15; const int row = rbase + min(wave * 16 + c16, RPB - 1);
        const bf16* ph = H + (size_t)row * D + 8 * g; const bf16* pl = HL + (size_t)row * D + 8 * g;
        f32x4 acc0 = {0.f, 0.f, 0.f, 0.f}, acc1 = {0.f, 0.f, 0.f, 0.f};
#pragma unroll 1
        for (int kb = 0; kb < 4; ++kb) { bf16x8 ah[8], al[8];
#pragma unroll
            for (int k8 = 0; k8 < 8; ++k8) { ah[k8] = *(const bf16x8*)(ph + 32 * (8 * kb + k8)); al[k8] = *(const bf16x8*)(pl + 32 * (8 * kb + k8)); }
#pragma unroll
            for (int k8 = 0; k8 < 8; ++k8) { const int k0 = 32 * (8 * kb + k8);
                const bf16x8 h0 = lds_frag(WH, 1032, 0, k0, lane), h1 = lds_frag(WH, 1032, 16, k0, lane), l0 = lds_frag(WL, 1032, 0, k0, lane), l1 = lds_frag(WL, 1032, 16, k0, lane);
                acc0 = mma(ah[k8], h0, acc0); acc0 = mma(ah[k8], l0, acc0); acc0 = mma(al[k8], h0, acc0);
                acc1 = mma(ah[k8], h1, acc1); acc1 = mma(ah[k8], l1, acc1); acc1 = mma(al[k8], h1, acc1); } }
        const float bi0 = A.in(IBR)[l * NE + c16], bi1 = A.in(IBR)[l * NE + 16 + c16];
#pragma unroll
        for (int r = 0; r < 4; ++r) { LGT[(wave * 16 + 4 * g + r) * 32 + c16] = acc0[r] + bi0; LGT[(wave * 16 + 4 * g + r) * 32 + 16 + c16] = acc1[r] + bi1; } }
    __syncthreads();
    if (tid < RPB) { const int rl = tid, m = rbase + rl; float lg[NE];
#pragma unroll
        for (int q = 0; q < 8; ++q) { const f32x4 t4 = *(const LAS f32x4*)(LGT + rl * 32 + 4 * q); lg[4 * q] = t4.x; lg[4 * q + 1] = t4.y; lg[4 * q + 2] = t4.z; lg[4 * q + 3] = t4.w; }
        float tv[4]; int te[4];
#pragma unroll
        for (int k = 0; k < 4; ++k) { float mx = -INFINITY; int mi = 0;
#pragma unroll
            for (int e = 0; e < NE; ++e) { const bool gt = lg[e] > mx; mx = gt ? lg[e] : mx; mi = gt ? e : mi; }
            tv[k] = mx; te[k] = mi;
#pragma unroll
            for (int e = 0; e < NE; ++e) lg[e] = (e == mi) ? -INFINITY : lg[e]; }
        const float e1 = __expf(tv[1] - tv[0]), e2 = __expf(tv[2] - tv[0]), e3 = __expf(tv[3] - tv[0]); const float inv = 1.f / (1.f + e1 + e2 + e3);
        *(f32x4*)((float*)(A.ws() + WS_TOKG) + (size_t)m * 4) = (f32x4){inv, e1 * inv, e2 * inv, e3 * inv};
#pragma unroll
        for (int k = 0; k < 4; ++k) { const int pos = atomicAdd((int*)(msc + te[k]), 1); msc[64 + rl * 4 + k] = te[k] | (pos << 8); }
    }
    __syncthreads();
    unsigned* gcnt = (unsigned*)(A.ws() + WS_CTL) + CW_CNT + l * 64;
    if (tid < NE) msc[32 + tid] = (int)atomicAdd(gcnt + tid, (unsigned)msc[tid]);
    __syncthreads();
    int* toke = (int*)(A.ws() + WS_TOKE); int* tokp = (int*)(A.ws() + WS_TOKP); int* etok = (int*)(A.ws() + WS_ETOK);
    for (int i = tid; i < RPB * 4; i += NTHR) { const int s = msc[64 + i], e = s & 255, idx = msc[32 + e] + (s >> 8);
        toke[(size_t)rbase * 4 + i] = e; tokp[(size_t)rbase * 4 + i] = idx; etok[(size_t)e * NTOK + idx] = rbase + (i >> 2); }
    __syncthreads();
}

__device__ __forceinline__ void ph_combine(const Ctx& A, int l, LAS unsigned char* lds, int tid, int lane, int wave, int G, int nrows_total) {
    LAS int* tab = (LAS int*)(lds + MISC_OFF + 1024);
    moe_tables((const unsigned*)(A.ws() + WS_CTL) + CW_CNT + l * 64, tab, tid);
    const int gw = blockIdx.x * NWAVES + wave, NGW = G * NWAVES;
    float* X = (float*)(A.ws() + WS_X); bf16* H = (bf16*)(A.ws() + WS_H); const bf16* YB = (const bf16*)(A.ws() + WS_YB);
    const float* mods = (const float*)(A.ws() + WS_MODS) + (size_t)l * 5 * 6144;
    const int* toke = (const int*)(A.ws() + WS_TOKE); const int* tokp = (const int*)(A.ws() + WS_TOKP); const float* tokg = (const float*)(A.ws() + WS_TOKG);
    const float* g2 = A.in(ILN2G) + l * D; const float* b2 = A.in(ILN2B) + l * D; const float* g1 = A.in(ILN1G) + l * D; const float* b1 = A.in(ILN1B) + l * D;
    for (int m = gw; m < nrows_total; m += NGW) {
        f32x4 f[4];
#pragma unroll
        for (int j = 0; j < 4; ++j) f[j] = (f32x4){0.f, 0.f, 0.f, 0.f};
#pragma unroll
        for (int k = 0; k < 4; ++k) { const int slot = tab[toke[m * 4 + k]] + tokp[m * 4 + k]; const float g = tokg[m * 4 + k]; const u32x2* y = (const u32x2*)(YB + (size_t)slot * D) + lane;
#pragma unroll
            for (int j = 0; j < 4; ++j) { const u32x2 w = y[64 * j]; f[j].x += g * bf2f(w.x & 0xffffu); f[j].y += g * bf2f(w.x >> 16); f[j].z += g * bf2f(w.y & 0xffffu); f[j].w += g * bf2f(w.y >> 16); } }
        f32x4* xr = (f32x4*)(X + (size_t)m * D) + lane; const float* md = mods + (size_t)mod_row(m) * 6144; f32x4 v[4];
#pragma unroll
        for (int j = 0; j < 4; ++j) v[j] = xr[64 * j];
        row_ln1p(v);
#pragma unroll
        for (int j = 0; j < 4; ++j) { const f32x4 x = v[j] * ((const f32x4*)g1)[lane + 64 * j] + ((const f32x4*)b1)[lane + 64 * j]; v[j] = x * DN_ALPHA + ((const f32x4*)(md + 5 * D))[lane + 64 * j] * f[j]; }
        row_ln(v);
#pragma unroll
        for (int j = 0; j < 4; ++j) v[j] = v[j] * ((const f32x4*)g2)[lane + 64 * j] + ((const f32x4*)b2)[lane + 64 * j];
        if (l == DEPTH - 1) { f32x4* o = (f32x4*)(A.out() + (size_t)m * D) + lane;
#pragma unroll
            for (int j = 0; j < 4; ++j) o[64 * j] = v[j];
        } else {
#pragma unroll
            for (int j = 0; j < 4; ++j) xr[64 * j] = v[j];
            row_ln(v);
            const float* mn = mods + 5 * 6144 + (size_t)mod_row(m) * 6144;
#pragma unroll
            for (int j = 0; j < 4; ++j) { const f32x4 sh = ((const f32x4*)mn)[lane + 64 * j], scl = ((const f32x4*)(mn + D))[lane + 64 * j]; v[j] = v[j] * (scl + 1.f) + sh; }
            row_store_bf16(H + (size_t)m * D, v, lane);
        }
    }
}

__device__ __forceinline__ u32x2 lds_tr16(unsigned addr) { u32x2 r; asm volatile("ds_read_b64_tr_b16 %0, %1" : "=&v"(r) : "v"(addr) : "memory"); return r; }
template <bool CTXQ>
__device__ __forceinline__ void na_unit(const Ctx& A, int l, LAS unsigned char* lds, int unit, int tid, int lane, int wave) {
    constexpr int NKT = CTXQ ? 16 : 48, NTW = NKT / 2, NKEYS = NKT * 16, KST = 72, NCH = NKEYS * 8 / NTHR;
    const bf16* cols = (const bf16*)(A.ws() + WS_COLS); bf16* MIX = (bf16*)(A.ws() + WS_MIX);
    int b, h, r = 0, r0 = 0, qbase;
    if (!CTXQ) { b = unit >> 8; h = (unit >> 6) & 3; r = unit & 63; r0 = min(max(r - 4, 0), 56); qbase = b * SEQ + r * 64; }
    else { b = unit >> 4; h = (unit >> 2) & 3; qbase = NLAT + b * CTXL + (unit & 3) * 64; }
    LAS bf16* Kimg = (LAS bf16*)lds;
    const int mt = wave & 3, kq = wave >> 2, qi = lane & 15, g = lane >> 4;
    const char* cb = (const char*)cols; LAS float* RP = (LAS float*)(lds + 114688 + 256);
    if (!CTXQ && tid < 465) RP[tid] = A.in(IRPB)[(size_t)(l * 4 + h) * 465 + tid];
#define NA_KOFF(k2, n, part) const int q_ = tid + NTHR * (k2), n = q_ >> 3, part = q_ & 7; \
        const int krow_ = (!CTXQ && n < 512) ? (b * SEQ + (r0 + (n >> 6)) * 64 + (n & 63)) : (NLAT + b * CTXL + (CTXQ ? n : n - 512)); const unsigned koff_ = (unsigned)(krow_ * DIN + h * 64 + part * 8) * 2u
#pragma unroll
    for (int k2 = 0; k2 < NCH; ++k2) { NA_KOFF(k2, n, part); *(LAS u32x4*)(Kimg + n * KST + part * 8) = *(const u32x4*)(cb + koff_ + C_NA_K * 2); }
    const int qrow = qbase + mt * 16 + qi;
    bf16x8 qf0 = *(const bf16x8*)(cols + (size_t)qrow * DIN + C_NA_Q + h * 64 + g * 8), qf1 = *(const bf16x8*)(cols + (size_t)qrow * DIN + C_NA_Q + h * 64 + 32 + g * 8);
    LBAR();
    const int cq = mt * 16 + qi, c0 = min(max(cq - 8, 0), 48);
    const int mk0 = 4 * g - c0, bi0 = 4 * g - cq + 15;
    const int ctlo = mt >= 2 ? mt - 1 : 0, cthi = mt <= 1 ? mt + 1 : 3;
#define NA_TILE(t, sv) do { const int kt = kq * NTW + (t); \
        if (!CTXQ && kt < 32 && ((kt & 3) < ctlo || (kt & 3) > cthi)) { sv = (f32x4){-INFINITY, -INFINITY, -INFINITY, -INFINITY}; } \
        else { f32x4 acc_ = {0.f, 0.f, 0.f, 0.f}; \
            acc_ = mma(lds_frag(Kimg, KST, kt * 16, 0, lane), qf0, acc_); acc_ = mma(lds_frag(Kimg, KST, kt * 16, 32, lane), qf1, acc_); \
            if (!CTXQ && kt < 32) { const int ct16_ = (kt & 3) * 16; const LAS float* rp_ = RP + (r0 + (kt >> 2) - r + 7) * 31 + ct16_ + bi0; const int mk_ = ct16_ + mk0; \
                _Pragma("unroll") for (int i_ = 0; i_ < 4; ++i_) sv[i_] = ((unsigned)(mk_ + i_) < 16u) ? acc_[i_] * 0.125f + rp_[i_] : -INFINITY; } \
            else { sv = acc_ * 0.125f; } } } while (0)
    f32x4 s[NTW]; float mloc = -INFINITY;
#pragma unroll
    for (int t = 0; t < NTW; ++t) { f32x4 sv; NA_TILE(t, sv); s[t] = sv; mloc = fmaxf(fmaxf(mloc, fmaxf(sv[0], sv[1])), fmaxf(sv[2], sv[3])); if (t & 1) __builtin_amdgcn_sched_barrier(0); }
    mloc = fmaxf(mloc, __shfl_xor(mloc, 16)); mloc = fmaxf(mloc, __shfl_xor(mloc, 32));
    u32x4 vreg[NCH];
#pragma unroll
    for (int k2 = 0; k2 < NCH; ++k2) { NA_KOFF(k2, n, part); (void)n; vreg[k2] = *(const u32x4*)(cb + koff_ + C_NA_V * 2); }
    float lsum = 0.f; bf16x8 pb[NTW / 2];
#pragma unroll
    for (int tt = 0; tt < NTW / 2; ++tt) { float p[8];
#pragma unroll
        for (int i = 0; i < 4; ++i) { p[i] = __expf(s[2 * tt][i] - mloc); p[4 + i] = __expf(s[2 * tt + 1][i] - mloc); }
#pragma unroll
        for (int i = 0; i < 8; ++i) lsum += p[i];
        u32x4 w; w.x = pk2(p[0], p[1]); w.y = pk2(p[2], p[3]); w.z = pk2(p[4], p[5]); w.w = pk2(p[6], p[7]);
        pb[tt] = __builtin_bit_cast(bf16x8, w); }
#undef NA_TILE
    lsum += __shfl_xor(lsum, 16); lsum += __shfl_xor(lsum, 32);
    LBAR();
#pragma unroll
    for (int k2 = 0; k2 < NCH; ++k2) { const int q_ = tid + NTHR * k2, n = q_ >> 3, part = q_ & 7; *(LAS u32x4*)(Kimg + n * KST + part * 8) = vreg[k2]; }
#undef NA_KOFF
    LBAR();
    f32x4 o[4];
    const unsigned vbase = (unsigned)(size_t)Kimg + (unsigned)(((kq * NTW * 16 + 4 * g + (qi >> 2)) * KST + 4 * (qi & 3)) * 2);
#define NA_OFFL(dt, tt) (((32 * (tt)) * 72 + 16 * (dt)) * 2)
#define NA_OFFH(dt, tt) (((32 * (tt) + 16) * 72 + 16 * (dt)) * 2)
#define NA_PV2(dt, t2) do { u32x2 l0, l1, h0, h1; \
        asm volatile("ds_read_b64_tr_b16 %0, %4 offset:%5\n\tds_read_b64_tr_b16 %2, %4 offset:%6\n\tds_read_b64_tr_b16 %1, %4 offset:%7\n\tds_read_b64_tr_b16 %3, %4 offset:%8\n\ts_waitcnt lgkmcnt(0)" \
                     : "=&v"(l0), "=&v"(l1), "=&v"(h0), "=&v"(h1) : "v"(vbase), "i"(NA_OFFL(dt, t2)), "i"(NA_OFFH(dt, t2)), "i"(NA_OFFL(dt, (t2) + 1)), "i"(NA_OFFH(dt, (t2) + 1)) : "memory"); \
        u32x4 w_; w_.x = l0.x; w_.y = l0.y; w_.z = h0.x; w_.w = h0.y; acc = mma(__builtin_bit_cast(bf16x8, w_), pb[(t2)], acc); \
        w_.x = l1.x; w_.y = l1.y; w_.z = h1.x; w_.w = h1.y; acc = mma(__builtin_bit_cast(bf16x8, w_), pb[(t2) + 1], acc); } while (0)
#define NA_PV(dt, hb) do { NA_PV2(dt, 4 * (hb)); NA_PV2(dt, 4 * (hb) + 2); } while (0)
#define NA_PVD(dt) do { f32x4 acc = {0.f, 0.f, 0.f, 0.f}; NA_PV(dt, 0); if constexpr (NTW / 8 > 1) { NA_PV(dt, 1); NA_PV(dt, 2); } o[dt] = acc; } while (0)
    NA_PVD(0); NA_PVD(1); NA_PVD(2); NA_PVD(3);
#undef NA_PVD
#undef NA_PV
#undef NA_PV2
#undef NA_OFFL
#undef NA_OFFH
    LBAR();
    LAS float* mrg = (LAS float*)lds + mt * 1088;
    if (kq == 1) {
#pragma unroll
        for (int dt = 0; dt < 4; ++dt)
#pragma unroll
            for (int i = 0; i < 4; ++i) mrg[(dt * 16 + 4 * g + i) * 16 + qi] = o[dt][i];
        if (g == 0) { mrg[1024 + qi] = mloc; mrg[1040 + qi] = lsum; } }
    LBAR();
    if (kq == 0) { const float m1 = mrg[1024 + qi], l1 = mrg[1040 + qi], mm = fmaxf(mloc, m1), f0 = __expf(mloc - mm), f1 = __expf(m1 - mm), inv = 1.f / (lsum * f0 + l1 * f1);
#pragma unroll
        for (int dt = 0; dt < 4; ++dt) { float y[4];
#pragma unroll
            for (int i = 0; i < 4; ++i) y[i] = (o[dt][i] * f0 + mrg[(dt * 16 + 4 * g + i) * 16 + qi] * f1) * inv;
            u32x2 w; w.x = pk2(y[0], y[1]); w.y = pk2(y[2], y[3]);
            *(u32x2*)(MIX + (size_t)qrow * D + 256 + h * 64 + dt * 16 + 4 * g) = w; } }
    LBAR();
}
__device__ __forceinline__ void gla_item_info(int item, int& b, int& h, int& cc, int& m0, bool& isctx) {
    const int cidx = item >> 2; h = item & 3;
    if (cidx < 512) { b = cidx >> 7; cc = cidx & 127; m0 = b * SEQ + cc * 32; isctx = false; } else { const int j = cidx - 512; b = j >> 3; cc = j & 7; m0 = NLAT + b * CTXL + cc * 32; isctx = true; }
}
__device__ __forceinline__ int gla_cpos(bool isctx, int cc, int dir) { return isctx ? (dir ? 7 - cc : cc) : 8 + (dir ? 127 - cc : cc); }
__device__ __forceinline__ float fast_logsigmoid(float z) { return fminf(z, 0.f) - __logf(1.f + __expf(-fabsf(z))); }

__device__ __forceinline__ void gla_a_chunk(const Ctx& A, int l, LAS unsigned char* lds, int lane, int wave, int chunk) {
    LAS unsigned char* base = lds + wave * 17664;
    LAS bf16* QT = (LAS bf16*)base; LAS bf16* KT = (LAS bf16*)(base + 2560); LAS bf16* KDT = (LAS bf16*)(base + 5120); LAS bf16* PM = (LAS bf16*)(base + 7680); LAS bf16* VT = (LAS bf16*)(base + 10240); LAS float* GL = (LAS float*)(base + 15360); LAS float* ALR = (LAS float*)(base + 15616);
    const bf16* cols = (const bf16*)(A.ws() + WS_COLS); const float* gates = (const float*)(A.ws() + WS_GATES); const float* rope = (const float*)(A.ws() + WS_ROPE);
    bf16* SD = (bf16*)(A.ws() + WS_SD); float* SA = (float*)(A.ws() + WS_SA); bf16* OI = (bf16*)(A.ws() + WS_OI); bf16* QTG = (bf16*)(A.ws() + WS_QTG);
    const int d = lane & 31, dr = lane >> 5, g = lane >> 4, c16 = lane & 15;
    { const int item = chunk * NWAVES + wave;
        int b, h, cc, m0; bool isctx; gla_item_info(item, b, h, cc, m0, isctx);
        { u32x4 vv[4];
#pragma unroll
          for (int k = 0; k < 4; ++k) { const int c = lane + 64 * k; vv[k] = *(const u32x4*)(cols + (size_t)(m0 + (c >> 3)) * DIN + C_GLA_V + h * 64 + (c & 7) * 8); }
#pragma unroll
          for (int k = 0; k < 4; ++k) { const int c = lane + 64 * k; LAS bf16* d = VT + ((c & 7) * 8) * 40 + (c >> 3); const u32x4 w = vv[k];
              d[0] = (bf16)(w.x & 0xffffu); d[40] = (bf16)(w.x >> 16); d[80] = (bf16)(w.y & 0xffffu); d[120] = (bf16)(w.y >> 16);
              d[160] = (bf16)(w.z & 0xffffu); d[200] = (bf16)(w.z >> 16); d[240] = (bf16)(w.w & 0xffffu); d[280] = (bf16)(w.w >> 16); } }
        f32x4 o[2][4];
#pragma unroll
        for (int i = 0; i < 2; ++i)
#pragma unroll
            for (int j = 0; j < 4; ++j) o[i][j] = (f32x4){0.f, 0.f, 0.f, 0.f};
#pragma unroll 1
        for (int dir = 0; dir < 2; ++dir) {
            const float* w2 = A.in(IGLAW) + ((size_t)(l * 2 + dir) * 16) * 128 + h * 32 + d; float w[16];
#pragma unroll
            for (int r = 0; r < 16; ++r) w[r] = w2[r * 128];
            float Gr = 0.f; const float bias = A.in(IGLAB)[(l * 2 + dir) * 128 + h * 32 + d];
            const float xs = dr ? 1.f : 0.17677669529663687f;
            { const int t = lane >> 1, part = lane & 1; const f32x4* ap = (const f32x4*)(gates + (size_t)(m0 + t) * 48 + dir * 16 + part * 8);
              const f32x4 v0 = ap[0], v1 = ap[1]; *(LAS f32x4*)(ALR + t * 16 + part * 8) = v0; *(LAS f32x4*)(ALR + t * 16 + part * 8 + 4) = v1; }
#pragma unroll
            for (int k2 = 0; k2 < 2; ++k2) { const int c = lane + 64 * k2, row = c >> 2, part = c & 3; const bf16* src = cols + (size_t)(m0 + row) * DIN + h * 32 + part * 8;
                *(LAS u32x4*)(QT + row * 40 + part * 8) = *(const u32x4*)(src + C_GLA_Q); *(LAS u32x4*)(KT + row * 40 + part * 8) = *(const u32x4*)(src + C_GLA_K); }
            WAVE_SYNC();
            LAS bf16* XI = dr ? KT : QT;
            float rc = 1.f, rs = 0.f, rcd = 1.f, rsd = 0.f;
            if (!isctx) { const int t0 = dir ? 31 : 0, tpos0 = cc * 32 + t0, pos0 = (d & 16) ? (tpos0 & 63) : (tpos0 >> 6); rc = rope[(pos0 * 8 + (d & 7)) * 2]; rs = rope[(pos0 * 8 + (d & 7)) * 2 + 1];
                if (d & 16) { rcd = rope[(8 + (d & 7)) * 2]; rsd = rope[(8 + (d & 7)) * 2 + 1]; if (dir) rsd = -rsd; } }
#pragma unroll 4
            for (int i = 0; i < 32; ++i) { const int t = dir ? 31 - i : i;
                const LAS f32x4* ap = (const LAS f32x4*)(ALR + t * 16); const f32x4 a0 = ap[0], a1 = ap[1], a2 = ap[2], a3 = ap[3];
                const float z = bias + a0.x * w[0] + a0.y * w[1] + a0.z * w[2] + a0.w * w[3] + a1.x * w[4] + a1.y * w[5] + a1.z * w[6] + a1.w * w[7]
                                     + a2.x * w[8] + a2.y * w[9] + a2.z * w[10] + a2.w * w[11] + a3.x * w[12] + a3.y * w[13] + a3.z * w[14] + a3.w * w[15];
                Gr += fast_logsigmoid(z) * (1.f / 16.f);
                float x = bf2f(XI[t * 40 + d]) * xs; const float y = dppf<0x128>(x);
                if (!isctx) { x = (d & 8) ? (x * rc + y * rs) : (x * rc - y * rs);
                    const float nc = rc * rcd - rs * rsd, ns = rs * rcd + rc * rsd; rc = nc; rs = ns; }
                if (dr == 0) QT[t * 40 + d] = (bf16)f2bf(x * __expf(Gr));
                else { const bf16 kv = (bf16)f2bf(x * __expf(-Gr)); KT[t * 40 + d] = kv; KDT[d * 40 + t] = kv; } }
            const float glast = Gr;
            if (dr == 0) GL[d] = __expf(glast);
            WAVE_SYNC();
#pragma unroll
            for (int ti = 0; ti < 2; ++ti) { const bf16x8 a = lds_frag(QT, 40, 16 * ti, 0, lane);
#pragma unroll
                for (int sj = 0; sj < 2; ++sj) { f32x4 acc = {0.f, 0.f, 0.f, 0.f}; acc = mma(a, lds_frag(KT, 40, 16 * sj, 0, lane), acc);
#pragma unroll
                    for (int r = 0; r < 4; ++r) { const int t = 16 * ti + 4 * g + r, s = 16 * sj + c16; const bool keep = dir ? (s >= t) : (s <= t);
                        PM[t * 40 + s] = (bf16)f2bf(keep ? acc[r] : 0.f); } } }
            WAVE_SYNC();
            const int chain = (b * 4 + h) * 2 + dir, cpos = gla_cpos(isctx, cc, dir);
            bf16* sd = SD + ((size_t)chain * 136 + cpos) * 2048;
#pragma unroll
            for (int j = 0; j < 4; ++j) { const bf16x8 vb = lds_frag(VT, 40, 16 * j, 0, lane);
#pragma unroll
                for (int ti = 0; ti < 2; ++ti) { o[ti][j] = mma(lds_frag(PM, 40, 16 * ti, 0, lane), vb, o[ti][j]);
                    f32x4 acc = {0.f, 0.f, 0.f, 0.f}; acc = mma(lds_frag(KDT, 40, 16 * ti, 0, lane), vb, acc);
#pragma unroll
                    for (int r = 0; r < 4; ++r) sd[(16 * ti + 4 * g + r) * 64 + 16 * j + c16] = (bf16)f2bf(acc[r] * GL[16 * ti + 4 * g + r]); } }
            if (dr == 0) SA[((size_t)chain * 136 + cpos) * 32 + d] = GL[d];
            { bf16* qg = QTG + ((size_t)item * 2 + dir) * 1024;
#pragma unroll
              for (int k2 = 0; k2 < 2; ++k2) { const int c = lane + 64 * k2, row = c >> 2, part = c & 3; *(u32x4*)(qg + row * 32 + part * 8) = *(const LAS u32x4*)(QT + row * 40 + part * 8); } }
            WAVE_SYNC();
        }
        bf16* oi = OI + (size_t)item * 2048;
#pragma unroll
        for (int ti = 0; ti < 2; ++ti)
#pragma unroll
            for (int j = 0; j < 4; ++j)
#pragma unroll
                for (int r = 0; r < 4; ++r) oi[(16 * ti + 4 * g + r) * 64 + 16 * j + c16] = (bf16)f2bf(o[ti][j][r]);
    }
}
__device__ __forceinline__ void ph_gla_b(const Ctx& A, int tid, int blk, int nblk) {
    const bf16* __restrict__ SD = (const bf16*)(A.ws() + WS_SD); const float* __restrict__ SA = (const float*)(A.ws() + WS_SA); bf16* __restrict__ SS = (bf16*)(A.ws() + WS_SS);
    for (int idx = blk * NTHR + tid; idx < 32 * 2048; idx += nblk * NTHR) {
        const int chain = idx >> 11, e = idx & 2047, d = e >> 6;
        const bf16* sd = SD + (size_t)chain * 136 * 2048 + e; const float* sa = SA + (size_t)chain * 136 * 32 + d; bf16* ss = SS + (size_t)chain * 136 * 2048 + e;
        float S = 0.f;
#pragma unroll 1
        for (int p0 = 0; p0 < 136; p0 += 17) { float inc[17], a[17];
#pragma unroll
            for (int k = 0; k < 17; ++k) { inc[k] = bf2f(sd[(size_t)(p0 + k) * 2048]); a[k] = sa[(p0 + k) * 32]; }
#pragma unroll
            for (int k = 0; k < 17; ++k) { ss[(size_t)(p0 + k) * 2048] = (bf16)f2bf(S); S = a[k] * S + inc[k]; } }
    }
}
__device__ __forceinline__ void ph_gla_c(const Ctx& A, int l, int lane, int wave, int G, int nitems) {
    const bf16* cols = (const bf16*)(A.ws() + WS_COLS); const bf16* SS = (const bf16*)(A.ws() + WS_SS); bf16* MIX = (bf16*)(A.ws() + WS_MIX);
    const bf16* OI = (const bf16*)(A.ws() + WS_OI); const bf16* QTG = (const bf16*)(A.ws() + WS_QTG);
    const int gw = blockIdx.x * NWAVES + wave, NGW = G * NWAVES; const int g = lane >> 4, c16 = lane & 15;
    for (int item = gw; item < nitems; item += NGW) {
        int b, h, cc, m0; bool isctx; gla_item_info(item, b, h, cc, m0, isctx);
        f32x4 o[2][4]; const bf16* oi = OI + (size_t)item * 2048;
#pragma unroll
        for (int ti = 0; ti < 2; ++ti)
#pragma unroll
            for (int j = 0; j < 4; ++j)
#pragma unroll
                for (int r = 0; r < 4; ++r) o[ti][j][r] = bf2f(oi[(16 * ti + 4 * g + r) * 64 + 16 * j + c16]);
#pragma unroll
        for (int dir = 0; dir < 2; ++dir) {
            const int chain = (b * 4 + h) * 2 + dir, cpos = gla_cpos(isctx, cc, dir);
            const bf16* sd = SS + ((size_t)chain * 136 + cpos) * 2048; const bf16* qg = QTG + ((size_t)item * 2 + dir) * 1024;
            const bf16x8 qa0 = *(const bf16x8*)(qg + c16 * 32 + 8 * g), qa1 = *(const bf16x8*)(qg + (16 + c16) * 32 + 8 * g);
#pragma unroll
            for (int j = 0; j < 4; ++j) { unsigned sv[8];
#pragma unroll
                for (int jj = 0; jj < 8; ++jj) sv[jj] = sd[(8 * g + jj) * 64 + 16 * j + c16];
                u32x4 w; w.x = sv[0] | (sv[1] << 16); w.y = sv[2] | (sv[3] << 16); w.z = sv[4] | (sv[5] << 16); w.w = sv[6] | (sv[7] << 16);
                const bf16x8 sb = __builtin_bit_cast(bf16x8, w);
                o[0][j] = mma(qa0, sb, o[0][j]); o[1][j] = mma(qa1, sb, o[1][j]); } }
        const float* ng = A.in(IGLAN) + l * 64;
#pragma unroll
        for (int ti = 0; ti < 2; ++ti)
#pragma unroll
            for (int r = 0; r < 4; ++r) { float ss = 0.f;
#pragma unroll
                for (int j = 0; j < 4; ++j) ss += o[ti][j][r] * o[ti][j][r];
                ss = row16_sum(ss);
                const float rs = rsqrtf(ss * (1.f / 64.f) + RMS_EPS); const int t = 16 * ti + 4 * g + r;
#pragma unroll
                for (int j = 0; j < 4; ++j) { const int dv = 16 * j + c16; const float gt = bf2f(cols[(size_t)(m0 + t) * DIN + C_GLA_G + h * 64 + dv]);
                    MIX[(size_t)(m0 + t) * D + h * 64 + dv] = (bf16)f2bf(o[ti][j][r] * rs * ng[dv] * siluf_(gt)); } }
    }
}

__device__ __forceinline__ int gdn_m0(int ci) { return ci < 256 ? ((ci >> 6) * SEQ + (ci & 63) * 64) : (NLAT + ((ci - 256) >> 2) * CTXL + ((ci - 256) & 3) * 64); }

__device__ __forceinline__ void gdn_solve(const LAS bf16* LB, LAS float* Ld, LAS bf16* TT, LAS bf16* DA, LAS bf16* TBv, LAS bf16* TBw, const LAS float* gc, int dir, int lane) {
    const int g = lane >> 4, c16 = lane & 15;
    { const LAS float* ld = Ld + g * 320; float dc[16];
#pragma unroll
      for (int r = 0; r < 16; ++r) { float a = (r == c16) ? 1.f : 0.f;
#pragma unroll
          for (int j4 = 0; j4 < (r + 3) / 4; ++j4) { const f32x4 lv = *(const LAS f32x4*)(ld + r * 20 + 4 * j4);
              if (4 * j4 + 0 < r) a -= lv.x * dc[4 * j4 + 0];
              if (4 * j4 + 1 < r) a -= lv.y * dc[4 * j4 + 1];
              if (4 * j4 + 2 < r) a -= lv.z * dc[4 * j4 + 2];
              if (4 * j4 + 3 < r) a -= lv.w * dc[4 * j4 + 3]; }
          dc[r] = a; }
#pragma unroll
      for (int r = 0; r < 16; ++r) { DA[(16 * g + r) * 32 + c16] = (bf16)f2bf(dc[r]); DA[(16 * g + r) * 32 + 16 + c16] = 0; } }
    WAVE_SYNC();
    LAS bf16* XT = (LAS bf16*)Ld;
#pragma unroll
    for (int q = 0; q < 5; ++q) ((LAS u32x4*)XT)[lane + 64 * q] = (u32x4){0u, 0u, 0u, 0u};
    float sv[4], sw[4]; int tc[4];
#pragma unroll
    for (int nt = 0; nt < 4; ++nt) { const int c = 16 * nt + c16; const float be = gc[64 + c]; sv[nt] = be; sw[nt] = -be * __expf(gc[c]); tc[nt] = dir ? 63 - c : c; }
    WAVE_SYNC();
#pragma unroll 1
    for (int ib = 0; ib < 4; ++ib) {
        f32x4 x[4];
#pragma unroll
        for (int nt = 0; nt < 4; ++nt) x[nt] = (f32x4){0.f, 0.f, 0.f, 0.f};
        if (ib > 0) { const bf16x8 a0 = lds_frag(LB, 72, 16 * ib, 0, lane), a1 = lds_frag(LB, 72, 16 * ib, 32, lane);
#pragma unroll
            for (int nt = 0; nt < 4; ++nt) { x[nt] = mma(a0, lds_frag(TT, 72, 16 * nt, 0, lane), x[nt]); x[nt] = mma(a1, lds_frag(TT, 72, 16 * nt, 32, lane), x[nt]); } }
#pragma unroll
        for (int nt = 0; nt < 4; ++nt) { f32x4 v = x[nt];
#pragma unroll
            for (int r = 0; r < 4; ++r) if (nt == ib && 4 * g + r == c16) v[r] += 1.f;
            u32x2 w; w.x = pk2(v[0], v[1]); w.y = pk2(v[2], v[3]); *(LAS u32x2*)(XT + (16 * nt + c16) * 40 + 4 * g) = w; }
        WAVE_SYNC();
        const bf16x8 da = lds_frag(DA, 32, 16 * ib, 0, lane);
#pragma unroll
        for (int nt = 0; nt < 4; ++nt) { f32x4 t = {0.f, 0.f, 0.f, 0.f}; t = mma(da, lds_frag(XT, 40, 16 * nt, 0, lane), t);
            u32x2 w; w.x = pk2(t[0], t[1]); w.y = pk2(t[2], t[3]); *(LAS u32x2*)(TT + (16 * nt + c16) * 72 + 16 * ib + 4 * g) = w;
#pragma unroll
            for (int r = 0; r < 4; ++r) { TBv[(16 * ib + 4 * g + r) * 72 + tc[nt]] = (bf16)f2bf(t[r] * sv[nt]); TBw[(16 * ib + 4 * g + r) * 72 + tc[nt]] = (bf16)f2bf(t[r] * sw[nt]); } }
        WAVE_SYNC();
    }
}

__device__ __forceinline__ void gdn_prep_item(const Ctx& A, int l, LAS unsigned char* lds, int item, int tid, int lane, int wave) {
    LAS bf16* QN = (LAS bf16*)lds; LAS bf16* KN = (LAS bf16*)(lds + 17408);
    LAS bf16* LB = (LAS bf16*)lds; LAS float* Ld = (LAS float*)(lds + 18432);
    LAS bf16* TT = (LAS bf16*)(lds + 109568); LAS float* RB = (LAS float*)(lds + 128000);
    LAS bf16* VT = (LAS bf16*)(lds + 34816); LAS bf16* KNT = (LAS bf16*)(lds + 53248);
    LAS float* KK = (LAS float*)(lds + 71680); LAS float* QK = (LAS float*)(lds + 88320);
    LAS bf16* TB = (LAS bf16*)(lds + 71680);
    LAS float* GC = (LAS float*)(lds + 108544);
    const int ci = item >> 2, h = item & 3, m0 = gdn_m0(ci);
    { const bf16* cols = (const bf16*)(A.ws() + WS_COLS); const float* cw = A.in(ICONV) + (size_t)l * 5 * 1536; bf16* GQ = (bf16*)(A.ws() + WS_GQ);
      const int part = lane >> 4, c8 = (lane & 15) * 8; const bool isctx = ci >= 256; const int slen = isctx ? CTXL : SEQ, cpos = (isctx ? ((ci - 256) & 3) : (ci & 63)) * 64, tseq0 = cpos + wave * 8, mseq0 = m0 - cpos;
      if (part < 3) { const int ch = part * 512 + h * 128 + c8;
          u32x4 xin[12];
#pragma unroll
          for (int i = 0; i < 12; ++i) { const int tt = tseq0 + i - 2, tc = min(max(tt, 0), slen - 1); const u32x4 x = *(const u32x4*)(cols + (size_t)(mseq0 + tc) * DIN + C_GDN_Q + ch);
              const bool ok = tt == tc; xin[i].x = ok ? x.x : 0u; xin[i].y = ok ? x.y : 0u; xin[i].z = ok ? x.z : 0u; xin[i].w = ok ? x.w : 0u; }
          f32x4 w0[5], w1[5];
#pragma unroll
          for (int j = 0; j < 5; ++j) { w0[j] = *(const f32x4*)(cw + j * 1536 + ch); w1[j] = *(const f32x4*)(cw + j * 1536 + ch + 4); }
#pragma unroll
          for (int r = 0; r < 8; ++r) { f32x4 a0 = {0.f, 0.f, 0.f, 0.f}, a1 = {0.f, 0.f, 0.f, 0.f};
#pragma unroll
              for (int j = 0; j < 5; ++j) { const u32x4 w = xin[r + j];
                  a0 += (f32x4){bf2f(w.x & 0xffffu), bf2f(w.x >> 16), bf2f(w.y & 0xffffu), bf2f(w.y >> 16)} * w0[j]; a1 += (f32x4){bf2f(w.z & 0xffffu), bf2f(w.z >> 16), bf2f(w.w & 0xffffu), bf2f(w.w >> 16)} * w1[j]; }
              { const f32x4 t0 = a0 * -1.4426950408889634f, t1 = a1 * -1.4426950408889634f;
                const f32x4 d0 = (f32x4){__builtin_amdgcn_exp2f(t0[0]), __builtin_amdgcn_exp2f(t0[1]), __builtin_amdgcn_exp2f(t0[2]), __builtin_amdgcn_exp2f(t0[3])} + 1.f, d1 = (f32x4){__builtin_amdgcn_exp2f(t1[0]), __builtin_amdgcn_exp2f(t1[1]), __builtin_amdgcn_exp2f(t1[2]), __builtin_amdgcn_exp2f(t1[3])} + 1.f;
                a0 = a0 * (f32x4){__builtin_amdgcn_rcpf(d0[0]), __builtin_amdgcn_rcpf(d0[1]), __builtin_amdgcn_rcpf(d0[2]), __builtin_amdgcn_rcpf(d0[3])}; a1 = a1 * (f32x4){__builtin_amdgcn_rcpf(d1[0]), __builtin_amdgcn_rcpf(d1[1]), __builtin_amdgcn_rcpf(d1[2]), __builtin_amdgcn_rcpf(d1[3])}; }
              float scale = 1.f;
              if (part < 2) { const f32x4 q = a0 * a0 + a1 * a1; const float ss = row16_sum((q[0] + q[1]) + (q[2] + q[3])); scale = rsqrtf(ss + 1e-6f) * (part == 0 ? 0.08838834764831845f : 1.f); }
              a0 = a0 * scale; a1 = a1 * scale;
              u32x4 o; o.x = pk2(a0[0], a0[1]); o.y = pk2(a0[2], a0[3]); o.z = pk2(a1[0], a1[1]); o.w = pk2(a1[2], a1[3]);
              const int t = wave * 8 + r;
              if (part == 0) { *(LAS u32x4*)(QN + t * 136 + c8) = o; *(u32x4*)(GQ + (size_t)(m0 + t) * 512 + h * 128 + c8) = o; }
              else { if (part == 1) *(LAS u32x4*)(KN + t * 136 + c8) = o;
                  LAS bf16* d = (part == 1 ? KNT : VT) + c8 * 72 + t;
                  d[0] = (bf16)(o.x & 0xffffu); d[72] = (bf16)(o.x >> 16); d[144] = (bf16)(o.y & 0xffffu); d[216] = (bf16)(o.y >> 16);
                  d[288] = (bf16)(o.z & 0xffffu); d[360] = (bf16)(o.z >> 16); d[432] = (bf16)(o.w & 0xffffu); d[504] = (bf16)(o.w >> 16); } } }
      if (tid < 128) { const int dir = tid >> 6, i = tid & 63, t = dir ? 63 - i : i; const float* gp = (const float*)(A.ws() + WS_GATES) + (size_t)(m0 + t) * 48; const int c = dir * 4 + h;
          GC[dir * 128 + i] = -__expf(A.in(IALOG)[l * 8 + c]) * softplusf_(gp[40 + c] + A.in(IDTB)[l * 8 + c]); GC[dir * 128 + 64 + i] = sigmoidf_(gp[32 + c]); } }
    LBAR();
    const int g = lane >> 4, c16 = lane & 15;
#pragma unroll
    for (int x = 0; x < 4; ++x) { const int id = wave * 4 + x, ti = (id >> 2) & 3, tj = id & 3; const bool isq = id >= 16;
        f32x4 acc = {0.f, 0.f, 0.f, 0.f};
#pragma unroll
        for (int ks = 0; ks < 4; ++ks) acc = mma(lds_frag(isq ? QN : KN, 136, 16 * ti, 32 * ks, lane), lds_frag(KN, 136, 16 * tj, 32 * ks, lane), acc);
        LAS float* dst = isq ? QK : KK;
#pragma unroll
        for (int r = 0; r < 4; ++r) dst[(16 * ti + 4 * g + r) * 65 + 16 * tj + c16] = acc[r]; }
    float myg = 0.f;
    if (tid < 128) { myg = GC[(tid >> 6) * 128 + (tid & 63)];
#pragma unroll
        for (int o = 1; o < 64; o <<= 1) { const float t = __shfl_up(myg, o); if ((tid & 63) >= o) myg += t; } }
    LBAR();
    if (tid < 128) { const int dir = tid >> 6, i = tid & 63; GC[dir * 128 + i] = myg; float* gcb = (float*)(A.ws() + WS_GCB) + (size_t)(item * 2 + dir) * 128; gcb[i] = myg; gcb[64 + i] = GC[dir * 128 + 64 + i]; }
    LBAR();
    for (int q4 = tid; q4 < 2048; q4 += NTHR) { const int dir = q4 >> 10, i = (q4 >> 4) & 63, j0 = (q4 & 15) * 4, ti = dir ? 63 - i : i;
        const LAS float* gc = GC + dir * 128; const f32x4 gj = *(const LAS f32x4*)(gc + j0); const float gi = gc[i], bi = gc[64 + i];
        const f32x4 tt = __builtin_elementwise_min((f32x4){gi, gi, gi, gi} - gj, (f32x4){0.f, 0.f, 0.f, 0.f}) * 1.4426950408889634f;
        const f32x4 dec = {__builtin_amdgcn_exp2f(tt[0]), __builtin_amdgcn_exp2f(tt[1]), __builtin_amdgcn_exp2f(tt[2]), __builtin_amdgcn_exp2f(tt[3])};
        const LAS float* kr = KK + ti * 65; const LAS float* qr = QK + ti * 65; f32x4 kk, qk;
#pragma unroll
        for (int c = 0; c < 4; ++c) { const int tj = dir ? 63 - (j0 + c) : j0 + c; kk[c] = kr[tj]; qk[c] = qr[tj]; }
        f32x4 lv = kk * dec * bi, qv = qk * dec;
#pragma unroll
        for (int c = 0; c < 4; ++c) { lv[c] = (j0 + c < i) ? lv[c] : 0.f; qv[c] = (j0 + c <= i) ? qv[c] : 0.f; }
        const bool diag = (i >> 4) == (j0 >> 4);
        { u32x2 w; w.x = diag ? 0u : pk2(-lv[0], -lv[1]); w.y = diag ? 0u : pk2(-lv[2], -lv[3]); *(LAS u32x2*)(LB + dir * 4608 + i * 72 + j0) = w; }
        if (diag) *(LAS f32x4*)(Ld + dir * 1280 + (i >> 4) * 320 + (i & 15) * 20 + (j0 & 15)) = lv;
        { u32x2 w; w.x = pk2(qv[0], qv[1]); w.y = pk2(qv[2], qv[3]); *(u32x2*)((bf16*)(A.ws() + WS_GQKM) + (size_t)(item * 2 + dir) * 4096 + i * 64 + j0) = w; } }
    for (int idx = tid; idx < 2 * 64 * 72 / 2; idx += NTHR) ((LAS unsigned*)TT)[idx] = 0u;
    LBAR();
    if (wave < 2) { const int dir = wave; const LAS float* gc = GC + dir * 128;
        gdn_solve(LB + dir * 4608, Ld + dir * 1280, TT + dir * 4608, (LAS bf16*)(RB + dir * 1088), TB + (dir * 2) * 4608, TB + (dir * 2 + 1) * 4608, gc, dir, lane);
    } else { bf16* GKT = (bf16*)(A.ws() + WS_GKT) + (size_t)item * 8192;
        for (int c = tid - 128; c < 1024; c += NTHR - 128) { const int row = c >> 3, part = c & 7; *(u32x4*)(GKT + row * 64 + part * 8) = *(const LAS u32x4*)(KNT + row * 72 + part * 8); } }
    LBAR();
    { const int o = wave >> 1, dir = o >> 1, isw = o & 1; const LAS bf16* Xt = isw ? KNT : VT; const LAS bf16* Tb = TB + o * 4608;
      bf16* O = (bf16*)(A.ws() + (isw ? WS_GW : WS_GU)) + (size_t)(item * 2 + dir) * 8192;
#pragma unroll
      for (int mi = 0; mi < 2; ++mi) { const int mt = (wave & 1) * 2 + mi; const bf16x8 t0 = lds_frag(Tb, 72, 16 * mt, 0, lane), t1 = lds_frag(Tb, 72, 16 * mt, 32, lane);
#pragma unroll
          for (int nt = 0; nt < 8; ++nt) { f32x4 acc = {0.f, 0.f, 0.f, 0.f}; const bf16x8 x0 = lds_frag(Xt, 72, 16 * nt, 0, lane), x1 = lds_frag(Xt, 72, 16 * nt, 32, lane);
              if (isw) { acc = mma(x0, t0, acc); acc = mma(x1, t1, acc); }
              else { acc = mma(t0, x0, acc); acc = mma(t1, x1, acc); }
              u32x2 w; w.x = pk2(acc[0], acc[1]); w.y = pk2(acc[2], acc[3]);
              if (isw) *(u32x2*)(O + (16 * mt + c16) * 128 + 16 * nt + 4 * g) = w; else *(u32x2*)(O + (16 * nt + c16) * 64 + 16 * mt + 4 * g) = w; } } }
    LBAR();
}
#define GDN_BAR() do { asm volatile("s_waitcnt lgkmcnt(0)" ::: "memory"); __builtin_amdgcn_s_barrier(); asm volatile("" ::: "memory"); } while (0)
#if defined(PROBE_ID) && (PROBE_ID == 52 || PROBE_ID == 53)
#define GDN_BARP(id) do { if ((id) == PROBE_ID) { const unsigned long long t0_ = __builtin_amdgcn_s_memrealtime(); GDN_BAR(); const unsigned long long t1_ = __builtin_amdgcn_s_memrealtime(), dt_ = (t1_ - t0_) * 3ull; \
        while (__builtin_amdgcn_s_memrealtime() - t1_ < dt_) __builtin_amdgcn_s_sleep(4); } else GDN_BAR(); } while (0)
#else
#define GDN_BARP(id) GDN_BAR()
#endif
__device__ __forceinline__ void gdn_step_ids(int p, int b, int h, int dir, int& item, int& m0) {
    int ci; if (p < 4) ci = 256 + b * 4 + (dir ? 3 - p : p); else { const int q = p - 4; ci = b * 64 + (dir ? 63 - q : q); }
    item = ci * 4 + h; m0 = gdn_m0(ci);
}
constexpr int GNT = 2;
struct GdnS { bf16x8 w[4], k[4]; u32x2 ut[GNT]; f32x4 gc; float gl; };
struct GdnO { bf16x8 q[4], p[2]; f32x4 gc; };
__device__ __forceinline__ void gdn_load_s(const Ctx& A, GdnS& o, int p, int b, int h, int dir, unsigned offw, unsigned offk, unsigned offu, unsigned offgc) {
    int item, m0; gdn_step_ids(p, b, h, dir, item, m0); const int oi = item * 2 + dir; const char* ws = (const char*)A.ws();
    const char* bw = ws + WS_GW + (size_t)oi * 16384; const char* bk = ws + WS_GKT + (size_t)item * 16384; const char* bu = ws + WS_GU + (size_t)oi * 16384; const char* bg = ws + WS_GCB + (size_t)oi * 512;
#pragma unroll
    for (int ks = 0; ks < 4; ++ks) o.w[ks] = *(const bf16x8*)(bw + offw + 64 * ks);
    o.k[0] = *(const bf16x8*)(bk + offk); o.k[1] = *(const bf16x8*)(bk + offk + 64); o.k[2] = *(const bf16x8*)(bk + offk + 2048); o.k[3] = *(const bf16x8*)(bk + offk + 2048 + 64);
#pragma unroll
    for (int nt = 0; nt < GNT; ++nt) o.ut[nt] = *(const u32x2*)(bu + offu + 2048 * nt);
    o.gc = *(const f32x4*)(bg + offgc); o.gl = *(const float*)(bg + 252);
}
__device__ __forceinline__ void gdn_load_o(const Ctx& A, GdnO& o, int p, int b, int h, int dir, unsigned offq, unsigned offp, unsigned offgc) {
    int item, m0; gdn_step_ids(p, b, h, dir, item, m0); const int oi = item * 2 + dir; const char* ws = (const char*)A.ws();
    const char* bq = ws + WS_GQ + ((size_t)m0 * 512 + h * 128) * 2; const char* bp = ws + WS_GQKM + (size_t)oi * 8192; const char* bg = ws + WS_GCB + (size_t)oi * 512;
#pragma unroll
    for (int ks = 0; ks < 4; ++ks) o.q[ks] = *(const bf16x8*)(bq + offq + 64 * ks);
    o.p[0] = *(const bf16x8*)(bp + offp); o.p[1] = *(const bf16x8*)(bp + offp + 64);
    o.gc = *(const f32x4*)(bg + offgc);
}
__device__ __forceinline__ void gdn_step_s(const GdnS& o, f32x4 (&accs)[2][GNT], LAS bf16* ST, LAS bf16* VNO, LAS bf16* VNS, int dir, int w, int lane, int g, int c16) {
    const float gl = o.gl; const float e0 = __expf(gl - o.gc.x), e1 = __expf(gl - o.gc.y), e2 = __expf(gl - o.gc.z), e3 = __expf(gl - o.gc.w);
#pragma unroll
    for (int nt = 0; nt < GNT; ++nt) {
        f32x4 acc = {bf2f(o.ut[nt].x & 0xffffu), bf2f(o.ut[nt].x >> 16), bf2f(o.ut[nt].y & 0xffffu), bf2f(o.ut[nt].y >> 16)};
#pragma unroll
        for (int ks = 0; ks < 4; ++ks) acc = mma(o.w[ks], lds_frag(ST, 136, 16 * nt, 32 * ks, lane), acc);
        u32x2 v; v.x = pk2(acc[0], acc[1]); v.y = pk2(acc[2], acc[3]);
        *(LAS u32x2*)(VNO + (16 * nt + c16) * 72 + 16 * w + 4 * g) = v;
        const float s0 = acc[0] * e0, s1 = acc[1] * e1, s2 = acc[2] * e2, s3 = acc[3] * e3;
        if (dir) { v.x = pk2(s3, s2); v.y = pk2(s1, s0); *(LAS u32x2*)(VNS + (16 * nt + c16) * 72 + 60 - 16 * w - 4 * g) = v; }
        else { v.x = pk2(s0, s1); v.y = pk2(s2, s3); *(LAS u32x2*)(VNS + (16 * nt + c16) * 72 + 16 * w + 4 * g) = v; } }
    GDN_BARP(52);
    const float al = __expf(gl);
#pragma unroll
    for (int nt = 0; nt < GNT; ++nt) {
        const bf16x8 v0 = lds_frag(VNS, 72, 16 * nt, 0, lane), v1 = lds_frag(VNS, 72, 16 * nt, 32, lane);
#pragma unroll
        for (int x = 0; x < 2; ++x) { f32x4 s = accs[x][nt] * al; s = mma(o.k[2 * x], v0, s); s = mma(o.k[2 * x + 1], v1, s); accs[x][nt] = s;
            u32x2 v; v.x = pk2(s[0], s[1]); v.y = pk2(s[2], s[3]); *(LAS u32x2*)(ST + (16 * nt + c16) * 136 + 32 * w + 16 * x + 4 * g) = v; } }
    GDN_BARP(52);
}
__device__ __forceinline__ void gdn_step_o(const Ctx& A, const GdnO& o, LAS bf16* ST, LAS bf16* VNO, int p, int b, int h, int dir, const unsigned (&offo)[4], int lane) {
    f32x4 acc[GNT]; const float e0 = __expf(o.gc.x), e1 = __expf(o.gc.y), e2 = __expf(o.gc.z), e3 = __expf(o.gc.w);
#pragma unroll
    for (int nt = 0; nt < GNT; ++nt) { f32x4 a = {0.f, 0.f, 0.f, 0.f};
#pragma unroll
        for (int ks = 0; ks < 4; ++ks) a = mma(o.q[ks], lds_frag(ST, 136, 16 * nt, 32 * ks, lane), a);
        a[0] *= e0; a[1] *= e1; a[2] *= e2; a[3] *= e3; acc[nt] = a; }
    GDN_BARP(53);
    int item, m0; gdn_step_ids(p, b, h, dir, item, m0);
    char* og = (char*)A.ws() + WS_OG + (((size_t)dir * NTOK + m0) * 512 + h * 128) * 2;
#pragma unroll
    for (int nt = 0; nt < GNT; ++nt) { f32x4 a = acc[nt]; a = mma(o.p[0], lds_frag(VNO, 72, 16 * nt, 0, lane), a); a = mma(o.p[1], lds_frag(VNO, 72, 16 * nt, 32, lane), a);
#pragma unroll
        for (int r = 0; r < 4; ++r) *(bf16*)(og + offo[r] + 32 * nt) = (bf16)f2bf(a[r]); }
    GDN_BARP(53);
}
__device__ __forceinline__ void gdn_scan_chain(const Ctx& A, LAS unsigned char* lds, int chain, int sl, int tid, int lane, int wave) {
    LAS bf16* ST = (LAS bf16*)lds; LAS bf16* VNO = (LAS bf16*)(lds + 34816); LAS bf16* VNS = (LAS bf16*)(lds + 53248);
    const int g = lane >> 4, c16 = lane & 15, b = chain >> 3, h = (chain >> 1) & 3, dir = chain & 1, w4 = wave & 3;
    for (int i = tid; i < 16 * GNT * 136 / 2; i += NTHR) ((LAS unsigned*)ST)[i] = 0u;
    const unsigned offgc = (unsigned)(16 * w4 + 4 * g) * 4u;
    GDN_BAR();
    if (wave < 4) {
        const unsigned offw = (unsigned)((16 * w4 + c16) * 128 + 8 * g) * 2u, offk = (unsigned)((32 * w4 + c16) * 64 + 8 * g) * 2u, offu = (unsigned)((16 * GNT * sl + c16) * 64 + 16 * w4 + 4 * g) * 2u;
        f32x4 accs[2][GNT];
#pragma unroll
        for (int x = 0; x < 2; ++x)
#pragma unroll
            for (int nt = 0; nt < GNT; ++nt) accs[x][nt] = (f32x4){0.f, 0.f, 0.f, 0.f};
        GdnS o0, o1, o2;
        gdn_load_s(A, o0, 0, b, h, dir, offw, offk, offu, offgc); gdn_load_s(A, o1, 1, b, h, dir, offw, offk, offu, offgc);
#pragma unroll 1
        for (int p = 0; p < 66; p += 3) {
            gdn_load_s(A, o2, p + 2, b, h, dir, offw, offk, offu, offgc); gdn_step_s(o0, accs, ST, VNO, VNS, dir, w4, lane, g, c16);
            gdn_load_s(A, o0, p + 3, b, h, dir, offw, offk, offu, offgc); gdn_step_s(o1, accs, ST, VNO, VNS, dir, w4, lane, g, c16);
            gdn_load_s(A, o1, p + 4, b, h, dir, offw, offk, offu, offgc); gdn_step_s(o2, accs, ST, VNO, VNS, dir, w4, lane, g, c16);
        }
        gdn_step_s(o0, accs, ST, VNO, VNS, dir, w4, lane, g, c16); gdn_step_s(o1, accs, ST, VNO, VNS, dir, w4, lane, g, c16);
    } else {
        const int i = 16 * w4 + c16, t = dir ? 63 - i : i;
        const unsigned offq = (unsigned)(t * 512 + 8 * g) * 2u, offp = (unsigned)(i * 64 + 8 * g) * 2u; unsigned offo[4];
#pragma unroll
        for (int r = 0; r < 4; ++r) { const int io = 16 * w4 + 4 * g + r, to = dir ? 63 - io : io; offo[r] = (unsigned)(to * 512 + 16 * GNT * sl + c16) * 2u; }
        GdnO o0, o1, o2;
        gdn_load_o(A, o0, 0, b, h, dir, offq, offp, offgc); gdn_load_o(A, o1, 1, b, h, dir, offq, offp, offgc);
#pragma unroll 1
        for (int p = 0; p < 66; p += 3) {
            gdn_load_o(A, o2, p + 2, b, h, dir, offq, offp, offgc); gdn_step_o(A, o0, ST, VNO, p, b, h, dir, offo, lane);
            gdn_load_o(A, o0, p + 3, b, h, dir, offq, offp, offgc); gdn_step_o(A, o1, ST, VNO, p + 1, b, h, dir, offo, lane);
            gdn_load_o(A, o1, p + 4, b, h, dir, offq, offp, offgc); gdn_step_o(A, o2, ST, VNO, p + 2, b, h, dir, offo, lane);
        }
        gdn_step_o(A, o0, ST, VNO, 66, b, h, dir, offo, lane); gdn_step_o(A, o1, ST, VNO, 67, b, h, dir, offo, lane);
    }
    asm volatile("s_waitcnt vmcnt(0)" ::: "memory"); __syncthreads();
}
__device__ __forceinline__ void ph_gdn_finish(const Ctx& A, int l, int lane, int wave, int G, int nrows) {
    const int gw = blockIdx.x * NWAVES + wave, NGW = G * NWAVES;
    const bf16* OG = (const bf16*)(A.ws() + WS_OG); const bf16* cols = (const bf16*)(A.ws() + WS_COLS); bf16* MIX = (bf16*)(A.ws() + WS_MIX);
    const float* ng = A.in(IGDNN) + l * 128 + (lane & 15) * 8;
    const f32x4 n0 = *(const f32x4*)ng, n1 = *(const f32x4*)(ng + 4);
    for (int m0 = gw * 4; m0 < nrows; m0 += NGW * 4) {
        u32x4 fw[4], bw[4], zw[4];
#pragma unroll
        for (int q = 0; q < 4; ++q) { const int m = m0 + q; fw[q] = *(const u32x4*)(OG + (size_t)m * 512 + 8 * lane); bw[q] = *(const u32x4*)(OG + ((size_t)NTOK + m) * 512 + 8 * lane);
            zw[q] = *(const u32x4*)(cols + (size_t)m * DIN + C_GDN_Z + 8 * lane); }
#pragma unroll
        for (int q = 0; q < 4; ++q) { const int m = m0 + q; const u32x4 f = fw[q], b = bw[q];
            const f32x4 v0 = {bf2f(f.x & 0xffffu) + bf2f(b.x & 0xffffu), bf2f(f.x >> 16) + bf2f(b.x >> 16), bf2f(f.y & 0xffffu) + bf2f(b.y & 0xffffu), bf2f(f.y >> 16) + bf2f(b.y >> 16)};
            const f32x4 v1 = {bf2f(f.z & 0xffffu) + bf2f(b.z & 0xffffu), bf2f(f.z >> 16) + bf2f(b.z >> 16), bf2f(f.w & 0xffffu) + bf2f(b.w & 0xffffu), bf2f(f.w >> 16) + bf2f(b.w >> 16)};
            float ss = v0.x * v0.x + v0.y * v0.y + v0.z * v0.z + v0.w * v0.w + v1.x * v1.x + v1.y * v1.y + v1.z * v1.z + v1.w * v1.w;
            ss = row16_sum(ss);
            const float rs = rsqrtf(ss * (1.f / 128.f) + RMS_EPS); const u32x4 z = zw[q];
            float y[8];
            y[0] = v0.x * rs * n0.x * siluf_(bf2f(z.x & 0xffffu)); y[1] = v0.y * rs * n0.y * siluf_(bf2f(z.x >> 16));
            y[2] = v0.z * rs * n0.z * siluf_(bf2f(z.y & 0xffffu)); y[3] = v0.w * rs * n0.w * siluf_(bf2f(z.y >> 16));
            y[4] = v1.x * rs * n1.x * siluf_(bf2f(z.z & 0xffffu)); y[5] = v1.y * rs * n1.y * siluf_(bf2f(z.z >> 16));
            y[6] = v1.z * rs * n1.z * siluf_(bf2f(z.w & 0xffffu)); y[7] = v1.w * rs * n1.w * siluf_(bf2f(z.w >> 16));
            u32x4 o; o.x = pk2(y[0], y[1]); o.y = pk2(y[2], y[3]); o.z = pk2(y[4], y[5]); o.w = pk2(y[6], y[7]);
            *(u32x4*)(MIX + (size_t)m * D + 512 + 8 * lane) = o; }
    }
}

constexpr int NPH = 13;
#ifndef MK_MULTI
#define MK_MULTI 0
#endif
#ifndef PHMASK
#define PHMASK 0x1fff
#endif
#define IN(k) (((PHMASK >> (k)) & 1) && A.ph_lo <= (k) && (k) < A.ph_hi)
#define SEAM() do { if (fused) xcd_barrier(bar); } while (0)
#define PH_BEGIN() int tid = tid0; asm volatile("" : "+v"(tid)); int zz = 0; asm volatile("" : "+s"(zz)); const int lane = tid & 63, wave = __builtin_amdgcn_readfirstlane(tid >> 6); const Ctx C{&A, zz}; (void)lane; (void)wave
#ifdef PROBE_ID
#ifndef PROBE_ID2
#define PROBE_ID2 -1
#endif
#ifndef PROBE_ID3
#define PROBE_ID3 -1
#endif
#define PT0() const unsigned long long pt0_ = __builtin_amdgcn_s_memrealtime()
#define PT1(id) do { if ((id) == PROBE_ID || (id) == PROBE_ID2 || (id) == PROBE_ID3) { const unsigned long long pt1_ = __builtin_amdgcn_s_memrealtime(), dt_ = (pt1_ - pt0_) * 3ull; while (__builtin_amdgcn_s_memrealtime() - pt1_ < dt_) __builtin_amdgcn_s_sleep(16); } } while (0)
#else
#define PT0() do {} while (0)
#define PT1(id) do {} while (0)
#endif
#define CVT_TAIL(k, t0, nt) do { if constexpr (!last) { int tq_ = tid0; asm volatile("" : "+v"(tq_)); int z2_ = 0; asm volatile("" : "+s"(z2_)); const Ctx C2_{&A, z2_}; \
        cvt_drain(C2_, lds, l + 1, (t0), (nt), (unsigned*)(C2_.ws() + WS_CTL) + CW_CQ + (l * 4 + (k)) * 64, tq_, tq_ & 63, __builtin_amdgcn_readfirstlane(tq_ >> 6)); } } while (0)
constexpr int CVQ7 = 1200, CVQ10 = 200, CVQ11 = CV_TICKETS - CVQ7 - CVQ10;
constexpr int CV0_FIRST = (CV_IN + CV_OUT) / 8;
template <int L>
__device__ __forceinline__ void layer_body(const Args& A, LAS unsigned char* lds, const int tid0, const int G, const int vcu, const bool fused, const XcdBarrier& bar) {
    constexpr int l = L; constexpr bool last = (L == DEPTH - 1); constexpr int nrows = last ? NLAT : NTOK;
    if constexpr (L == 0) {
        if (IN(0)) { PH_BEGIN(); { PT0(); ph_mods(C, lds, tid, G); PT1(1); } { PT0(); cvt_drain(C, lds, 0, 0, CV0_FIRST, (unsigned*)(C.ws() + WS_CTL) + CW_CQ + 15 * 64, tid, lane, wave); PT1(0); } SEAM(); }
        if (IN(1)) { PH_BEGIN(); ph_init(C, lane, wave, G); SEAM(); }
    }
    if (IN(2)) { PH_BEGIN();
        pg8::Gemm g{(const bf16*)(C.ws() + WS_H), (const bf16*)(C.ws() + WS_WIN) + (size_t)l * DINP * D, NTOK, DINP, D};
        int Gp = G, cc = (int)blockIdx.x;
        if constexpr (L == 0) { if (G >= 256) { Gp = 176; if (cc >= Gp) cc = (NTOK / 256) * (DINP / 256); } }
        pg8::StaticOrder S; S.init(NTOK, DINP, Gp, cc);
        EpiCols E{(bf16*)(C.ws() + WS_COLS), (float*)(C.ws() + WS_GATES)};
        PT0(); pg8::gemm_phase<EpiCols, pg8::StaticOrder>(lds, g, S, E, nullptr, tid); PT1(2);
        if constexpr (L == 0) { int tq_ = tid0; asm volatile("" : "+v"(tq_)); int z2_ = 0; asm volatile("" : "+s"(z2_)); const Ctx C2_{&A, z2_};
            cvt_drain(C2_, lds, 0, CV0_FIRST, CV_TICKETS - CV0_FIRST, (unsigned*)(C2_.ws() + WS_CTL) + CW_CQ + 14 * 64, tq_, tq_ & 63, __builtin_amdgcn_readfirstlane(tq_ >> 6)); }
        SEAM();
    }
    if (IN(4)) { PH_BEGIN();
        { PT0(); LAS int* wq = (LAS int*)(lds + MISC_OFF + 512); unsigned* ctr = (unsigned*)(C.ws() + WS_CTL) + CW_PQ + l * 64;
          __syncthreads(); if (tid == 0) wq[0] = (int)atomicAdd(ctr, 1u); __syncthreads();
          for (int u = wq[0]; u < 1088 + 272; ) { int nxt = 0; if (tid == 0) nxt = (int)atomicAdd(ctr, 1u);
              int tq = tid; asm volatile("" : "+v"(tq));
              if (u >= 272) gdn_prep_item(C, l, lds, u - 272, tq, tq & 63, wave); else gla_a_chunk(C, l, lds, tq & 63, wave, u);
              __syncthreads(); if (tid == 0) wq[0] = nxt; __syncthreads(); u = wq[0]; }
          PT1(41); }
        SEAM();
    }
    if (IN(5)) { PH_BEGIN();
        { PT0(); if ((int)blockIdx.x < 128) gdn_scan_chain(C, lds, (int)(blockIdx.x & 7) + 8 * (int)(blockIdx.x >> 5), (int)(blockIdx.x >> 3) & 3, tid, lane, wave); else ph_gla_b(C, tid, blockIdx.x - 128, 128); PT1(50); }
        { PT0(); LAS int* wq = (LAS int*)(lds + MISC_OFF + 512); unsigned* ctr = (unsigned*)(C.ws() + WS_CTL) + CW_NAQ + l * 64; const int nun = last ? 1024 : 1088;
          __syncthreads(); if (tid == 0) wq[0] = (int)atomicAdd(ctr, 1u); __syncthreads();
          for (int u = wq[0]; u < nun; ) { int nxt = 0; if (tid == 0) nxt = (int)atomicAdd(ctr, 1u);
              int tq = tid; asm volatile("" : "+v"(tq));
              if (u < 1024) na_unit<false>(C, l, lds, u, tq, tq & 63, wave); else na_unit<true>(C, l, lds, u - 1024, tq, tq & 63, wave);
              __syncthreads(); if (tid == 0) wq[0] = nxt; __syncthreads(); u = wq[0]; }
          PT1(31); }
        SEAM();
    }
    if (IN(6)) { PH_BEGIN();
        { PT0(); ph_gla_c(C, l, lane, wave, G, last ? 2048 : 2176); PT1(60); }
        { PT0(); ph_gdn_finish(C, l, lane, wave, G, nrows); PT1(61); }
        SEAM();
    }
    if (IN(7)) { PH_BEGIN();
        pg8::Gemm g{(const bf16*)(C.ws() + WS_MIX), (const bf16*)(C.ws() + WS_WOUT) + (size_t)l * D * D, nrows, D, D};
        int Gp = G, cc = (int)blockIdx.x;
        if constexpr (!last) { constexpr int units = (nrows / 256) * (D / 256); const int rounds = (units + G - 1) / G; Gp = min(G, (((units + rounds - 1) / rounds) + 7) & ~7); if (cc >= Gp) cc = units; }
        pg8::StaticOrder S; S.init(nrows, D, Gp, cc);
        EpiOut E{(float*)(C.ws() + WS_X), (const float*)(C.ws() + WS_MODS) + (size_t)l * 5 * 6144};
        PT0(); pg8::gemm_phase<EpiOut, pg8::StaticOrder>(lds, g, S, E, nullptr, tid); PT1(7);
        CVT_TAIL(0, 0, CVQ7);
        SEAM();
    }
    if (IN(8)) { PH_BEGIN(); PT0(); ph_ln1_route(C, l, lds, tid, lane, wave, nrows); PT1(8); SEAM(); }
    if (IN(10)) { PH_BEGIN();
        LAS int* tab = (LAS int*)(lds + MISC_OFF + 1024);
        moe_tables((const unsigned*)(C.ws() + WS_CTL) + CW_CNT + l * 64, tab, tid);
        pg8::Gemm g{(const bf16*)(C.ws() + WS_H), (const bf16*)(C.ws() + WS_WGU) + (size_t)l * NE * 2048 * D, 0, 0, D};
        int Gp = G, cc = vcu; const int units = tab[40] * 8;
        if constexpr (!last) { if (G % 8 == 0) { const int rounds = (units + G - 1) / G; Gp = min(G, (((units + rounds - 1) / rounds) + 7) & ~7); const int gp8 = Gp >> 3, bx = (int)blockIdx.x; cc = (bx >> 3) < gp8 ? (bx & 7) * gp8 + (bx >> 3) : units; } }
        MoeOrder S{tab + 64, units, 8, Gp, cc, tab, (const int*)(C.ws() + WS_ETOK)};
        EpiAct E{(bf16*)(C.ws() + WS_ACT), C.in(IBGU) + (size_t)l * NE * 2048};
        PT0(); pg8::gemm_phase<EpiAct, MoeOrder, true>(lds, g, S, E, nullptr, tid); PT1(10);
        CVT_TAIL(1, CVQ7, CVQ10);
        SEAM();
    }
    if (IN(11)) { PH_BEGIN();
        LAS int* tab = (LAS int*)(lds + MISC_OFF + 1024);
        moe_tables((const unsigned*)(C.ws() + WS_CTL) + CW_CNT + l * 64, tab, tid);
        pg8::Gemm g{(const bf16*)(C.ws() + WS_ACT), (const bf16*)(C.ws() + WS_WD) + (size_t)l * NE * D * D, 0, 0, D};
        int Gp = G, cc = vcu; const int units = tab[40] * 4;
        if constexpr (!last) { if (G % 8 == 0) { const int rounds = (units + G - 1) / G; Gp = min(G, (((units + rounds - 1) / rounds) + 7) & ~7); const int gp8 = Gp >> 3, bx = (int)blockIdx.x; cc = (bx >> 3) < gp8 ? (bx & 7) * gp8 + (bx >> 3) : units; } }
        MoeOrder S{tab + 64, units, 4, Gp, cc, tab, (const int*)(C.ws() + WS_ETOK)};
        EpiY E{(bf16*)(C.ws() + WS_YB), C.in(IBD) + (size_t)l * NE * D};
        PT0(); pg8::gemm_phase<EpiY, MoeOrder>(lds, g, S, E, nullptr, tid); PT1(11);
        CVT_TAIL(2, CVQ7 + CVQ10, CVQ11);
        SEAM();
    }
    if (IN(12)) { PH_BEGIN(); PT0(); ph_combine(C, l, lds, tid, lane, wave, G, nrows); PT1(12); if (!last) SEAM(); }
}
__global__ void __launch_bounds__(NTHR, 2) fwd(Args A) {
    extern __shared__ __attribute__((aligned(16))) unsigned char lds_raw[];
    LAS unsigned char* lds = (LAS unsigned char*)lds_raw;
    const int tid0 = threadIdx.x, G = gridDim.x;
    volatile LAS unsigned* misc = (volatile LAS unsigned*)(lds + MISC_OFF);
    if (tid0 < 64) misc[tid0] = 0u;
    __syncthreads();
    unsigned* ctl = (unsigned*)(A.ws + WS_CTL);
    XcdBarrier bar = xcd_barrier_post(ctl + CW_BAR, misc + 8);
    const bool fused = (A.ph_hi - A.ph_lo) > 1;
    const int vcu = (G % 8 == 0) ? ((int)(blockIdx.x % 8) * (G / 8) + (int)(blockIdx.x / 8)) : (int)blockIdx.x;
    if (A.l_lo <= 0 && 0 < A.l_hi) layer_body<0>(A, lds, tid0, G, vcu, fused, bar);
    if (A.l_lo <= 1 && 1 < A.l_hi) layer_body<1>(A, lds, tid0, G, vcu, fused, bar);
    if (A.l_lo <= 2 && 2 < A.l_hi) layer_body<2>(A, lds, tid0, G, vcu, fused, bar);
    if (A.l_lo <= 3 && 3 < A.l_hi) layer_body<3>(A, lds, tid0, G, vcu, fused, bar);
}
#undef IN
#undef SEAM
#undef PH_BEGIN

extern "C" void kernel_launch(void* const* d_in, const int* in_sizes, int n_in, void* d_out, int out_size, void* d_ws, size_t ws_size, hipStream_t stream) {
    static int grid = 0;
    if (grid == 0) {
        if (n_in != NIN || out_size != NLAT * D || ws_size < WS_END) { fprintf(stderr, "kernel_launch: unexpected problem (n_in %d, out %d, ws %zu)\n", n_in, out_size, ws_size); grid = -1; return; }
        int dev = 0, cus = 0, per_cu = 0;
        if (hipGetDevice(&dev) != hipSuccess || hipDeviceGetAttribute(&cus, hipDeviceAttributeMultiprocessorCount, dev) != hipSuccess) { grid = -1; return; }
        if (hipFuncSetAttribute((const void*)fwd, hipFuncAttributeMaxDynamicSharedMemorySize, LDS_BYTES) != hipSuccess) { fprintf(stderr, "kernel_launch: hipFuncSetAttribute failed\n"); grid = -1; return; }
        if (hipOccupancyMaxActiveBlocksPerMultiprocessor(&per_cu, (const void*)fwd, NTHR, LDS_BYTES) != hipSuccess || per_cu < 1) fprintf(stderr, "kernel_launch: occupancy query says %d\n", per_cu);
        (void)hipGetLastError();
        grid = cus;
    }
    if (grid < 0) return;
    (void)hipMemsetAsync((char*)d_ws + WS_CTL, 0, CTL_BYTES, stream);
    Args a{};
    for (int i = 0; i < NIN; ++i) a.in[i] = (const float*)d_in[i];
    a.out = (float*)d_out; a.ws = (unsigned char*)d_ws;
#if MK_MULTI
    for (int l = 0; l < DEPTH; ++l)
        for (int ph = (l == 0 ? 0 : 2); ph < NPH; ++ph) { a.l_lo = l; a.l_hi = l + 1; a.ph_lo = ph; a.ph_hi = ph + 1;
            hipLaunchKernelGGL(fwd, dim3(grid), dim3(NTHR), LDS_BYTES, stream, a); }
#else
    a.l_lo = 0; a.l_hi = DEPTH; a.ph_lo = 0; a.ph_hi = NPH;
    hipLaunchKernelGGL(fwd, dim3(grid), dim3(NTHR), LDS_BYTES, stream, a);
#endif
}
```

```cpp
#include <hip/hip_runtime.h>
#include <cstdio>
#include <cstdint>

namespace pg8 {
#define PG8_LAS __attribute__((address_space(3)))
typedef unsigned short bf16_t;
typedef short bf16x8 __attribute__((ext_vector_type(8)));
typedef float f32x4 __attribute__((ext_vector_type(4)));
typedef unsigned u32x4 __attribute__((ext_vector_type(4)));
constexpr int BM = 256, BK = 64, HALF = 128, HTB = HALF * BK * 2  , STAGE_BYTES = 8 * HTB, NXCD = 8, WGM = 8;

__host__ __device__ __forceinline__ int lds_byte(int r, int c) { const int st = (r >> 4) * 2 + (c >> 5), rr = r & 15, cc = c & 31, ob = rr * 64 + cc * 2; return st * 1024 + (ob ^ (((ob >> 9) & 1) << 5)); }
__host__ __device__ __forceinline__ void stage_rc(int b, int& R, int& C) { const int st = b / 1024, sb = b % 1024, swz = sb ^ (((sb >> 9) & 1) << 5); R = (st >> 1) * 16 + swz / 64; C = (st & 1) * 32 + (swz % 64) / 2; }
__host__ __device__ __forceinline__ int perm32(int rho) { const int n = rho >> 4, i = rho & 15; return 8 * (i >> 2) + 4 * n + (i & 3); }

struct Unit { int pm, pn; };
struct Gemm { const bf16_t* A; const bf16_t* Bt; int M, N, K; };

struct StaticOrder {
    int nM, nN, nwg, G, c;
    __host__ __device__ void init(int M, int N, int G_, int c_) { nM = M / BM; nN = N / BM; nwg = nM * nN; G = G_; c = c_; }
    __host__ __device__ bool next(int i, Unit& u) const {
        const long L = (long)i * G + c; if (L >= nwg) return false;
        int wgid = (int)L; { const int q = nwg / NXCD, r = nwg % NXCD, xcd = wgid % NXCD, off = wgid / NXCD; wgid = (xcd < r ? xcd * (q + 1) : r * (q + 1) + (xcd - r) * q) + off; }
        const int nig = WGM * nN, gid = wgid / nig, fm = gid * WGM, gsz = (nM - fm) < WGM ? (nM - fm) : WGM;
        u.pm = fm + ((wgid % nig) % gsz); u.pn = (wgid % nig) / gsz; return true;
    }
    __device__ __forceinline__ void a_ready(const Unit&) const {}
    __device__ __forceinline__ void done(const Unit&) const {}
};
__device__ __forceinline__ unsigned cvt_pk_bf16(float lo, float hi) { unsigned r; asm volatile("v_cvt_pk_bf16_f32 %0, %1, %2" : "=v"(r) : "v"(lo), "v"(hi)); return r; }
template <class Epi, class Sched, bool GATHER = false, bool STAMP = false>
__device__ __forceinline__ void gemm_phase(PG8_LAS unsigned char* lds, const Gemm g, const Sched& S, const Epi& E, unsigned long long* stamps, const int tid) {
    const int wid = __builtin_amdgcn_readfirstlane(tid >> 6), lane = tid & 63, wr = wid >> 2, wc = wid & 3, fr = lane & 15, fq = lane >> 4;
    const int K = g.K, nt = K / BK;
    int ts_lo = 0, ts_hi = 0, nts = 0; const unsigned long long rt_entry = STAMP ? (unsigned long long)wall_clock64() : 0ull;
#define PG8_STAMP() do { if (STAMP && wid == 0 && nts < 64) { const unsigned long long _c = (unsigned long long)clock64(); \
        ts_lo = (lane == nts) ? (int)(unsigned)_c : ts_lo; ts_hi = (lane == nts) ? (int)(unsigned)(_c >> 32) : ts_hi; ++nts; } } while (0)
    PG8_STAMP();
    unsigned voffA[2], voffB[2]; int rowA[2];
#pragma unroll
    for (int i = 0; i < 2; ++i) { int R, C; stage_rc(tid * 16 + i * 8192, R, C); const int Rb = Epi::PERM ? ((R & ~31) + perm32(R & 31)) : R;
        voffA[i] = (unsigned)(R * K + C) * 2u; voffB[i] = (unsigned)(Rb * K + C) * 2u; rowA[i] = R; }
    unsigned vAc[2][2], vAn[2][2];
    const size_t kstep = (size_t)(BK * 2);
    const size_t hstep = (size_t)HALF * K * 2;
    const size_t tstep = 2 * hstep;
    const unsigned ldsw = (unsigned)wid * 1024u;
    const int aoff = lds_byte(wr * 64 + fr, fq * 8), boff = lds_byte(wc * 32 + fr, fq * 8);
#define PG8_SA(b, h) (((b) * 2 + (h)) * HTB)
#define PG8_SB(b, h) ((4 + (b) * 2 + (h)) * HTB)
#define PG8_STAGE(bufoff, gbase, voff) do { _Pragma("unroll") for (int _i = 0; _i < 2; ++_i) \
        __builtin_amdgcn_global_load_lds((const unsigned*)((const char*)(gbase) + (voff)[_i]), (PG8_LAS unsigned*)(lds + (bufoff) + ldsw + _i * 8192), 16, 0, 0); } while (0)
#define PG8_GOFF(dstv, u) do { _Pragma("unroll") for (int _h = 0; _h < 2; ++_h) _Pragma("unroll") for (int _i = 0; _i < 2; ++_i) \
        dstv[_h][_i] = (unsigned)S.a_row(u, _h * HALF + rowA[_i]) * (unsigned)(K * 2) + (voffA[_i] - (unsigned)(rowA[_i] * K * 2)); } while (0)
#define PG8_STAGE_A(bufoff, usenext, h, kb) do { if constexpr (GATHER) { const unsigned _o0 = (usenext) ? vAn[h][0] : vAc[h][0], _o1 = (usenext) ? vAn[h][1] : vAc[h][1]; const char* _gb = (const char*)g.A + (kb); \
        __builtin_amdgcn_global_load_lds((const unsigned*)(_gb + _o0), (PG8_LAS unsigned*)(lds + (bufoff) + ldsw), 16, 0, 0); \
        __builtin_amdgcn_global_load_lds((const unsigned*)(_gb + _o1), (PG8_LAS unsigned*)(lds + (bufoff) + ldsw + 8192), 16, 0, 0); } \
    else { const char* _gb = ((usenext) ? nA : cA) + (h) * hstep + (kb); PG8_STAGE(bufoff, _gb, voffA); } } while (0)
#define PG8_LDA(dst, b, h) do { _Pragma("unroll") for (int m = 0; m < 4; ++m) _Pragma("unroll") for (int k = 0; k < 2; ++k) dst[m][k] = *(const PG8_LAS bf16x8*)(lds + PG8_SA(b, h) + aoff + m * 2048 + k * 1024); } while (0)
#define PG8_LDB(dst, b, h) do { _Pragma("unroll") for (int n = 0; n < 2; ++n) _Pragma("unroll") for (int k = 0; k < 2; ++k) dst[n][k] = *(const PG8_LAS bf16x8*)(lds + PG8_SB(b, h) + boff + n * 2048 + k * 1024); } while (0)
#define PG8_MMA(ai, bj, At, Bt) do { __builtin_amdgcn_s_setprio(1); _Pragma("unroll") for (int m = 0; m < 4; ++m) _Pragma("unroll") for (int n = 0; n < 2; ++n) _Pragma("unroll") for (int k = 0; k < 2; ++k) \
        acc[ai][bj][m][n] = __builtin_amdgcn_mfma_f32_16x16x32_bf16(Bt[n][k], At[m][k], acc[ai][bj][m][n], 0, 0, 0); __builtin_amdgcn_s_setprio(0); } while (0)
#define PG8_WAIT_V(n) asm volatile("s_waitcnt vmcnt(" #n ")" ::: "memory")
#define PG8_WAIT_L(n) asm volatile("s_waitcnt lgkmcnt(" #n ")" ::: "memory")
#define PG8_BAR __builtin_amdgcn_s_barrier()
#define PG8_SCHED __builtin_amdgcn_sched_barrier(0)
    Unit cur, nxt; int ui = 0;
    if (!S.next(0, cur)) return;
    f32x4 acc[2][2][4][2];
#pragma unroll
    for (int a = 0; a < 2; ++a)
#pragma unroll
        for (int b = 0; b < 2; ++b)
#pragma unroll
            for (int m = 0; m < 4; ++m)
#pragma unroll
                for (int n = 0; n < 2; ++n) acc[a][b][m][n] = (f32x4){0.f, 0.f, 0.f, 0.f};
    bf16x8 At[4][2], B0[2][2], B1[2][2];
    const char* cA = (const char*)g.A + (size_t)cur.pm * tstep; const char* cB = (const char*)g.Bt + (size_t)cur.pn * tstep; const char* nA = cA;
    S.a_ready(cur);
    if constexpr (GATHER) { PG8_GOFF(vAc, cur); PG8_GOFF(vAn, cur); }
    PG8_STAGE(PG8_SB(0, 0), cB, voffB); PG8_STAGE_A(PG8_SA(0, 0), false, 0, (size_t)0); PG8_STAGE(PG8_SB(0, 1), cB + hstep, voffB); PG8_STAGE_A(PG8_SA(0, 1), false, 1, (size_t)0);
    if (wr == 1) PG8_BAR;
    PG8_WAIT_V(4); PG8_BAR;
    PG8_STAGE(PG8_SB(1, 0), cB + kstep, voffB); PG8_STAGE_A(PG8_SA(1, 0), false, 0, kstep); PG8_STAGE(PG8_SB(1, 1), cB + hstep + kstep, voffB);
    PG8_WAIT_V(6); PG8_BAR;
    PG8_STAMP();
    for (;;) {
        const bool has_next = S.next(ui + 1, nxt);
        nA = has_next ? (const char*)g.A + (size_t)nxt.pm * tstep : cA;
        if constexpr (GATHER) { if (has_next) PG8_GOFF(vAn, nxt); }
        const char* nB = has_next ? (const char*)g.Bt + (size_t)nxt.pn * tstep : cB;
        for (int t = 0; t < nt; t += 2) {
            const bool last = (t == nt - 2);
            const size_t k1 = (size_t)(t + 1) * kstep, k2 = last ? (size_t)0 : (size_t)(t + 2) * kstep;
            const char* b2 = last ? nB : cB + (size_t)(t + 2) * kstep; const char* b3 = b2 + kstep;
            if (last && has_next) S.a_ready(nxt);
            PG8_LDB(B0, 0, 0); PG8_SCHED; PG8_LDA(At, 0, 0); PG8_STAGE_A(PG8_SA(1, 1), false, 1, k1);
            PG8_WAIT_L(8); PG8_BAR; PG8_WAIT_L(0); PG8_MMA(0, 0, At, B0); PG8_BAR; PG8_SCHED;
            PG8_LDB(B1, 0, 1); PG8_STAGE(PG8_SB(0, 0), b2, voffB);
            PG8_BAR; PG8_WAIT_L(0); PG8_MMA(0, 1, At, B1); PG8_BAR;
            PG8_LDA(At, 0, 1); PG8_STAGE_A(PG8_SA(0, 0), last, 0, k2);
            PG8_BAR; PG8_WAIT_L(0); PG8_MMA(1, 0, At, B0); PG8_BAR; PG8_SCHED;
            PG8_STAGE(PG8_SB(0, 1), b2 + hstep, voffB);
            PG8_WAIT_V(6); PG8_BAR; PG8_MMA(1, 1, At, B1); PG8_BAR;
            PG8_LDB(B0, 1, 0); PG8_SCHED; PG8_LDA(At, 1, 0); PG8_STAGE_A(PG8_SA(0, 1), last, 1, k2);
            PG8_WAIT_L(8); PG8_BAR; PG8_WAIT_L(0); PG8_MMA(0, 0, At, B0); PG8_BAR; PG8_SCHED;
            PG8_LDB(B1, 1, 1); PG8_STAGE(PG8_SB(1, 0), b3, voffB);
            PG8_BAR; PG8_WAIT_L(0); PG8_MMA(0, 1, At, B1); PG8_BAR;
            PG8_LDA(At, 1, 1); PG8_STAGE_A(PG8_SA(1, 0), last, 0, k2 + kstep);
            PG8_BAR; PG8_WAIT_L(0); PG8_MMA(1, 0, At, B0); PG8_BAR; PG8_SCHED;
            PG8_STAGE(PG8_SB(1, 1), b3 + hstep, voffB);
            PG8_WAIT_V(6); PG8_BAR; PG8_MMA(1, 1, At, B1); PG8_BAR;
        }
        PG8_STAMP();
        if constexpr (!Epi::AFTER_DRAIN) { E(acc, cur, wr, wc, fr, fq); S.done(cur); }
        PG8_STAMP();
        if (!has_next) break;
#pragma unroll
        for (int a = 0; a < 2; ++a)
#pragma unroll
            for (int b = 0; b < 2; ++b)
#pragma unroll
                for (int m = 0; m < 4; ++m)
#pragma unroll
                    for (int n = 0; n < 2; ++n) acc[a][b][m][n] = (f32x4){0.f, 0.f, 0.f, 0.f};
        cur = nxt; cA = nA; cB = nB; ++ui;
        if constexpr (GATHER) { _Pragma("unroll") for (int _h = 0; _h < 2; ++_h) _Pragma("unroll") for (int _i = 0; _i < 2; ++_i) vAc[_h][_i] = vAn[_h][_i]; }
    }
    PG8_WAIT_V(0);
    if (wr == 0) PG8_BAR;
    PG8_BAR;
    if constexpr (Epi::AFTER_DRAIN) { E.fused(acc, cur, wr, wc, fr, fq, lds, wid, lane); S.done(cur); }
    PG8_STAMP();
    if (STAMP && wid == 0) { stamps[lane] = lane < nts ? (((unsigned long long)(unsigned)ts_hi << 32) | (unsigned)ts_lo) : 0ull;
        if (lane == 62) stamps[62] = rt_entry; if (lane == 63) stamps[63] = (unsigned long long)wall_clock64(); }
#undef PG8_STAMP
#undef PG8_SA
#undef PG8_SB
#undef PG8_STAGE
#undef PG8_GOFF
#undef PG8_STAGE_A
#undef PG8_LDA
#undef PG8_LDB
#undef PG8_MMA
#undef PG8_WAIT_V
#undef PG8_WAIT_L
#undef PG8_BAR
#undef PG8_SCHED
}
}
#define XB_TMO      128
#define XB_XCNT(j)  (256  + 64 * (j))
#define XB_XSUB(j)  (1280 + 64 * (j))
#define XB_XGEN(j)  (2304 + 64 * (j))
#define XB_TOP      3328
#define XB_TOPGEN   3392
#define XCD_BAR_WORDS 3456
#define XB_SPIN_CAP (1u << 18)
#define LAS __attribute__((address_space(3)))

__device__ __forceinline__ unsigned xb_ld(unsigned* p)              { return __hip_atomic_load(p, __ATOMIC_RELAXED, __HIP_MEMORY_SCOPE_AGENT); }
__device__ __forceinline__ unsigned xb_add(unsigned* p, unsigned v) { return __hip_atomic_fetch_add(p, v, __ATOMIC_RELAXED, __HIP_MEMORY_SCOPE_AGENT); }
__device__ __forceinline__ unsigned xb_xcc_id() { return (unsigned)__builtin_amdgcn_s_getreg((3 << 11) | 20) & 0xFu; }
#define XB_SPIN(cond, bar) do { unsigned _sp = 0; while (cond) { __builtin_amdgcn_s_sleep(1); \
    if ((++_sp & 255u) == 0u) { if (xb_ld(&(bar)[XB_TMO])) break; if (_sp > XB_SPIN_CAP) { atomicAdd(&(bar)[XB_TMO], 1u); break; } } } } while (0)

struct XcdBarrier {
    unsigned* bar; unsigned x;
    volatile LAS unsigned* st;
};

__device__ __forceinline__ XcdBarrier xcd_barrier_post(unsigned* bar, volatile LAS unsigned* st) {
    XcdBarrier b; b.bar = bar; b.x = xb_xcc_id(); b.st = st;
    if (threadIdx.x == 0) (void)xb_add(&bar[XB_XCNT(b.x)], 1u);
    return b;
}
__device__ __forceinline__ void xcd_barrier_complete(unsigned* bar, unsigned x, unsigned& nloc, unsigned& nx) {
    const unsigned G = gridDim.x * gridDim.y * gridDim.z;
    unsigned sum, cnt, mine, sp = 0u;
    for (;;) {
        sum = 0u; cnt = 0u; mine = 0u;
#pragma unroll
        for (unsigned j = 0; j < 16; ++j) { const unsigned c = xb_ld(&bar[XB_XCNT(j)]); sum += c; cnt += (c > 0u) ? 1u : 0u; mine = (j == x) ? c : mine; }
        if (sum == G) break;
        __builtin_amdgcn_s_sleep(1);
        if ((++sp & 255u) == 0u) { if (xb_ld(&bar[XB_TMO])) break; if (sp > XB_SPIN_CAP) { atomicAdd(&bar[XB_TMO], 1u); break; } }
    }
    nloc = mine > 0u ? mine : 1u; nx = cnt > 0u ? cnt : 1u;
}

__device__ __forceinline__ void xcd_barrier(const XcdBarrier& b) {
    asm volatile("s_waitcnt vmcnt(0)" ::: "memory");
    __syncthreads();
    if (threadIdx.x == 0) {
        unsigned* bar = b.bar;
        __builtin_amdgcn_s_waitcnt(0);
        unsigned nloc = b.st[0], nx = b.st[1];
        if (nloc == 0u) { xcd_barrier_complete(bar, b.x, nloc, nx); b.st[0] = nloc; b.st[1] = nx; }
        const unsigned old = xb_add(&bar[XB_XSUB(b.x)], 1u);
        const unsigned gen = old / nloc;
        if (old + 1u == (gen + 1u) * nloc) {
            __builtin_amdgcn_fence(__ATOMIC_RELEASE, "agent");
            asm volatile("s_waitcnt vmcnt(0)" ::: "memory");
            const unsigned og = xb_add(&bar[XB_TOP], 1u);
            const unsigned tg = og / nx;
            if (og + 1u == (tg + 1u) * nx) xb_add(&bar[XB_TOPGEN], 1u);
            else XB_SPIN(xb_ld(&bar[XB_TOPGEN]) == tg, bar);
            __builtin_amdgcn_fence(__ATOMIC_ACQUIRE, "agent");
            xb_add(&bar[XB_XGEN(b.x)], 1u);
            asm volatile("s_waitcnt vmcnt(0)" ::: "memory");
        } else {
            XB_SPIN(xb_ld(&bar[XB_XGEN(b.x)]) == gen, bar);
            __builtin_amdgcn_fence(__ATOMIC_ACQUIRE, "agent");
            asm volatile("s_waitcnt vmcnt(0)" ::: "memory");
        }
    }
    __syncthreads();
}


#define GAS __attribute__((address_space(1)))
typedef unsigned short bf16;
typedef short bf16x8 __attribute__((ext_vector_type(8)));
typedef float f32x4 __attribute__((ext_vector_type(4)));
typedef unsigned u32x4 __attribute__((ext_vector_type(4)));
typedef unsigned u32x2 __attribute__((ext_vector_type(2)));

constexpr int D = 1024, NB = 4, SEQ = 4096, CTXL = 256, DEPTH = 4;
constexpr int NLAT = NB * SEQ, NCTX = NB * CTXL, NTOK = NLAT + NCTX;
constexpr int DIN = 3632, DINP = 3840;
constexpr int C_GLA_Q = 0, C_GLA_K = 128, C_GLA_V = 256, C_GLA_A = 512, C_GLA_G = 544;
constexpr int C_NA_Q = 800, C_NA_K = 1056, C_NA_V = 1312;
constexpr int C_GDN_Q = 1568, C_GDN_K = 2080, C_GDN_V = 2592, C_GDN_B = 3104, C_GDN_A = 3112, C_GDN_Z = 3120;
constexpr int NE = 32, TOPK = 4, MAXRB = 304;
constexpr float DN_ALPHA = 1.681792830507429f;
constexpr float LN_EPS = 1e-5f, RMS_EPS = 1e-6f;
constexpr int NWAVES = 8, NTHR = 512;

enum { IX = 0, IC, ICTX, ICCTX, IWADA, IBADA, IWIN, IGLAW, IGLAB, IGLAN, IRPB, ICONV, IALOG, IDTB, IGDNN, IWOUT, ILN1G, ILN1B, IWR, IBR, IWGU, IBGU, IWD, IBD, ILN2G, ILN2B, NIN };

constexpr size_t MiB = 1u << 20;
constexpr size_t WS_CTL = 0, CTL_BYTES = 1 * MiB;
constexpr size_t WS_MODS = 1 * MiB;
constexpr size_t WS_WIN = 2 * MiB;
constexpr size_t WS_WOUT = 32 * MiB;
constexpr size_t WS_WGU = 40 * MiB;
constexpr size_t WS_WD = 552 * MiB;
constexpr size_t WS_X = 808 * MiB;
constexpr size_t WS_H = 876 * MiB;
constexpr size_t WS_COLS = 910 * MiB;
constexpr size_t WS_GATES = 1032 * MiB;
constexpr size_t WS_GQ = 1036 * MiB, WS_GK = 1053 * MiB, WS_GV = 1070 * MiB;
constexpr size_t WS_GG = 1087 * MiB, WS_GB = 1088 * MiB;
constexpr size_t WS_MIX = 1089 * MiB;
constexpr size_t WS_SD = 1123 * MiB;
constexpr size_t WS_SA = 1157 * MiB;
constexpr size_t WS_GU = 1158 * MiB, WS_GW = 1192 * MiB;
constexpr size_t WS_GKT = 1226 * MiB;
constexpr size_t WS_GQKM = 1294 * MiB;
constexpr size_t WS_GCB = 1311 * MiB;
constexpr size_t WS_OG = 1313 * MiB;
constexpr size_t WS_TOKE = 1381 * MiB, WS_TOKP = 1382 * MiB, WS_TOKG = 1383 * MiB, WS_TOKS = 1384 * MiB;
constexpr size_t WS_LG = 1385 * MiB;
constexpr size_t WS_TG = 1419 * MiB;
constexpr size_t WS_XB = 1436 * MiB;
constexpr size_t WS_ACT = 1588 * MiB;
constexpr size_t WS_YB = 1740 * MiB;
constexpr size_t WS_SS = 1892 * MiB;
constexpr size_t WS_OI = 1926 * MiB;
constexpr size_t WS_QTG = 1944 * MiB;
constexpr size_t WS_ROPE = 1953 * MiB;
constexpr size_t WS_WRT = 1953 * MiB + 65536;
constexpr size_t WS_ETOK = 1954 * MiB;
constexpr size_t WS_WRH = 1993 * MiB, WS_WRL = 1993 * MiB + 262144;
constexpr size_t WS_HL = 1959 * MiB;
constexpr size_t WS_DUMMY = 1957 * MiB;
constexpr size_t WS_END = 1994 * MiB;
constexpr int CW_BAR = 4096;
constexpr int CW_NAQ = 20480;
constexpr int CW_PQ = 24576;
constexpr int CW_CQ = 28672;
constexpr int CW_CNT = 16384;

constexpr int LDS_BYTES = 147456;
constexpr int MISC_OFF = 143360;

struct Args { const float* in[NIN]; float* out; unsigned char* ws; int l_lo, l_hi, ph_lo, ph_hi; };
struct Ctx { const Args* a; int z;
    __device__ __forceinline__ const float* in(int i) const { return a->in[i + z]; }
    __device__ __forceinline__ unsigned char* ws() const { return a->ws + z; }
    __device__ __forceinline__ float* out() const { return a->out + z; } };

__device__ __forceinline__ float bf2f(unsigned u) { return __uint_as_float(u << 16); }
typedef __bf16 bf16x2_t __attribute__((ext_vector_type(2)));
typedef float f32x2_t __attribute__((ext_vector_type(2)));
__device__ __forceinline__ unsigned f2bf(float f) { return (unsigned)__builtin_bit_cast(unsigned short, (__bf16)f); }
__device__ __forceinline__ unsigned pk2(float lo, float hi) { const f32x2_t f = {lo, hi}; return __builtin_bit_cast(unsigned, __builtin_convertvector(f, bf16x2_t)); }
template <int CTRL> __device__ __forceinline__ float dppf(float v) { return __int_as_float(__builtin_amdgcn_update_dpp(0, __float_as_int(v), CTRL, 0xF, 0xF, true)); }
__device__ __forceinline__ float row16_sum(float v) { v += dppf<0xB1>(v); v += dppf<0x4E>(v); v += dppf<0x141>(v); v += dppf<0x140>(v); return v; }
__device__ __forceinline__ float row16_max(float v) { v = fmaxf(v, dppf<0xB1>(v)); v = fmaxf(v, dppf<0x4E>(v)); v = fmaxf(v, dppf<0x141>(v)); v = fmaxf(v, dppf<0x140>(v)); return v; }
__device__ __forceinline__ float rows_sum(float v) { return __int_as_float(__builtin_amdgcn_readlane(__float_as_int(v), 0)) + __int_as_float(__builtin_amdgcn_readlane(__float_as_int(v), 16))
                                                          + __int_as_float(__builtin_amdgcn_readlane(__float_as_int(v), 32)) + __int_as_float(__builtin_amdgcn_readlane(__float_as_int(v), 48)); }
__device__ __forceinline__ float wsum(float v) { return rows_sum(row16_sum(v)); }
__device__ __forceinline__ float wmax(float v) { v = row16_max(v); return fmaxf(fmaxf(__int_as_float(__builtin_amdgcn_readlane(__float_as_int(v), 0)), __int_as_float(__builtin_amdgcn_readlane(__float_as_int(v), 16))),
                                                                                   fmaxf(__int_as_float(__builtin_amdgcn_readlane(__float_as_int(v), 32)), __int_as_float(__builtin_amdgcn_readlane(__float_as_int(v), 48)))); }
__device__ __forceinline__ float sigmoidf_(float x) { return __builtin_amdgcn_rcpf(1.f + __expf(-x)); }
__device__ __forceinline__ float siluf_(float x) { return x * __builtin_amdgcn_rcpf(1.f + __expf(-x)); }
__device__ __forceinline__ float softplusf_(float x) { return fmaxf(x, 0.f) + log1pf(__expf(-fabsf(x))); }
__device__ __forceinline__ float logsigmoidf_(float x) { return fminf(x, 0.f) - log1pf(__expf(-fabsf(x))); }
#define WAVE_SYNC() do { asm volatile("s_waitcnt lgkmcnt(0)" ::: "memory"); __builtin_amdgcn_wave_barrier(); } while (0)
#define BLOCK_SYNC() do { __threadfence_block(); __syncthreads(); } while (0)
#define LBAR() do { asm volatile("s_waitcnt lgkmcnt(0)" ::: "memory"); __builtin_amdgcn_s_barrier(); asm volatile("" ::: "memory"); } while (0)

__device__ __forceinline__ bf16x8 lds_frag(const LAS bf16* base, int stride, int row0, int k0, int lane) {
    return *(const LAS bf16x8*)(base + (row0 + (lane & 15)) * stride + k0 + 8 * (lane >> 4));
}
__device__ __forceinline__ f32x4 mma(bf16x8 a, bf16x8 b, f32x4 c) { return __builtin_amdgcn_mfma_f32_16x16x32_bf16(a, b, c, 0, 0, 0); }

__device__ __forceinline__ int mod_row(int m) { return m < NLAT ? (m >> 12) : 4; }

__device__ __forceinline__ void row_ln(f32x4 (&v)[4]) {
    float s = 0.f;
#pragma unroll
    for (int j = 0; j < 4; ++j) s += (v[j].x + v[j].y) + (v[j].z + v[j].w);
    const float mean = wsum(s) * (1.f / D);
    float s2 = 0.f;
#pragma unroll
    for (int j = 0; j < 4; ++j) { v[j] = v[j] - mean; s2 += (v[j].x * v[j].x + v[j].y * v[j].y) + (v[j].z * v[j].z + v[j].w * v[j].w); }
    const float rstd = rsqrtf(wsum(s2) * (1.f / D) + LN_EPS);
#pragma unroll
    for (int j = 0; j < 4; ++j) v[j] = v[j] * rstd;
}
__device__ __forceinline__ void row_store_bf16(bf16* row, const f32x4 (&v)[4], int lane) {
    u32x2* o = (u32x2*)row + lane;
#pragma unroll
    for (int j = 0; j < 4; ++j) { u32x2 w; w.x = pk2(v[j].x, v[j].y); w.y = pk2(v[j].z, v[j].w); o[64 * j] = w; }
}

__device__ __forceinline__ void ph_mods(const Ctx& A, LAS unsigned char* lds, int tid, int G) {
    LAS float* sc = (LAS float*)lds;
    LAS float* red = (LAS float*)(lds + 20480);
    const float* c = A.in(IC); const float* cc = A.in(ICCTX);
    for (int i = tid; i < 5 * D; i += NTHR) { const int r = i >> 10, k = i & 1023; const float v = r < 4 ? c[r * D + k] : cc[k]; sc[i] = siluf_(v); }
    __syncthreads();
    float* mods = (float*)(A.ws() + WS_MODS);
    if (blockIdx.x == 0) { float* rope = (float*)(A.ws() + WS_ROPE); const int pos = tid >> 3, j = tid & 7; float sn, cs;
        sincosf((float)pos * expf(-(float)j * 1.1512925464970229f), &sn, &cs); rope[tid * 2] = cs; rope[tid * 2 + 1] = sn; }
    { bf16* wrh = (bf16*)(A.ws() + WS_WRH); bf16* wrl = (bf16*)(A.ws() + WS_WRL);
      for (int i = blockIdx.x * NTHR + tid; i < DEPTH * D * NE; i += G * NTHR) { const int ll = i >> 15, e = (i >> 10) & 31, k = i & 1023; const float w = A.in(IWR)[((size_t)ll * D + k) * NE + e];
          const unsigned hi = f2bf(w); wrh[i] = (bf16)hi; wrl[i] = (bf16)f2bf(w - bf2f(hi)); } }
    const int col = tid & 63, kg = tid >> 6;
    for (int item = blockIdx.x; item < DEPTH * 96; item += G) {
        const int l = item / 96, n0 = (item % 96) * 64;
        const float* w = A.in(IWADA) + ((size_t)l * D + kg * 128) * 6144 + n0 + col;
        float a0 = 0.f, a1 = 0.f, a2 = 0.f, a3 = 0.f, a4 = 0.f;
#pragma unroll 32
        for (int k = 0; k < 128; ++k) { const float wv = __builtin_nontemporal_load(w + (size_t)k * 6144); const int kk = kg * 128 + k;
            a0 += sc[kk] * wv; a1 += sc[D + kk] * wv; a2 += sc[2 * D + kk] * wv; a3 += sc[3 * D + kk] * wv; a4 += sc[4 * D + kk] * wv; }
        red[(kg * 5 + 0) * 64 + col] = a0; red[(kg * 5 + 1) * 64 + col] = a1; red[(kg * 5 + 2) * 64 + col] = a2; red[(kg * 5 + 3) * 64 + col] = a3; red[(kg * 5 + 4) * 64 + col] = a4;
        __syncthreads();
        if (tid < 320) { const int r = tid >> 6, cl = tid & 63; float s = 0.f;
#pragma unroll
            for (int g = 0; g < 8; ++g) s += red[(g * 5 + r) * 64 + cl];
            mods[((size_t)l * 5 + r) * 6144 + n0 + cl] = s + A.in(IBADA)[l * 6144 + n0 + cl]; }
        __syncthreads();
    }
}

constexpr int CV_IN = 16 * 60, CV_OUT = 16 * 16, CV_GU = NE * 16 * 32, CV_D = NE * 16 * 16, CV_ITEMS = CV_IN + CV_OUT + CV_GU + CV_D, CV_TICKETS = CV_ITEMS / 8;
struct CvtJob { const float* wp; bf16* dst; int N; bool ok; };
__device__ __forceinline__ CvtJob cvt_decode(const Ctx& A, int l, int r, int lane) {
    const float* W; int N, k0, src0; bf16* dst;
    if (r < CV_IN) { const int nb = r % 60, kb = r / 60; W = A.in(IWIN) + (size_t)l * D * DIN; N = DIN; k0 = kb * 64; src0 = nb * 64; dst = (bf16*)(A.ws() + WS_WIN) + ((size_t)l * DINP + nb * 64) * D; }
    else if (r < CV_IN + CV_OUT) { r -= CV_IN; const int nb = r % 16, kb = r / 16; W = A.in(IWOUT) + (size_t)l * D * D; N = D; k0 = kb * 64; src0 = nb * 64; dst = (bf16*)(A.ws() + WS_WOUT) + ((size_t)l * D + nb * 64) * D; }
    else if (r < CV_IN + CV_OUT + CV_GU) { r -= CV_IN + CV_OUT; const int nb = r % 32, kb = (r / 32) % 16, le = l * NE + r / 512; const int j = nb >> 2, q = nb & 3;
        W = A.in(IWGU) + (size_t)le * D * 2048; N = 2048; k0 = kb * 64; src0 = (q < 2) ? (128 * j + 64 * q) : (1024 + 128 * j + 64 * (q - 2)); dst = (bf16*)(A.ws() + WS_WGU) + ((size_t)le * 2048 + nb * 64) * D; }
    else { r -= CV_IN + CV_OUT + CV_GU; const int nb = r % 16, kb = (r / 16) % 16, le = l * NE + r / 256; W = A.in(IWD) + (size_t)le * D * D; N = D; k0 = kb * 64; src0 = nb * 64; dst = (bf16*)(A.ws() + WS_WD) + ((size_t)le * D + nb * 64) * D; }
    CvtJob j; j.ok = (src0 + lane) < N; j.N = N; j.dst = dst + k0;
    j.wp = W + (size_t)k0 * N + (j.ok ? src0 + lane : 0);
    return j;
}
__device__ __forceinline__ void cvt_drain(const Ctx& A, LAS unsigned char* lds, int l, int t0, int nt, unsigned* ctr, int tid, int lane, int wave) {
    LAS int* wq = (LAS int*)(lds + MISC_OFF + 512); LAS float* scr = (LAS float*)(lds + wave * 16640);
    __syncthreads(); if (tid == 0) { const int f = (int)atomicAdd(ctr, 2u); wq[0] = f; wq[1] = f + 1; } __syncthreads();
    int cur = __builtin_amdgcn_readfirstlane(wq[0]), nxt = __builtin_amdgcn_readfirstlane(wq[1]);
    int zv = 0; asm volatile("" : "+v"(zv)); unsigned* ctrv = ctr + zv;
    float v[64]; CvtJob jc = cvt_decode(A, l, (t0 + min(cur, nt - 1)) * 8 + wave, lane);
    if (cur < nt) {
#pragma unroll
        for (int kk = 0; kk < 64; ++kk) v[kk] = jc.wp[(size_t)kk * jc.N]; }
    while (cur < nt) {
        int nn = 0; if (tid == 0) nn = (int)atomicAdd(ctrv, 1u);
#pragma unroll
        for (int kk = 0; kk < 64; ++kk) scr[kk * 65 + lane] = jc.ok ? v[kk] : 0.f;
        bf16* dst = jc.dst;
        if (nxt < nt) { jc = cvt_decode(A, l, (t0 + nxt) * 8 + wave, lane);
#pragma unroll
            for (int kk = 0; kk < 64; ++kk) v[kk] = jc.wp[(size_t)kk * jc.N]; }
        WAVE_SYNC();
        const int c = lane & 7;
#pragma unroll
        for (int j = 0; j < 8; ++j) { const int n = (lane >> 3) + 8 * j; const LAS float* sp = scr + (8 * c) * 65 + n;
            u32x4 o; o.x = pk2(sp[0], sp[65]); o.y = pk2(sp[2 * 65], sp[3 * 65]); o.z = pk2(sp[4 * 65], sp[5 * 65]); o.w = pk2(sp[6 * 65], sp[7 * 65]);
            *(u32x4*)(dst + (size_t)n * D + 8 * c) = o; }
        WAVE_SYNC();
        LBAR(); if (tid == 0) wq[0] = nn; LBAR();
        cur = nxt; nxt = __builtin_amdgcn_readfirstlane(wq[0]);
    }
    __syncthreads();
}

__device__ __forceinline__ void ph_init(const Ctx& A, int lane, int wave, int G) {
    const int gw = blockIdx.x * NWAVES + wave, NGW = G * NWAVES;
    float* X = (float*)(A.ws() + WS_X); bf16* H = (bf16*)(A.ws() + WS_H); const float* mods = (const float*)(A.ws() + WS_MODS);
    for (int m = gw; m < NTOK; m += NGW) {
        const float* src = m < NLAT ? A.in(IX) + (size_t)m * D : A.in(ICTX) + (size_t)(m - NLAT) * D;
        const f32x4* xr = (const f32x4*)src + lane; f32x4* xo = (f32x4*)(X + (size_t)m * D) + lane;
        f32x4 v[4];
#pragma unroll
        for (int j = 0; j < 4; ++j) { v[j] = xr[64 * j]; xo[64 * j] = v[j]; }
        row_ln(v);
        const float* md = mods + (size_t)(0 * 5 + mod_row(m)) * 6144;
#pragma unroll
        for (int j = 0; j < 4; ++j) { const f32x4 sh = ((const f32x4*)md)[lane + 64 * j], scl = ((const f32x4*)(md + D))[lane + 64 * j]; v[j] = v[j] * (scl + 1.f) + sh; }
        row_store_bf16(H + (size_t)m * D, v, lane);
    }
}

struct EpiCols {
    static constexpr bool PERM = true, AFTER_DRAIN = false;
    bf16* C; float* gates;
    __device__ __forceinline__ void operator()(const f32x4 (&acc)[2][2][4][2], const pg8::Unit& u, int wr, int wc, int fr, int fq) const {
        const int row0 = u.pm * 256 + wr * 64 + fr, colb = u.pn * 256 + wc * 32 + 8 * fq;
#pragma unroll
        for (int ai = 0; ai < 2; ++ai)
#pragma unroll
            for (int m = 0; m < 4; ++m) { const int row = row0 + ai * 128 + m * 16;
#pragma unroll
                for (int bj = 0; bj < 2; ++bj) { const int col = colb + bj * 128; const f32x4 v0 = acc[ai][bj][m][0], v1 = acc[ai][bj][m][1];
                    if (col < DIN) { u32x4 w; w.x = pk2(v0[0], v0[1]); w.y = pk2(v0[2], v0[3]); w.z = pk2(v1[0], v1[1]); w.w = pk2(v1[2], v1[3]);
                        *(u32x4*)(C + (size_t)row * DIN + col) = w; }
                    int gc = -1;
                    if (col >= C_GLA_A && col < C_GLA_A + 32) gc = col - C_GLA_A; else if (col >= C_GDN_B && col < C_GDN_B + 16) gc = 32 + col - C_GDN_B;
                    if (gc >= 0) { float* gp = gates + (size_t)row * 48 + gc; *(f32x4*)gp = v0; *(f32x4*)(gp + 4) = v1; } } }
    }
};
struct EpiOut {
    static constexpr bool PERM = false, AFTER_DRAIN = false;
    float* X; const float* mods;
    __device__ __forceinline__ void operator()(const f32x4 (&acc)[2][2][4][2], const pg8::Unit& u, int wr, int wc, int fr, int fq) const {
        const int row0 = u.pm * 256 + wr * 64 + fr, col0 = u.pn * 256 + wc * 32 + 4 * fq;
#pragma unroll
        for (int ai = 0; ai < 2; ++ai)
#pragma unroll
            for (int m = 0; m < 4; ++m) { const int row = row0 + ai * 128 + m * 16; float* xr = X + (size_t)row * D + col0; const float* g = mods + (size_t)mod_row(row) * 6144 + 2 * D + col0;
#pragma unroll
                for (int bj = 0; bj < 2; ++bj)
#pragma unroll
                    for (int n = 0; n < 2; ++n) { const int o = bj * 128 + n * 16; const f32x4 xv = *(const f32x4*)(xr + o), gv = *(const f32x4*)(g + o);
                        *(f32x4*)(xr + o) = xv * DN_ALPHA + gv * acc[ai][bj][m][n]; } }
    }
};
__device__ __forceinline__ f32x4 act4(const f32x4 g, const f32x4 u) {
    const f32x4 lim = {7.f, 7.f, 7.f, 7.f};
    const f32x4 gt = __builtin_elementwise_min(g, lim), up = __builtin_elementwise_min(__builtin_elementwise_max(u, -lim), lim);
    const f32x4 t = gt * (-1.702f * 1.4426950408889634f);
    const f32x4 d = (f32x4){__builtin_amdgcn_exp2f(t[0]), __builtin_amdgcn_exp2f(t[1]), __builtin_amdgcn_exp2f(t[2]), __builtin_amdgcn_exp2f(t[3])} + 1.f;
    const f32x4 r = {__builtin_amdgcn_rcpf(d[0]), __builtin_amdgcn_rcpf(d[1]), __builtin_amdgcn_rcpf(d[2]), __builtin_amdgcn_rcpf(d[3])};
    return (up * gt + gt) * r;
}
struct EpiAct {
    static constexpr bool PERM = true, AFTER_DRAIN = false;
    bf16* O; const float* bias;
    __device__ __forceinline__ void operator()(const f32x4 (&acc)[2][2][4][2], const pg8::Unit& u, int wr, int wc, int fr, int fq) const {
        const int e = u.pn >> 3, j = u.pn & 7;
        const int row0 = u.pm * 256 + wr * 64 + fr, col = j * 128 + wc * 32 + 8 * fq;
        const float* bg = bias + (size_t)e * 2048 + col; const float* bu = bg + 1024;
        const f32x4 bg0 = *(const f32x4*)bg, bg1 = *(const f32x4*)(bg + 4), bu0 = *(const f32x4*)bu, bu1 = *(const f32x4*)(bu + 4);
#pragma unroll
        for (int ai = 0; ai < 2; ++ai)
#pragma unroll
            for (int m = 0; m < 4; ++m) { const int row = row0 + ai * 128 + m * 16;
                const f32x4 a0 = act4(acc[ai][0][m][0] + bg0, acc[ai][1][m][0] + bu0), a1 = act4(acc[ai][0][m][1] + bg1, acc[ai][1][m][1] + bu1);
                u32x4 w; w.x = pk2(a0[0], a0[1]); w.y = pk2(a0[2], a0[3]); w.z = pk2(a1[0], a1[1]); w.w = pk2(a1[2], a1[3]);
                *(u32x4*)(O + (size_t)row * D + col) = w; }
    }
};
struct EpiY {
    static constexpr bool PERM = true, AFTER_DRAIN = false;
    bf16* O; const float* bias;
    __device__ __forceinline__ void operator()(const f32x4 (&acc)[2][2][4][2], const pg8::Unit& u, int wr, int wc, int fr, int fq) const {
        const int e = u.pn >> 2, j = u.pn & 3;
        const int row0 = u.pm * 256 + wr * 64 + fr, colb = j * 256 + wc * 32 + 8 * fq;
#pragma unroll
        for (int bj = 0; bj < 2; ++bj) { const int col = colb + bj * 128; const float* b = bias + (size_t)e * D + col; const f32x4 b0 = *(const f32x4*)b, b1 = *(const f32x4*)(b + 4);
#pragma unroll
            for (int ai = 0; ai < 2; ++ai)
#pragma unroll
                for (int m = 0; m < 4; ++m) { const int row = row0 + ai * 128 + m * 16; const f32x4 v0 = acc[ai][bj][m][0] + b0, v1 = acc[ai][bj][m][1] + b1;
                    u32x4 w; w.x = pk2(v0[0], v0[1]); w.y = pk2(v0[2], v0[3]); w.z = pk2(v1[0], v1[1]); w.w = pk2(v1[2], v1[3]);
                    *(u32x4*)(O + (size_t)row * D + col) = w; } }
    }
};
struct MoeOrder {
    const LAS int* blk_e; int n_units, NT, G, c; const LAS int* tab; const int* etok;
    __device__ __forceinline__ bool next(int i, pg8::Unit& u) const {
        const int L = i * G + c; if (L >= n_units) return false;
        const int rb = L / NT, j = L - rb * NT; u.pm = rb; u.pn = __builtin_amdgcn_readfirstlane(blk_e[rb]) * NT + j; return true;
    }
    __device__ __forceinline__ int a_row(const pg8::Unit& u, int r) const {
        const int e = __builtin_amdgcn_readfirstlane(blk_e[u.pm]), base = u.pm * 256 - __builtin_amdgcn_readfirstlane(tab[e]), cnt = __builtin_amdgcn_readfirstlane(tab[400 + e]);
        const int idx = base + r; return idx < cnt ? etok[(size_t)e * NTOK + idx] : 0; }
    __device__ __forceinline__ void a_ready(const pg8::Unit&) const {}
    __device__ __forceinline__ void done(const pg8::Unit&) const {}
};
__device__ __forceinline__ void moe_tables(const unsigned* cnt, LAS int* tab, int tid) {
    if (tid < 64) {
        const int c = tid < NE ? (int)__hip_atomic_load(cnt + tid, __ATOMIC_RELAXED, __HIP_MEMORY_SCOPE_AGENT) : 0; const int nb = (c + 255) >> 8; int incl = nb;
#pragma unroll
        for (int o = 1; o < 32; o <<= 1) { const int t = __shfl_up(incl, o); if ((tid & 63) >= o) incl += t; }
        const int excl = incl - nb;
        if (tid < NE) { tab[tid] = excl * 256; tab[400 + tid] = c; for (int q = 0; q < nb; ++q) tab[64 + excl + q] = tid; }
        if (tid == NE - 1) { tab[32] = incl * 256; tab[40] = incl; } }
    __syncthreads();
}

__device__ __forceinline__ void wsum2(float& a, float& b) { a = wsum(a); b = wsum(b); }
__device__ __forceinline__ void row_ln1p(f32x4 (&v)[4]) {
    float s = 0.f, s2 = 0.f;
#pragma unroll
    for (int j = 0; j < 4; ++j) { s += (v[j].x + v[j].y) + (v[j].z + v[j].w); s2 += (v[j].x * v[j].x + v[j].y * v[j].y) + (v[j].z * v[j].z + v[j].w * v[j].w); }
    wsum2(s, s2);
    const float mean = s * (1.f / D), rstd = rsqrtf(fmaxf(s2 * (1.f / D) - mean * mean, 0.f) + LN_EPS);
#pragma unroll
    for (int j = 0; j < 4; ++j) v[j] = (v[j] - mean) * rstd;
}
__device__ __forceinline__ void ph_ln1_route(const Ctx& A, int l, LAS unsigned char* lds, int tid, int lane, int wave, int nrows_total) {
    LAS bf16* WH = (LAS bf16*)lds; LAS bf16* WL = (LAS bf16*)(lds + 66048); LAS float* LGT = (LAS float*)(lds + 132096); LAS int* msc = (LAS int*)(lds + MISC_OFF + 1024);
    { const u32x4* srch = (const u32x4*)((const bf16*)(A.ws() + WS_WRH) + (size_t)l * D * NE); const u32x4* srcl = (const u32x4*)((const bf16*)(A.ws() + WS_WRL) + (size_t)l * D * NE);
      for (int i = tid; i < D * NE / 8; i += NTHR) { const int e = i >> 7, part = i & 127; *(LAS u32x4*)(WH + e * 1032 + part * 8) = srch[i]; *(LAS u32x4*)(WL + e * 1032 + part * 8) = srcl[i]; } }
    if (tid < 64) msc[tid] = 0;
    const int RPB = nrows_total / (int)gridDim.x;
    const int rbase = blockIdx.x * RPB;
    float* X = (float*)(A.ws() + WS_X); bf16* H = (bf16*)(A.ws() + WS_H); bf16* HL = (bf16*)(A.ws() + WS_HL); const float* mods = (const float*)(A.ws() + WS_MODS) + (size_t)l * 5 * 6144;
    const float* g1 = A.in(ILN1G) + l * D; const float* b1 = A.in(ILN1B) + l * D;
    f32x4 nv[4], nw[4];
    { const f32x4* xr = (const f32x4*)(X + (size_t)(rbase + wave) * D) + lane; const f32x4* xs = (const f32x4*)(X + (size_t)(rbase + min(wave + NWAVES, RPB - 1)) * D) + lane;
#pragma unroll
      for (int j = 0; j < 4; ++j) { nv[j] = xr[64 * j]; nw[j] = xs[64 * j]; } }
    for (int rl = wave; rl < RPB; rl += NWAVES) {
        const int m = rbase + rl;
        f32x4 v[4];
#pragma unroll
        for (int j = 0; j < 4; ++j) { v[j] = nv[j]; nv[j] = nw[j]; }
        if (rl + 2 * NWAVES < RPB) { const f32x4* xn = (const f32x4*)(X + (size_t)(m + 2 * NWAVES) * D) + lane;
#pragma unroll
            for (int j = 0; j < 4; ++j) nw[j] = xn[64 * j]; }
        row_ln1p(v);
#pragma unroll
        for (int j = 0; j < 4; ++j) v[j] = v[j] * ((const f32x4*)g1)[lane + 64 * j] + ((const f32x4*)b1)[lane + 64 * j];
        row_ln1p(v);
        const float* md = mods + (size_t)mod_row(m) * 6144;
        u32x2* oh = (u32x2*)(H + (size_t)m * D) + lane; u32x2* ol = (u32x2*)(HL + (size_t)m * D) + lane;
#pragma unroll
        for (int j = 0; j < 4; ++j) { const f32x4 sh = ((const f32x4*)(md + 3 * D))[lane + 64 * j], scl = ((const f32x4*)(md + 4 * D))[lane + 64 * j]; const f32x4 hv = v[j] * (scl + 1.f) + sh;
            u32x2 wh; wh.x = pk2(hv.x, hv.y); wh.y = pk2(hv.z, hv.w); oh[64 * j] = wh;
            u32x2 wl; wl.x = pk2(hv.x - bf2f(wh.x & 0xffffu), hv.y - bf2f(wh.x >> 16)); wl.y = pk2(hv.z - bf2f(wh.y & 0xffffu), hv.w - bf2f(wh.y >> 16)); ol[64 * j] = wl; }
    }
    BLOCK_SYNC();
    if (wave * 16 < RPB) { const int g = lane >> 4, c16 = lane & 15; const int row = rbase + min(wave * 16 + c16, RPB - 1);
        const bf16* ph = H + (size_t)row * D + 8 * g; const bf16* pl = HL + (size_t)row * D + 8 * g;
        f32x4 acc0 = {0.f, 0.f, 0.f, 0.f}, acc1 = {0.f, 0.f, 0.f, 0.f};
#pragma unroll 1
        for (int kb = 0; kb < 4; ++kb) { bf16x8 ah[8], al[8];
#pragma unroll
            for (int k8 = 0; k8 < 8; ++k8) { ah[k8] = *(const bf16x8*)(ph + 32 * (8 * kb + k8)); al[k8] = *(const bf16x8*)(pl + 32 * (8 * kb + k8)); }
#pragma unroll
            for (int k8 = 0; k8 < 8; ++k8) { const int k0 = 32 * (8 * kb + k8);
                const bf16x8 h0 = lds_frag(WH, 1032, 0, k0, lane), h1 = lds_frag(WH, 1032, 16, k0, lane), l0 = lds_frag(WL, 1032, 0, k0, lane), l1 = lds_frag(WL, 1032, 16, k0, lane);
                acc0 = mma(ah[k8], h0, acc0); acc0 = mma(ah[k8], l0, acc0); acc0 = mma(al[k8], h0, acc0);
                acc1 = mma(ah[k8], h1, acc1); acc1 = mma(ah[k8], l1, acc1); acc1 = mma(al[k8], h1, acc1); } }
        const float bi0 = A.in(IBR)[l * NE + c16], bi1 = A.in(IBR)[l * NE + 16 + c16];
#pragma unroll
        for (int r = 0; r < 4; ++r) { LGT[(wave * 16 + 4 * g + r) * 32 + c16] = acc0[r] + bi0; LGT[(wave * 16 + 4 * g + r) * 32 + 16 + c16] = acc1[r] + bi1; } }
    __syncthreads();
    if (tid < RPB) { const int rl = tid, m = rbase + rl; float lg[NE];
#pragma unroll
        for (int q = 0; q < 8; ++q) { const f32x4 t4 = *(const LAS f32x4*)(LGT + rl * 32 + 4 * q); lg[4 * q] = t4.x; lg[4 * q + 1] = t4.y; lg[4 * q + 2] = t4.z; lg[4 * q + 3] = t4.w; }
        float tv[4]; int te[4];
#pragma unroll
        for (int k = 0; k < 4; ++k) { float mx = -INFINITY; int mi = 0;
#pragma unroll
            for (int e = 0; e < NE; ++e) { const bool gt = lg[e] > mx; mx = gt ? lg[e] : mx; mi = gt ? e : mi; }
            tv[k] = mx; te[k] = mi;
#pragma unroll
            for (int e = 0; e < NE; ++e) lg[e] = (e == mi) ? -INFINITY : lg[e]; }
        const float e1 = __expf(tv[1] - tv[0]), e2 = __expf(tv[2] - tv[0]), e3 = __expf(tv[3] - tv[0]); const float inv = 1.f / (1.f + e1 + e2 + e3);
        *(f32x4*)((float*)(A.ws() + WS_TOKG) + (size_t)m * 4) = (f32x4){inv, e1 * inv, e2 * inv, e3 * inv};
#pragma unroll
        for (int k = 0; k < 4; ++k) { const int pos = atomicAdd((int*)(msc + te[k]), 1); msc[64 + rl * 4 + k] = te[k] | (pos << 8); }
    }
    __syncthreads();
    unsigned* gcnt = (unsigned*)(A.ws() + WS_CTL) + CW_CNT + l * 64;
    if (tid < NE) msc[32 + tid] = (int)atomicAdd(gcnt + tid, (unsigned)msc[tid]);
    __syncthreads();
    int* toke = (int*)(A.ws() + WS_TOKE); int* tokp = (int*)(A.ws() + WS_TOKP); int* etok = (int*)(A.ws() + WS_ETOK);
    for (int i = tid; i < RPB * 4; i += NTHR) { const int s = msc[64 + i], e = s & 255, idx = msc[32 + e] + (s >> 8);
        toke[(size_t)rbase * 4 + i] = e; tokp[(size_t)rbase * 4 + i] = idx; etok[(size_t)e * NTOK + idx] = rbase + (i >> 2); }
    __syncthreads();
}

__device__ __forceinline__ void ph_combine(const Ctx& A, int l, LAS unsigned char* lds, int tid, int lane, int wave, int G, int nrows_total) {
    LAS int* tab = (LAS int*)(lds + MISC_OFF + 1024);
    moe_tables((const unsigned*)(A.ws() + WS_CTL) + CW_CNT + l * 64, tab, tid);
    const int gw = blockIdx.x * NWAVES + wave, NGW = G * NWAVES;
    float* X = (float*)(A.ws() + WS_X); bf16* H = (bf16*)(A.ws() + WS_H); const bf16* YB = (const bf16*)(A.ws() + WS_YB);
    const float* mods = (const float*)(A.ws() + WS_MODS) + (size_t)l * 5 * 6144;
    const int* toke = (const int*)(A.ws() + WS_TOKE); const int* tokp = (const int*)(A.ws() + WS_TOKP); const float* tokg = (const float*)(A.ws() + WS_TOKG);
    const float* g2 = A.in(ILN2G) + l * D; const float* b2 = A.in(ILN2B) + l * D; const float* g1 = A.in(ILN1G) + l * D; const float* b1 = A.in(ILN1B) + l * D;
    for (int m = gw; m < nrows_total; m += NGW) {
        f32x4 f[4];
#pragma unroll
        for (int j = 0; j < 4; ++j) f[j] = (f32x4){0.f, 0.f, 0.f, 0.f};
#pragma unroll
        for (int k = 0; k < 4; ++k) { const int slot = tab[toke[m * 4 + k]] + tokp[m * 4 + k]; const float g = tokg[m * 4 + k]; const u32x2* y = (const u32x2*)(YB + (size_t)slot * D) + lane;
#pragma unroll
            for (int j = 0; j < 4; ++j) { const u32x2 w = y[64 * j]; f[j].x += g * bf2f(w.x & 0xffffu); f[j].y += g * bf2f(w.x >> 16); f[j].z += g * bf2f(w.y & 0xffffu); f[j].w += g * bf2f(w.y >> 16); } }
        f32x4* xr = (f32x4*)(X + (size_t)m * D) + lane; const float* md = mods + (size_t)mod_row(m) * 6144; f32x4 v[4];
#pragma unroll
        for (int j = 0; j < 4; ++j) v[j] = xr[64 * j];
        row_ln1p(v);
#pragma unroll
        for (int j = 0; j < 4; ++j) { const f32x4 x = v[j] * ((const f32x4*)g1)[lane + 64 * j] + ((const f32x4*)b1)[lane + 64 * j]; v[j] = x * DN_ALPHA + ((const f32x4*)(md + 5 * D))[lane + 64 * j] * f[j]; }
        row_ln(v);
#pragma unroll
        for (int j = 0; j < 4; ++j) v[j] = v[j] * ((const f32x4*)g2)[lane + 64 * j] + ((const f32x4*)b2)[lane + 64 * j];
        if (l == DEPTH - 1) { f32x4* o = (f32x4*)(A.out() + (size_t)m * D) + lane;
#pragma unroll
            for (int j = 0; j < 4; ++j) o[64 * j] = v[j];
        } else {
#pragma unroll
            for (int j = 0; j < 4; ++j) xr[64 * j] = v[j];
            row_ln(v);
            const float* mn = mods + 5 * 6144 + (size_t)mod_row(m) * 6144;
#pragma unroll
            for (int j = 0; j < 4; ++j) { const f32x4 sh = ((const f32x4*)mn)[lane + 64 * j], scl = ((const f32x4*)(mn + D))[lane + 64 * j]; v[j] = v[j] * (scl + 1.f) + sh; }
            row_store_bf16(H + (size_t)m * D, v, lane);
        }
    }
}

__device__ __forceinline__ u32x2 lds_tr16(unsigned addr) { u32x2 r; asm volatile("ds_read_b64_tr_b16 %0, %1" : "=&v"(r) : "v"(addr) : "memory"); return r; }
template <bool CTXQ>
__device__ __forceinline__ void na_unit(const Ctx& A, int l, LAS unsigned char* lds, int unit, int tid, int lane, int wave) {
    constexpr int NKT = CTXQ ? 16 : 48, NTW = NKT / 2, NKEYS = NKT * 16, KST = 72, NCH = NKEYS * 8 / NTHR;
    const bf16* cols = (const bf16*)(A.ws() + WS_COLS); bf16* MIX = (bf16*)(A.ws() + WS_MIX);
    int b, h, r = 0, r0 = 0, qbase;
    if (!CTXQ) { b = unit >> 8; h = (unit >> 6) & 3; r = unit & 63; r0 = min(max(r - 4, 0), 56); qbase = b * SEQ + r * 64; }
    else { b = unit >> 4; h = (unit >> 2) & 3; qbase = NLAT + b * CTXL + (unit & 3) * 64; }
    LAS bf16* Kimg = (LAS bf16*)lds;
    const int mt = wave & 3, kq = wave >> 2, qi = lane & 15, g = lane >> 4;
    const char* cb = (const char*)cols; LAS float* RP = (LAS float*)(lds + 114688 + 256);
    if (!CTXQ && tid < 465) RP[tid] = A.in(IRPB)[(size_t)(l * 4 + h) * 465 + tid];
#define NA_KOFF(k2, n, part) const int q_ = tid + NTHR * (k2), n = q_ >> 3, part = q_ & 7; \
        const int krow_ = (!CTXQ && n < 512) ? (b * SEQ + (r0 + (n >> 6)) * 64 + (n & 63)) : (NLAT + b * CTXL + (CTXQ ? n : n - 512)); const unsigned koff_ = (unsigned)(krow_ * DIN + h * 64 + part * 8) * 2u
#pragma unroll
    for (int k2 = 0; k2 < NCH; ++k2) { NA_KOFF(k2, n, part); *(LAS u32x4*)(Kimg + n * KST + part * 8) = *(const u32x4*)(cb + koff_ + C_NA_K * 2); }
    const int qrow = qbase + mt * 16 + qi;
    bf16x8 qf0 = *(const bf16x8*)(cols + (size_t)qrow * DIN + C_NA_Q + h * 64 + g * 8), qf1 = *(const bf16x8*)(cols + (size_t)qrow * DIN + C_NA_Q + h * 64 + 32 + g * 8);
    LBAR();
    const int cq = mt * 16 + qi, c0 = min(max(cq - 8, 0), 48);
    const int mk0 = 4 * g - c0, bi0 = 4 * g - cq + 15;
    const int ctlo = mt >= 2 ? mt - 1 : 0, cthi = mt <= 1 ? mt + 1 : 3;
#define NA_TILE(t, sv) do { const int kt = kq * NTW + (t); \
        if (!CTXQ && kt < 32 && ((kt & 3) < ctlo || (kt & 3) > cthi)) { sv = (f32x4){-INFINITY, -INFINITY, -INFINITY, -INFINITY}; } \
        else { f32x4 acc_ = {0.f, 0.f, 0.f, 0.f}; \
            acc_ = mma(lds_frag(Kimg, KST, kt * 16, 0, lane), qf0, acc_); acc_ = mma(lds_frag(Kimg, KST, kt * 16, 32, lane), qf1, acc_); \
            if (!CTXQ && kt < 32) { const int ct16_ = (kt & 3) * 16; const LAS float* rp_ = RP + (r0 + (kt >> 2) - r + 7) * 31 + ct16_ + bi0; const int mk_ = ct16_ + mk0; \
                _Pragma("unroll") for (int i_ = 0; i_ < 4; ++i_) sv[i_] = ((unsigned)(mk_ + i_) < 16u) ? acc_[i_] * 0.125f + rp_[i_] : -INFINITY; } \
            else { sv = acc_ * 0.125f; } } } while (0)
    f32x4 s[NTW]; float mloc = -INFINITY;
#pragma unroll
    for (int t = 0; t < NTW; ++t) { f32x4 sv; NA_TILE(t, sv); s[t] = sv; mloc = fmaxf(fmaxf(mloc, fmaxf(sv[0], sv[1])), fmaxf(sv[2], sv[3])); if (t & 1) __builtin_amdgcn_sched_barrier(0); }
    mloc = fmaxf(mloc, __shfl_xor(mloc, 16)); mloc = fmaxf(mloc, __shfl_xor(mloc, 32));
    u32x4 vreg[NCH];
#pragma unroll
    for (int k2 = 0; k2 < NCH; ++k2) { NA_KOFF(k2, n, part); (void)n; vreg[k2] = *(const u32x4*)(cb + koff_ + C_NA_V * 2); }
    float lsum = 0.f; bf16x8 pb[NTW / 2];
#pragma unroll
    for (int tt = 0; tt < NTW / 2; ++tt) { float p[8];
#pragma unroll
        for (int i = 0; i < 4; ++i) { p[i] = __expf(s[2 * tt][i] - mloc); p[4 + i] = __expf(s[2 * tt + 1][i] - mloc); }
#pragma unroll
        for (int i = 0; i < 8; ++i) lsum += p[i];
        u32x4 w; w.x = pk2(p[0], p[1]); w.y = pk2(p[2], p[3]); w.z = pk2(p[4], p[5]); w.w = pk2(p[6], p[7]);
        pb[tt] = __builtin_bit_cast(bf16x8, w); }
#undef NA_TILE
    lsum += __shfl_xor(lsum, 16); lsum += __shfl_xor(lsum, 32);
    LBAR();
#pragma unroll
    for (int k2 = 0; k2 < NCH; ++k2) { const int q_ = tid + NTHR * k2, n = q_ >> 3, part = q_ & 7; *(LAS u32x4*)(Kimg + n * KST + part * 8) = vreg[k2]; }
#undef NA_KOFF
    LBAR();
    f32x4 o[4];
    const unsigned vbase = (unsigned)(size_t)Kimg + (unsigned)(((kq * NTW * 16 + 4 * g + (qi >> 2)) * KST + 4 * (qi & 3)) * 2);
#define NA_OFFL(dt, tt) (((32 * (tt)) * 72 + 16 * (dt)) * 2)
#define NA_OFFH(dt, tt) (((32 * (tt) + 16) * 72 + 16 * (dt)) * 2)
#define NA_PV2(dt, t2) do { u32x2 l0, l1, h0, h1; \
        asm volatile("ds_read_b64_tr_b16 %0, %4 offset:%5\n\tds_read_b64_tr_b16 %2, %4 offset:%6\n\tds_read_b64_tr_b16 %1, %4 offset:%7\n\tds_read_b64_tr_b16 %3, %4 offset:%8\n\ts_waitcnt lgkmcnt(0)" \
                     : "=&v"(l0), "=&v"(l1), "=&v"(h0), "=&v"(h1) : "v"(vbase), "i"(NA_OFFL(dt, t2)), "i"(NA_OFFH(dt, t2)), "i"(NA_OFFL(dt, (t2) + 1)), "i"(NA_OFFH(dt, (t2) + 1)) : "memory"); \
        u32x4 w_; w_.x = l0.x; w_.y = l0.y; w_.z = h0.x; w_.w = h0.y; acc = mma(__builtin_bit_cast(bf16x8, w_), pb[(t2)], acc); \
        w_.x = l1.x; w_.y = l1.y; w_.z = h1.x; w_.w = h1.y; acc = mma(__builtin_bit_cast(bf16x8, w_), pb[(t2) + 1], acc); } while (0)
#define NA_PV(dt, hb) do { NA_PV2(dt, 4 * (hb)); NA_PV2(dt, 4 * (hb) + 2); } while (0)
#define NA_PVD(dt) do { f32x4 acc = {0.f, 0.f, 0.f, 0.f}; NA_PV(dt, 0); if constexpr (NTW / 8 > 1) { NA_PV(dt, 1); NA_PV(dt, 2); } o[dt] = acc; } while (0)
    NA_PVD(0); NA_PVD(1); NA_PVD(2); NA_PVD(3);
#undef NA_PVD
#undef NA_PV
#undef NA_PV2
#undef NA_OFFL
#undef NA_OFFH
    LBAR();
    LAS float* mrg = (LAS float*)lds + mt * 1088;
    if (kq == 1) {
#pragma unroll
        for (int dt = 0; dt < 4; ++dt)
#pragma unroll
            for (int i = 0; i < 4; ++i) mrg[(dt * 16 + 4 * g + i) * 16 + qi] = o[dt][i];
        if (g == 0) { mrg[1024 + qi] = mloc; mrg[1040 + qi] = lsum; } }
    LBAR();
    if (kq == 0) { const float m1 = mrg[1024 + qi], l1 = mrg[1040 + qi], mm = fmaxf(mloc, m1), f0 = __expf(mloc - mm), f1 = __expf(m1 - mm), inv = 1.f / (lsum * f0 + l1 * f1);
#pragma unroll
        for (int dt = 0; dt < 4; ++dt) { float y[4];
#pragma unroll
            for (int i = 0; i < 4; ++i) y[i] = (o[dt][i] * f0 + mrg[(dt * 16 + 4 * g + i) * 16 + qi] * f1) * inv;
            u32x2 w; w.x = pk2(y[0], y[1]); w.y = pk2(y[2], y[3]);
            *(u32x2*)(MIX + (size_t)qrow * D + 256 + h * 64 + dt * 16 + 4 * g) = w; } }
    LBAR();
}
__device__ __forceinline__ void gla_item_info(int item, int& b, int& h, int& cc, int& m0, bool& isctx) {
    const int cidx = item >> 2; h = item & 3;
    if (cidx < 512) { b = cidx >> 7; cc = cidx & 127; m0 = b * SEQ + cc * 32; isctx = false; } else { const int j = cidx - 512; b = j >> 3; cc = j & 7; m0 = NLAT + b * CTXL + cc * 32; isctx = true; }
}
__device__ __forceinline__ int gla_cpos(bool isctx, int cc, int dir) { return isctx ? (dir ? 7 - cc : cc) : 8 + (dir ? 127 - cc : cc); }
__device__ __forceinline__ float fast_logsigmoid(float z) { return fminf(z, 0.f) - __logf(1.f + __expf(-fabsf(z))); }

__device__ __forceinline__ void gla_a_chunk(const Ctx& A, int l, LAS unsigned char* lds, int lane, int wave, int chunk) {
    LAS unsigned char* base = lds + wave * 17664;
    LAS bf16* QT = (LAS bf16*)base; LAS bf16* KT = (LAS bf16*)(base + 2560); LAS bf16* KDT = (LAS bf16*)(base + 5120); LAS bf16* PM = (LAS bf16*)(base + 7680); LAS bf16* VT = (LAS bf16*)(base + 10240); LAS float* GL = (LAS float*)(base + 15360); LAS float* ALR = (LAS float*)(base + 15616);
    const bf16* cols = (const bf16*)(A.ws() + WS_COLS); const float* gates = (const float*)(A.ws() + WS_GATES); const float* rope = (const float*)(A.ws() + WS_ROPE);
    bf16* SD = (bf16*)(A.ws() + WS_SD); float* SA = (float*)(A.ws() + WS_SA); bf16* OI = (bf16*)(A.ws() + WS_OI); bf16* QTG = (bf16*)(A.ws() + WS_QTG);
    const int d = lane & 31, dr = lane >> 5, g = lane >> 4, c16 = lane & 15;
    { const int item = chunk * NWAVES + wave;
        int b, h, cc, m0; bool isctx; gla_item_info(item, b, h, cc, m0, isctx);
#pragma unroll 8
        for (int t = 0; t < 32; ++t) VT[lane * 40 + t] = cols[(size_t)(m0 + t) * DIN + C_GLA_V + h * 64 + lane];
        f32x4 o[2][4];
#pragma unroll
        for (int i = 0; i < 2; ++i)
#pragma unroll
            for (int j = 0; j < 4; ++j) o[i][j] = (f32x4){0.f, 0.f, 0.f, 0.f};
#pragma unroll 1
        for (int dir = 0; dir < 2; ++dir) {
            const float* w2 = A.in(IGLAW) + ((size_t)(l * 2 + dir) * 16) * 128 + h * 32 + d; float w[16];
#pragma unroll
            for (int r = 0; r < 16; ++r) w[r] = w2[r * 128];
            float Gr = 0.f; const float bias = A.in(IGLAB)[(l * 2 + dir) * 128 + h * 32 + d];
            const float xs = dr ? 1.f : 0.17677669529663687f;
            { const int t = lane >> 1, part = lane & 1; const f32x4* ap = (const f32x4*)(gates + (size_t)(m0 + t) * 48 + dir * 16 + part * 8);
              const f32x4 v0 = ap[0], v1 = ap[1]; *(LAS f32x4*)(ALR + t * 16 + part * 8) = v0; *(LAS f32x4*)(ALR + t * 16 + part * 8 + 4) = v1; }
#pragma unroll
            for (int k2 = 0; k2 < 2; ++k2) { const int c = lane + 64 * k2, row = c >> 2, part = c & 3; const bf16* src = cols + (size_t)(m0 + row) * DIN + h * 32 + part * 8;
                *(LAS u32x4*)(QT + row * 40 + part * 8) = *(const u32x4*)(src + C_GLA_Q); *(LAS u32x4*)(KT + row * 40 + part * 8) = *(const u32x4*)(src + C_GLA_K); }
            WAVE_SYNC();
            LAS bf16* XI = dr ? KT : QT;
            float rc = 1.f, rs = 0.f, rcd = 1.f, rsd = 0.f;
            if (!isctx) { const int t0 = dir ? 31 : 0, tpos0 = cc * 32 + t0, pos0 = (d & 16) ? (tpos0 & 63) : (tpos0 >> 6); rc = rope[(pos0 * 8 + (d & 7)) * 2]; rs = rope[(pos0 * 8 + (d & 7)) * 2 + 1];
                if (d & 16) { rcd = rope[(8 + (d & 7)) * 2]; rsd = rope[(8 + (d & 7)) * 2 + 1]; if (dir) rsd = -rsd; } }
#pragma unroll 4
            for (int i = 0; i < 32; ++i) { const int t = dir ? 31 - i : i;
                const LAS f32x4* ap = (const LAS f32x4*)(ALR + t * 16); const f32x4 a0 = ap[0], a1 = ap[1], a2 = ap[2], a3 = ap[3];
                const float z = bias + a0.x * w[0] + a0.y * w[1] + a0.z * w[2] + a0.w * w[3] + a1.x * w[4] + a1.y * w[5] + a1.z * w[6] + a1.w * w[7]
                                     + a2.x * w[8] + a2.y * w[9] + a2.z * w[10] + a2.w * w[11] + a3.x * w[12] + a3.y * w[13] + a3.z * w[14] + a3.w * w[15];
                Gr += fast_logsigmoid(z) * (1.f / 16.f);
                float x = bf2f(XI[t * 40 + d]) * xs; const float y = dppf<0x128>(x);
                if (!isctx) { x = (d & 8) ? (x * rc + y * rs) : (x * rc - y * rs);
                    const float nc = rc * rcd - rs * rsd, ns = rs * rcd + rc * rsd; rc = nc; rs = ns; }
                if (dr == 0) QT[t * 40 + d] = (bf16)f2bf(x * __expf(Gr));
                else { const bf16 kv = (bf16)f2bf(x * __expf(-Gr)); KT[t * 40 + d] = kv; KDT[d * 40 + t] = kv; } }
            const float glast = Gr;
            if (dr == 0) GL[d] = __expf(glast);
            WAVE_SYNC();
#pragma unroll
            for (int ti = 0; ti < 2; ++ti) { const bf16x8 a = lds_frag(QT, 40, 16 * ti, 0, lane);
#pragma unroll
                for (int sj = 0; sj < 2; ++sj) { f32x4 acc = {0.f, 0.f, 0.f, 0.f}; acc = mma(a, lds_frag(KT, 40, 16 * sj, 0, lane), acc);
#pragma unroll
                    for (int r = 0; r < 4; ++r) { const int t = 16 * ti + 4 * g + r, s = 16 * sj + c16; const bool keep = dir ? (s >= t) : (s <= t);
                        PM[t * 40 + s] = (bf16)f2bf(keep ? acc[r] : 0.f); } } }
            WAVE_SYNC();
            const int chain = (b * 4 + h) * 2 + dir, cpos = gla_cpos(isctx, cc, dir);
            bf16* sd = SD + ((size_t)chain * 136 + cpos) * 2048;
#pragma unroll
            for (int j = 0; j < 4; ++j) { const bf16x8 vb = lds_frag(VT, 40, 16 * j, 0, lane);
#pragma unroll
                for (int ti = 0; ti < 2; ++ti) { o[ti][j] = mma(lds_frag(PM, 40, 16 * ti, 0, lane), vb, o[ti][j]);
                    f32x4 acc = {0.f, 0.f, 0.f, 0.f}; acc = mma(lds_frag(KDT, 40, 16 * ti, 0, lane), vb, acc);
#pragma unroll
                    for (int r = 0; r < 4; ++r) sd[(16 * ti + 4 * g + r) * 64 + 16 * j + c16] = (bf16)f2bf(acc[r] * GL[16 * ti + 4 * g + r]); } }
            if (dr == 0) SA[((size_t)chain * 136 + cpos) * 32 + d] = GL[d];
            { bf16* qg = QTG + ((size_t)item * 2 + dir) * 1024;
#pragma unroll
              for (int k2 = 0; k2 < 2; ++k2) { const int c = lane + 64 * k2, row = c >> 2, part = c & 3; *(u32x4*)(qg + row * 32 + part * 8) = *(const LAS u32x4*)(QT + row * 40 + part * 8); } }
            WAVE_SYNC();
        }
        bf16* oi = OI + (size_t)item * 2048;
#pragma unroll
        for (int ti = 0; ti < 2; ++ti)
#pragma unroll
            for (int j = 0; j < 4; ++j)
#pragma unroll
                for (int r = 0; r < 4; ++r) oi[(16 * ti + 4 * g + r) * 64 + 16 * j + c16] = (bf16)f2bf(o[ti][j][r]);
    }
}
__device__ __forceinline__ void ph_gla_b(const Ctx& A, int tid, int blk, int nblk) {
    const bf16* __restrict__ SD = (const bf16*)(A.ws() + WS_SD); const float* __restrict__ SA = (const float*)(A.ws() + WS_SA); bf16* __restrict__ SS = (bf16*)(A.ws() + WS_SS);
    for (int idx = blk * NTHR + tid; idx < 32 * 2048; idx += nblk * NTHR) {
        const int chain = idx >> 11, e = idx & 2047, d = e >> 6;
        const bf16* sd = SD + (size_t)chain * 136 * 2048 + e; const float* sa = SA + (size_t)chain * 136 * 32 + d; bf16* ss = SS + (size_t)chain * 136 * 2048 + e;
        float S = 0.f;
#pragma unroll 1
        for (int p0 = 0; p0 < 136; p0 += 17) { float inc[17], a[17];
#pragma unroll
            for (int k = 0; k < 17; ++k) { inc[k] = bf2f(sd[(size_t)(p0 + k) * 2048]); a[k] = sa[(p0 + k) * 32]; }
#pragma unroll
            for (int k = 0; k < 17; ++k) { ss[(size_t)(p0 + k) * 2048] = (bf16)f2bf(S); S = a[k] * S + inc[k]; } }
    }
}
__device__ __forceinline__ void ph_gla_c(const Ctx& A, int l, int lane, int wave, int G, int nitems) {
    const bf16* cols = (const bf16*)(A.ws() + WS_COLS); const bf16* SS = (const bf16*)(A.ws() + WS_SS); bf16* MIX = (bf16*)(A.ws() + WS_MIX);
    const bf16* OI = (const bf16*)(A.ws() + WS_OI); const bf16* QTG = (const bf16*)(A.ws() + WS_QTG);
    const int gw = blockIdx.x * NWAVES + wave, NGW = G * NWAVES; const int g = lane >> 4, c16 = lane & 15;
    for (int item = gw; item < nitems; item += NGW) {
        int b, h, cc, m0; bool isctx; gla_item_info(item, b, h, cc, m0, isctx);
        f32x4 o[2][4]; const bf16* oi = OI + (size_t)item * 2048;
#pragma unroll
        for (int ti = 0; ti < 2; ++ti)
#pragma unroll
            for (int j = 0; j < 4; ++j)
#pragma unroll
                for (int r = 0; r < 4; ++r) o[ti][j][r] = bf2f(oi[(16 * ti + 4 * g + r) * 64 + 16 * j + c16]);
#pragma unroll
        for (int dir = 0; dir < 2; ++dir) {
            const int chain = (b * 4 + h) * 2 + dir, cpos = gla_cpos(isctx, cc, dir);
            const bf16* sd = SS + ((size_t)chain * 136 + cpos) * 2048; const bf16* qg = QTG + ((size_t)item * 2 + dir) * 1024;
            const bf16x8 qa0 = *(const bf16x8*)(qg + c16 * 32 + 8 * g), qa1 = *(const bf16x8*)(qg + (16 + c16) * 32 + 8 * g);
#pragma unroll
            for (int j = 0; j < 4; ++j) { unsigned sv[8];
#pragma unroll
                for (int jj = 0; jj < 8; ++jj) sv[jj] = sd[(8 * g + jj) * 64 + 16 * j + c16];
                u32x4 w; w.x = sv[0] | (sv[1] << 16); w.y = sv[2] | (sv[3] << 16); w.z = sv[4] | (sv[5] << 16); w.w = sv[6] | (sv[7] << 16);
                const bf16x8 sb = __builtin_bit_cast(bf16x8, w);
                o[0][j] = mma(qa0, sb, o[0][j]); o[1][j] = mma(qa1, sb, o[1][j]); } }
        const float* ng = A.in(IGLAN) + l * 64;
#pragma unroll
        for (int ti = 0; ti < 2; ++ti)
#pragma unroll
            for (int r = 0; r < 4; ++r) { float ss = 0.f;
#pragma unroll
                for (int j = 0; j < 4; ++j) ss += o[ti][j][r] * o[ti][j][r];
                ss = row16_sum(ss);
                const float rs = rsqrtf(ss * (1.f / 64.f) + RMS_EPS); const int t = 16 * ti + 4 * g + r;
#pragma unroll
                for (int j = 0; j < 4; ++j) { const int dv = 16 * j + c16; const float gt = bf2f(cols[(size_t)(m0 + t) * DIN + C_GLA_G + h * 64 + dv]);
                    MIX[(size_t)(m0 + t) * D + h * 64 + dv] = (bf16)f2bf(o[ti][j][r] * rs * ng[dv] * siluf_(gt)); } }
    }
}

__device__ __forceinline__ int gdn_m0(int ci) { return ci < 256 ? ((ci >> 6) * SEQ + (ci & 63) * 64) : (NLAT + ((ci - 256) >> 2) * CTXL + ((ci - 256) & 3) * 64); }

__device__ __forceinline__ void gdn_solve(const LAS bf16* LB, LAS float* Ld, LAS bf16* TT, LAS bf16* DA, LAS bf16* TBv, LAS bf16* TBw, const LAS float* gc, int dir, int lane) {
    const int g = lane >> 4, c16 = lane & 15;
    { const LAS float* ld = Ld + g * 320; float dc[16];
#pragma unroll
      for (int r = 0; r < 16; ++r) { float a = (r == c16) ? 1.f : 0.f;
#pragma unroll
          for (int j4 = 0; j4 < (r + 3) / 4; ++j4) { const f32x4 lv = *(const LAS f32x4*)(ld + r * 20 + 4 * j4);
              if (4 * j4 + 0 < r) a -= lv.x * dc[4 * j4 + 0];
              if (4 * j4 + 1 < r) a -= lv.y * dc[4 * j4 + 1];
              if (4 * j4 + 2 < r) a -= lv.z * dc[4 * j4 + 2];
              if (4 * j4 + 3 < r) a -= lv.w * dc[4 * j4 + 3]; }
          dc[r] = a; }
#pragma unroll
      for (int r = 0; r < 16; ++r) { DA[(16 * g + r) * 32 + c16] = (bf16)f2bf(dc[r]); DA[(16 * g + r) * 32 + 16 + c16] = 0; } }
    WAVE_SYNC();
    LAS bf16* XT = (LAS bf16*)Ld;
#pragma unroll
    for (int q = 0; q < 5; ++q) ((LAS u32x4*)XT)[lane + 64 * q] = (u32x4){0u, 0u, 0u, 0u};
    float sv[4], sw[4]; int tc[4];
#pragma unroll
    for (int nt = 0; nt < 4; ++nt) { const int c = 16 * nt + c16; const float be = gc[64 + c]; sv[nt] = be; sw[nt] = -be * __expf(gc[c]); tc[nt] = dir ? 63 - c : c; }
    WAVE_SYNC();
#pragma unroll 1
    for (int ib = 0; ib < 4; ++ib) {
        f32x4 x[4];
#pragma unroll
        for (int nt = 0; nt < 4; ++nt) x[nt] = (f32x4){0.f, 0.f, 0.f, 0.f};
        if (ib > 0) { const bf16x8 a0 = lds_frag(LB, 72, 16 * ib, 0, lane), a1 = lds_frag(LB, 72, 16 * ib, 32, lane);
#pragma unroll
            for (int nt = 0; nt < 4; ++nt) { x[nt] = mma(a0, lds_frag(TT, 72, 16 * nt, 0, lane), x[nt]); x[nt] = mma(a1, lds_frag(TT, 72, 16 * nt, 32, lane), x[nt]); } }
#pragma unroll
        for (int nt = 0; nt < 4; ++nt) { f32x4 v = x[nt];
#pragma unroll
            for (int r = 0; r < 4; ++r) if (nt == ib && 4 * g + r == c16) v[r] += 1.f;
            u32x2 w; w.x = pk2(v[0], v[1]); w.y = pk2(v[2], v[3]); *(LAS u32x2*)(XT + (16 * nt + c16) * 40 + 4 * g) = w; }
        WAVE_SYNC();
        const bf16x8 da = lds_frag(DA, 32, 16 * ib, 0, lane);
#pragma unroll
        for (int nt = 0; nt < 4; ++nt) { f32x4 t = {0.f, 0.f, 0.f, 0.f}; t = mma(da, lds_frag(XT, 40, 16 * nt, 0, lane), t);
            u32x2 w; w.x = pk2(t[0], t[1]); w.y = pk2(t[2], t[3]); *(LAS u32x2*)(TT + (16 * nt + c16) * 72 + 16 * ib + 4 * g) = w;
#pragma unroll
            for (int r = 0; r < 4; ++r) { TBv[(16 * ib + 4 * g + r) * 72 + tc[nt]] = (bf16)f2bf(t[r] * sv[nt]); TBw[(16 * ib + 4 * g + r) * 72 + tc[nt]] = (bf16)f2bf(t[r] * sw[nt]); } }
        WAVE_SYNC();
    }
}

__device__ __forceinline__ void gdn_prep_item(const Ctx& A, int l, LAS unsigned char* lds, int item, int tid, int lane, int wave) {
    LAS bf16* QN = (LAS bf16*)lds; LAS bf16* KN = (LAS bf16*)(lds + 17408);
    LAS bf16* LB = (LAS bf16*)lds; LAS float* Ld = (LAS float*)(lds + 18432);
    LAS bf16* TT = (LAS bf16*)(lds + 109568); LAS float* RB = (LAS float*)(lds + 128000);
    LAS bf16* VT = (LAS bf16*)(lds + 34816); LAS bf16* KNT = (LAS bf16*)(lds + 53248);
    LAS float* KK = (LAS float*)(lds + 71680); LAS float* QK = (LAS float*)(lds + 88320);
    LAS bf16* TB = (LAS bf16*)(lds + 71680);
    LAS float* GC = (LAS float*)(lds + 108544);
    const int ci = item >> 2, h = item & 3, m0 = gdn_m0(ci);
    { const bf16* cols = (const bf16*)(A.ws() + WS_COLS); const float* cw = A.in(ICONV) + (size_t)l * 5 * 1536; bf16* GQ = (bf16*)(A.ws() + WS_GQ);
      LAS bf16* VS = (LAS bf16*)(lds + 71680 + wave * 2176);
      const int part = lane >> 4, c8 = (lane & 15) * 8; const bool isctx = ci >= 256; const int slen = isctx ? CTXL : SEQ, cpos = (isctx ? ((ci - 256) & 3) : (ci & 63)) * 64, tseq0 = cpos + wave * 8, mseq0 = m0 - cpos;
      if (part < 3) { const int ch = part * 512 + h * 128 + c8;
          u32x4 xin[12];
#pragma unroll
          for (int i = 0; i < 12; ++i) { const int tt = tseq0 + i - 2, tc = min(max(tt, 0), slen - 1); const u32x4 x = *(const u32x4*)(cols + (size_t)(mseq0 + tc) * DIN + C_GDN_Q + ch);
              const bool ok = tt == tc; xin[i].x = ok ? x.x : 0u; xin[i].y = ok ? x.y : 0u; xin[i].z = ok ? x.z : 0u; xin[i].w = ok ? x.w : 0u; }
          f32x4 w0[5], w1[5];
#pragma unroll
          for (int j = 0; j < 5; ++j) { w0[j] = *(const f32x4*)(cw + j * 1536 + ch); w1[j] = *(const f32x4*)(cw + j * 1536 + ch + 4); }
#pragma unroll
          for (int r = 0; r < 8; ++r) { f32x4 a0 = {0.f, 0.f, 0.f, 0.f}, a1 = {0.f, 0.f, 0.f, 0.f};
#pragma unroll
              for (int j = 0; j < 5; ++j) { const u32x4 w = xin[r + j];
                  a0 += (f32x4){bf2f(w.x & 0xffffu), bf2f(w.x >> 16), bf2f(w.y & 0xffffu), bf2f(w.y >> 16)} * w0[j]; a1 += (f32x4){bf2f(w.z & 0xffffu), bf2f(w.z >> 16), bf2f(w.w & 0xffffu), bf2f(w.w >> 16)} * w1[j]; }
              { const f32x4 t0 = a0 * -1.4426950408889634f, t1 = a1 * -1.4426950408889634f;
                const f32x4 d0 = (f32x4){__builtin_amdgcn_exp2f(t0[0]), __builtin_amdgcn_exp2f(t0[1]), __builtin_amdgcn_exp2f(t0[2]), __builtin_amdgcn_exp2f(t0[3])} + 1.f, d1 = (f32x4){__builtin_amdgcn_exp2f(t1[0]), __builtin_amdgcn_exp2f(t1[1]), __builtin_amdgcn_exp2f(t1[2]), __builtin_amdgcn_exp2f(t1[3])} + 1.f;
                a0 = a0 * (f32x4){__builtin_amdgcn_rcpf(d0[0]), __builtin_amdgcn_rcpf(d0[1]), __builtin_amdgcn_rcpf(d0[2]), __builtin_amdgcn_rcpf(d0[3])}; a1 = a1 * (f32x4){__builtin_amdgcn_rcpf(d1[0]), __builtin_amdgcn_rcpf(d1[1]), __builtin_amdgcn_rcpf(d1[2]), __builtin_amdgcn_rcpf(d1[3])}; }
              float scale = 1.f;
              if (part < 2) { const f32x4 q = a0 * a0 + a1 * a1; const float ss = row16_sum((q[0] + q[1]) + (q[2] + q[3])); scale = rsqrtf(ss + 1e-6f) * (part == 0 ? 0.08838834764831845f : 1.f); }
              a0 = a0 * scale; a1 = a1 * scale;
              u32x4 o; o.x = pk2(a0[0], a0[1]); o.y = pk2(a0[2], a0[3]); o.z = pk2(a1[0], a1[1]); o.w = pk2(a1[2], a1[3]);
              const int t = wave * 8 + r;
              if (part == 0) { *(LAS u32x4*)(QN + t * 136 + c8) = o; *(u32x4*)(GQ + (size_t)(m0 + t) * 512 + h * 128 + c8) = o; }
              else if (part == 1) *(LAS u32x4*)(KN + t * 136 + c8) = o;
              else *(LAS u32x4*)(VS + r * 136 + c8) = o; } }
      WAVE_SYNC();
#pragma unroll
      for (int q = 0; q < 4; ++q) { const int chq = lane + 64 * (q & 1); const bool isk = q < 2; const LAS bf16* src = isk ? (KN + (wave * 8) * 136 + chq) : (VS + chq); unsigned hh[8];
#pragma unroll
          for (int e = 0; e < 8; ++e) hh[e] = src[e * 136];
          u32x4 w; w.x = hh[0] | (hh[1] << 16); w.y = hh[2] | (hh[3] << 16); w.z = hh[4] | (hh[5] << 16); w.w = hh[6] | (hh[7] << 16);
          *(LAS u32x4*)((isk ? KNT : VT) + chq * 72 + wave * 8) = w; }
      if (tid < 128) { const int dir = tid >> 6, i = tid & 63, t = dir ? 63 - i : i; const float* gp = (const float*)(A.ws() + WS_GATES) + (size_t)(m0 + t) * 48; const int c = dir * 4 + h;
          GC[dir * 128 + i] = -__expf(A.in(IALOG)[l * 8 + c]) * softplusf_(gp[40 + c] + A.in(IDTB)[l * 8 + c]); GC[dir * 128 + 64 + i] = sigmoidf_(gp[32 + c]); } }
    LBAR();
    const int g = lane >> 4, c16 = lane & 15;
#pragma unroll
    for (int x = 0; x < 4; ++x) { const int id = wave * 4 + x, ti = (id >> 2) & 3, tj = id & 3; const bool isq = id >= 16;
        f32x4 acc = {0.f, 0.f, 0.f, 0.f};
#pragma unroll
        for (int ks = 0; ks < 4; ++ks) acc = mma(lds_frag(isq ? QN : KN, 136, 16 * ti, 32 * ks, lane), lds_frag(KN, 136, 16 * tj, 32 * ks, lane), acc);
        LAS float* dst = isq ? QK : KK;
#pragma unroll
        for (int r = 0; r < 4; ++r) dst[(16 * ti + 4 * g + r) * 65 + 16 * tj + c16] = acc[r]; }
    float myg = 0.f;
    if (tid < 128) { myg = GC[(tid >> 6) * 128 + (tid & 63)];
#pragma unroll
        for (int o = 1; o < 64; o <<= 1) { const float t = __shfl_up(myg, o); if ((tid & 63) >= o) myg += t; } }
    LBAR();
    if (tid < 128) { const int dir = tid >> 6, i = tid & 63; GC[dir * 128 + i] = myg; float* gcb = (float*)(A.ws() + WS_GCB) + (size_t)(item * 2 + dir) * 128; gcb[i] = myg; gcb[64 + i] = GC[dir * 128 + 64 + i]; }
    LBAR();
    for (int q4 = tid; q4 < 2048; q4 += NTHR) { const int dir = q4 >> 10, i = (q4 >> 4) & 63, j0 = (q4 & 15) * 4, ti = dir ? 63 - i : i;
        const LAS float* gc = GC + dir * 128; const f32x4 gj = *(const LAS f32x4*)(gc + j0); const float gi = gc[i], bi = gc[64 + i];
        const f32x4 tt = __builtin_elementwise_min((f32x4){gi, gi, gi, gi} - gj, (f32x4){0.f, 0.f, 0.f, 0.f}) * 1.4426950408889634f;
        const f32x4 dec = {__builtin_amdgcn_exp2f(tt[0]), __builtin_amdgcn_exp2f(tt[1]), __builtin_amdgcn_exp2f(tt[2]), __builtin_amdgcn_exp2f(tt[3])};
        const LAS float* kr = KK + ti * 65; const LAS float* qr = QK + ti * 65; f32x4 kk, qk;
#pragma unroll
        for (int c = 0; c < 4; ++c) { const int tj = dir ? 63 - (j0 + c) : j0 + c; kk[c] = kr[tj]; qk[c] = qr[tj]; }
        f32x4 lv = kk * dec * bi, qv = qk * dec;
#pragma unroll
        for (int c = 0; c < 4; ++c) { lv[c] = (j0 + c < i) ? lv[c] : 0.f; qv[c] = (j0 + c <= i) ? qv[c] : 0.f; }
        const bool diag = (i >> 4) == (j0 >> 4);
        { u32x2 w; w.x = diag ? 0u : pk2(-lv[0], -lv[1]); w.y = diag ? 0u : pk2(-lv[2], -lv[3]); *(LAS u32x2*)(LB + dir * 4608 + i * 72 + j0) = w; }
        if (diag) *(LAS f32x4*)(Ld + dir * 1280 + (i >> 4) * 320 + (i & 15) * 20 + (j0 & 15)) = lv;
        { u32x2 w; w.x = pk2(qv[0], qv[1]); w.y = pk2(qv[2], qv[3]); *(u32x2*)((bf16*)(A.ws() + WS_GQKM) + (size_t)(item * 2 + dir) * 4096 + i * 64 + j0) = w; } }
    for (int idx = tid; idx < 2 * 64 * 72 / 2; idx += NTHR) ((LAS unsigned*)TT)[idx] = 0u;
    LBAR();
    if (wave < 2) { const int dir = wave; const LAS float* gc = GC + dir * 128;
        gdn_solve(LB + dir * 4608, Ld + dir * 1280, TT + dir * 4608, (LAS bf16*)(RB + dir * 1088), TB + (dir * 2) * 4608, TB + (dir * 2 + 1) * 4608, gc, dir, lane);
    } else { bf16* GKT = (bf16*)(A.ws() + WS_GKT) + (size_t)item * 8192;
        for (int c = tid - 128; c < 1024; c += NTHR - 128) { const int row = c >> 3, part = c & 7; *(u32x4*)(GKT + row * 64 + part * 8) = *(const LAS u32x4*)(KNT + row * 72 + part * 8); } }
    LBAR();
    { const int o = wave >> 1, dir = o >> 1, isw = o & 1; const LAS bf16* Xt = isw ? KNT : VT; const LAS bf16* Tb = TB + o * 4608;
      bf16* O = (bf16*)(A.ws() + (isw ? WS_GW : WS_GU)) + (size_t)(item * 2 + dir) * 8192;
#pragma unroll
      for (int mi = 0; mi < 2; ++mi) { const int mt = (wave & 1) * 2 + mi; const bf16x8 t0 = lds_frag(Tb, 72, 16 * mt, 0, lane), t1 = lds_frag(Tb, 72, 16 * mt, 32, lane);
#pragma unroll
          for (int nt = 0; nt < 8; ++nt) { f32x4 acc = {0.f, 0.f, 0.f, 0.f}; const bf16x8 x0 = lds_frag(Xt, 72, 16 * nt, 0, lane), x1 = lds_frag(Xt, 72, 16 * nt, 32, lane);
              if (isw) { acc = mma(x0, t0, acc); acc = mma(x1, t1, acc); }
              else { acc = mma(t0, x0, acc); acc = mma(t1, x1, acc); }
              u32x2 w; w.x = pk2(acc[0], acc[1]); w.y = pk2(acc[2], acc[3]);
              if (isw) *(u32x2*)(O + (16 * mt + c16) * 128 + 16 * nt + 4 * g) = w; else *(u32x2*)(O + (16 * nt + c16) * 64 + 16 * mt + 4 * g) = w; } } }
    LBAR();
}
#define GDN_BAR() do { asm volatile("s_waitcnt lgkmcnt(0)" ::: "memory"); __builtin_amdgcn_s_barrier(); asm volatile("" ::: "memory"); } while (0)
#if defined(PROBE_ID) && (PROBE_ID == 52 || PROBE_ID == 53)
#define GDN_BARP(id) do { if ((id) == PROBE_ID) { const unsigned long long t0_ = __builtin_amdgcn_s_memrealtime(); GDN_BAR(); const unsigned long long t1_ = __builtin_amdgcn_s_memrealtime(), dt_ = (t1_ - t0_) * 3ull; \
        while (__builtin_amdgcn_s_memrealtime() - t1_ < dt_) __builtin_amdgcn_s_sleep(4); } else GDN_BAR(); } while (0)
#else
#define GDN_BARP(id) GDN_BAR()
#endif
__device__ __forceinline__ void gdn_step_ids(int p, int b, int h, int dir, int& item, int& m0) {
    int ci; if (p < 4) ci = 256 + b * 4 + (dir ? 3 - p : p); else { const int q = p - 4; ci = b * 64 + (dir ? 63 - q : q); }
    item = ci * 4 + h; m0 = gdn_m0(ci);
}
constexpr int GNT = 2;
struct GdnS { bf16x8 w[4], k[4]; u32x2 ut[GNT]; f32x4 gc; float gl; };
struct GdnO { bf16x8 q[4], p[2]; f32x4 gc; };
__device__ __forceinline__ void gdn_load_s(const Ctx& A, GdnS& o, int p, int b, int h, int dir, unsigned offw, unsigned offk, unsigned offu, unsigned offgc) {
    int item, m0; gdn_step_ids(p, b, h, dir, item, m0); const int oi = item * 2 + dir; const char* ws = (const char*)A.ws();
    const char* bw = ws + WS_GW + (size_t)oi * 16384; const char* bk = ws + WS_GKT + (size_t)item * 16384; const char* bu = ws + WS_GU + (size_t)oi * 16384; const char* bg = ws + WS_GCB + (size_t)oi * 512;
#pragma unroll
    for (int ks = 0; ks < 4; ++ks) o.w[ks] = *(const bf16x8*)(bw + offw + 64 * ks);
    o.k[0] = *(const bf16x8*)(bk + offk); o.k[1] = *(const bf16x8*)(bk + offk + 64); o.k[2] = *(const bf16x8*)(bk + offk + 2048); o.k[3] = *(const bf16x8*)(bk + offk + 2048 + 64);
#pragma unroll
    for (int nt = 0; nt < GNT; ++nt) o.ut[nt] = *(const u32x2*)(bu + offu + 2048 * nt);
    o.gc = *(const f32x4*)(bg + offgc); o.gl = *(const float*)(bg + 252);
}
__device__ __forceinline__ void gdn_load_o(const Ctx& A, GdnO& o, int p, int b, int h, int dir, unsigned offq, unsigned offp, unsigned offgc) {
    int item, m0; gdn_step_ids(p, b, h, dir, item, m0); const int oi = item * 2 + dir; const char* ws = (const char*)A.ws();
    const char* bq = ws + WS_GQ + ((size_t)m0 * 512 + h * 128) * 2; const char* bp = ws + WS_GQKM + (size_t)oi * 8192; const char* bg = ws + WS_GCB + (size_t)oi * 512;
#pragma unroll
    for (int ks = 0; ks < 4; ++ks) o.q[ks] = *(const bf16x8*)(bq + offq + 64 * ks);
    o.p[0] = *(const bf16x8*)(bp + offp); o.p[1] = *(const bf16x8*)(bp + offp + 64);
    o.gc = *(const f32x4*)(bg + offgc);
}
__device__ __forceinline__ void gdn_step_s(const GdnS& o, f32x4 (&accs)[2][GNT], LAS bf16* ST, LAS bf16* VNO, LAS bf16* VNS, int dir, int w, int lane, int g, int c16) {
    const float gl = o.gl; const float e0 = __expf(gl - o.gc.x), e1 = __expf(gl - o.gc.y), e2 = __expf(gl - o.gc.z), e3 = __expf(gl - o.gc.w);
#pragma unroll
    for (int nt = 0; nt < GNT; ++nt) {
        f32x4 acc = {bf2f(o.ut[nt].x & 0xffffu), bf2f(o.ut[nt].x >> 16), bf2f(o.ut[nt].y & 0xffffu), bf2f(o.ut[nt].y >> 16)};
#pragma unroll
        for (int ks = 0; ks < 4; ++ks) acc = mma(o.w[ks], lds_frag(ST, 136, 16 * nt, 32 * ks, lane), acc);
        u32x2 v; v.x = pk2(acc[0], acc[1]); v.y = pk2(acc[2], acc[3]);
        *(LAS u32x2*)(VNO + (16 * nt + c16) * 72 + 16 * w + 4 * g) = v;
        const float s0 = acc[0] * e0, s1 = acc[1] * e1, s2 = acc[2] * e2, s3 = acc[3] * e3;
        if (dir) { v.x = pk2(s3, s2); v.y = pk2(s1, s0); *(LAS u32x2*)(VNS + (16 * nt + c16) * 72 + 60 - 16 * w - 4 * g) = v; }
        else { v.x = pk2(s0, s1); v.y = pk2(s2, s3); *(LAS u32x2*)(VNS + (16 * nt + c16) * 72 + 16 * w + 4 * g) = v; } }
    GDN_BARP(52);
    const float al = __expf(gl);
#pragma unroll
    for (int nt = 0; nt < GNT; ++nt) {
        const bf16x8 v0 = lds_frag(VNS, 72, 16 * nt, 0, lane), v1 = lds_frag(VNS, 72, 16 * nt, 32, lane);
#pragma unroll
        for (int x = 0; x < 2; ++x) { f32x4 s = accs[x][nt] * al; s = mma(o.k[2 * x], v0, s); s = mma(o.k[2 * x + 1], v1, s); accs[x][nt] = s;
            u32x2 v; v.x = pk2(s[0], s[1]); v.y = pk2(s[2], s[3]); *(LAS u32x2*)(ST + (16 * nt + c16) * 136 + 32 * w + 16 * x + 4 * g) = v; } }
    GDN_BARP(52);
}
__device__ __forceinline__ void gdn_step_o(const Ctx& A, const GdnO& o, LAS bf16* ST, LAS bf16* VNO, int p, int b, int h, int dir, const unsigned (&offo)[4], int lane) {
    f32x4 acc[GNT]; const float e0 = __expf(o.gc.x), e1 = __expf(o.gc.y), e2 = __expf(o.gc.z), e3 = __expf(o.gc.w);
#pragma unroll
    for (int nt = 0; nt < GNT; ++nt) { f32x4 a = {0.f, 0.f, 0.f, 0.f};
#pragma unroll
        for (int ks = 0; ks < 4; ++ks) a = mma(o.q[ks], lds_frag(ST, 136, 16 * nt, 32 * ks, lane), a);
        a[0] *= e0; a[1] *= e1; a[2] *= e2; a[3] *= e3; acc[nt] = a; }
    GDN_BARP(53);
    int item, m0; gdn_step_ids(p, b, h, dir, item, m0);
    char* og = (char*)A.ws() + WS_OG + (((size_t)dir * NTOK + m0) * 512 + h * 128) * 2;
#pragma unroll
    for (int nt = 0; nt < GNT; ++nt) { f32x4 a = acc[nt]; a = mma(o.p[0], lds_frag(VNO, 72, 16 * nt, 0, lane), a); a = mma(o.p[1], lds_frag(VNO, 72, 16 * nt, 32, lane), a);
#pragma unroll
        for (int r = 0; r < 4; ++r) *(bf16*)(og + offo[r] + 32 * nt) = (bf16)f2bf(a[r]); }
    GDN_BARP(53);
}
__device__ __forceinline__ void gdn_scan_chain(const Ctx& A, LAS unsigned char* lds, int chain, int sl, int tid, int lane, int wave) {
    LAS bf16* ST = (LAS bf16*)lds; LAS bf16* VNO = (LAS bf16*)(lds + 34816); LAS bf16* VNS = (LAS bf16*)(lds + 53248);
    const int g = lane >> 4, c16 = lane & 15, b = chain >> 3, h = (chain >> 1) & 3, dir = chain & 1, w4 = wave & 3;
    for (int i = tid; i < 16 * GNT * 136 / 2; i += NTHR) ((LAS unsigned*)ST)[i] = 0u;
    const unsigned offgc = (unsigned)(16 * w4 + 4 * g) * 4u;
    GDN_BAR();
    if (wave < 4) {
        const unsigned offw = (unsigned)((16 * w4 + c16) * 128 + 8 * g) * 2u, offk = (unsigned)((32 * w4 + c16) * 64 + 8 * g) * 2u, offu = (unsigned)((16 * GNT * sl + c16) * 64 + 16 * w4 + 4 * g) * 2u;
        f32x4 accs[2][GNT];
#pragma unroll
        for (int x = 0; x < 2; ++x)
#pragma unroll
            for (int nt = 0; nt < GNT; ++nt) accs[x][nt] = (f32x4){0.f, 0.f, 0.f, 0.f};
        GdnS o0, o1, o2;
        gdn_load_s(A, o0, 0, b, h, dir, offw, offk, offu, offgc); gdn_load_s(A, o1, 1, b, h, dir, offw, offk, offu, offgc);
#pragma unroll 1
        for (int p = 0; p < 66; p += 3) {
            gdn_load_s(A, o2, p + 2, b, h, dir, offw, offk, offu, offgc); gdn_step_s(o0, accs, ST, VNO, VNS, dir, w4, lane, g, c16);
            gdn_load_s(A, o0, p + 3, b, h, dir, offw, offk, offu, offgc); gdn_step_s(o1, accs, ST, VNO, VNS, dir, w4, lane, g, c16);
            gdn_load_s(A, o1, p + 4, b, h, dir, offw, offk, offu, offgc); gdn_step_s(o2, accs, ST, VNO, VNS, dir, w4, lane, g, c16);
        }
        gdn_step_s(o0, accs, ST, VNO, VNS, dir, w4, lane, g, c16); gdn_step_s(o1, accs, ST, VNO, VNS, dir, w4, lane, g, c16);
    } else {
        const int i = 16 * w4 + c16, t = dir ? 63 - i : i;
        const unsigned offq = (unsigned)(t * 512 + 8 * g) * 2u, offp = (unsigned)(i * 64 + 8 * g) * 2u; unsigned offo[4];
#pragma unroll
        for (int r = 0; r < 4; ++r) { const int io = 16 * w4 + 4 * g + r, to = dir ? 63 - io : io; offo[r] = (unsigned)(to * 512 + 16 * GNT * sl + c16) * 2u; }
        GdnO o0, o1, o2;
        gdn_load_o(A, o0, 0, b, h, dir, offq, offp, offgc); gdn_load_o(A, o1, 1, b, h, dir, offq, offp, offgc);
#pragma unroll 1
        for (int p = 0; p < 66; p += 3) {
            gdn_load_o(A, o2, p + 2, b, h, dir, offq, offp, offgc); gdn_step_o(A, o0, ST, VNO, p, b, h, dir, offo, lane);
            gdn_load_o(A, o0, p + 3, b, h, dir, offq, offp, offgc); gdn_step_o(A, o1, ST, VNO, p + 1, b, h, dir, offo, lane);
            gdn_load_o(A, o1, p + 4, b, h, dir, offq, offp, offgc); gdn_step_o(A, o2, ST, VNO, p + 2, b, h, dir, offo, lane);
        }
        gdn_step_o(A, o0, ST, VNO, 66, b, h, dir, offo, lane); gdn_step_o(A, o1, ST, VNO, 67, b, h, dir, offo, lane);
    }
    asm volatile("s_waitcnt vmcnt(0)" ::: "memory"); __syncthreads();
}
__device__ __forceinline__ void ph_gdn_finish(const Ctx& A, int l, int lane, int wave, int G, int nrows) {
    const int gw = blockIdx.x * NWAVES + wave, NGW = G * NWAVES;
    const bf16* OG = (const bf16*)(A.ws() + WS_OG); const bf16* cols = (const bf16*)(A.ws() + WS_COLS); bf16* MIX = (bf16*)(A.ws() + WS_MIX);
    const float* ng = A.in(IGDNN) + l * 128 + (lane & 15) * 8;
    const f32x4 n0 = *(const f32x4*)ng, n1 = *(const f32x4*)(ng + 4);
    for (int m0 = gw * 4; m0 < nrows; m0 += NGW * 4) {
        u32x4 fw[4], bw[4], zw[4];
#pragma unroll
        for (int q = 0; q < 4; ++q) { const int m = m0 + q; fw[q] = *(const u32x4*)(OG + (size_t)m * 512 + 8 * lane); bw[q] = *(const u32x4*)(OG + ((size_t)NTOK + m) * 512 + 8 * lane);
            zw[q] = *(const u32x4*)(cols + (size_t)m * DIN + C_GDN_Z + 8 * lane); }
#pragma unroll
        for (int q = 0; q < 4; ++q) { const int m = m0 + q; const u32x4 f = fw[q], b = bw[q];
            const f32x4 v0 = {bf2f(f.x & 0xffffu) + bf2f(b.x & 0xffffu), bf2f(f.x >> 16) + bf2f(b.x >> 16), bf2f(f.y & 0xffffu) + bf2f(b.y & 0xffffu), bf2f(f.y >> 16) + bf2f(b.y >> 16)};
            const f32x4 v1 = {bf2f(f.z & 0xffffu) + bf2f(b.z & 0xffffu), bf2f(f.z >> 16) + bf2f(b.z >> 16), bf2f(f.w & 0xffffu) + bf2f(b.w & 0xffffu), bf2f(f.w >> 16) + bf2f(b.w >> 16)};
            float ss = v0.x * v0.x + v0.y * v0.y + v0.z * v0.z + v0.w * v0.w + v1.x * v1.x + v1.y * v1.y + v1.z * v1.z + v1.w * v1.w;
            ss = row16_sum(ss);
            const float rs = rsqrtf(ss * (1.f / 128.f) + RMS_EPS); const u32x4 z = zw[q];
            float y[8];
            y[0] = v0.x * rs * n0.x * siluf_(bf2f(z.x & 0xffffu)); y[1] = v0.y * rs * n0.y * siluf_(bf2f(z.x >> 16));
            y[2] = v0.z * rs * n0.z * siluf_(bf2f(z.y & 0xffffu)); y[3] = v0.w * rs * n0.w * siluf_(bf2f(z.y >> 16));
            y[4] = v1.x * rs * n1.x * siluf_(bf2f(z.z & 0xffffu)); y[5] = v1.y * rs * n1.y * siluf_(bf2f(z.z >> 16));
            y[6] = v1.z * rs * n1.z * siluf_(bf2f(z.w & 0xffffu)); y[7] = v1.w * rs * n1.w * siluf_(bf2f(z.w >> 16));
            u32x4 o; o.x = pk2(y[0], y[1]); o.y = pk2(y[2], y[3]); o.z = pk2(y[4], y[5]); o.w = pk2(y[6], y[7]);
            *(u32x4*)(MIX + (size_t)m * D + 512 + 8 * lane) = o; }
    }
}

constexpr int NPH = 13;
#ifndef MK_MULTI
#define MK_MULTI 0
#endif
#ifndef PHMASK
#define PHMASK 0x1fff
#endif
#define IN(k) (((PHMASK >> (k)) & 1) && A.ph_lo <= (k) && (k) < A.ph_hi)
#define SEAM() do { if (fused) xcd_barrier(bar); } while (0)
#define PH_BEGIN() int tid = tid0; asm volatile("" : "+v"(tid)); int zz = 0; asm volatile("" : "+s"(zz)); const int lane = tid & 63, wave = __builtin_amdgcn_readfirstlane(tid >> 6); const Ctx C{&A, zz}; (void)lane; (void)wave
#ifdef PROBE_ID
#ifndef PROBE_ID2
#define PROBE_ID2 -1
#endif
#ifndef PROBE_ID3
#define PROBE_ID3 -1
#endif
#define PT0() const unsigned long long pt0_ = __builtin_amdgcn_s_memrealtime()
#define PT1(id) do { if ((id) == PROBE_ID || (id) == PROBE_ID2 || (id) == PROBE_ID3) { const unsigned long long pt1_ = __builtin_amdgcn_s_memrealtime(), dt_ = (pt1_ - pt0_) * 3ull; while (__builtin_amdgcn_s_memrealtime() - pt1_ < dt_) __builtin_amdgcn_s_sleep(16); } } while (0)
#else
#define PT0() do {} while (0)
#define PT1(id) do {} while (0)
#endif
#define CVT_TAIL(k, t0, nt) do { if constexpr (!last) { int tq_ = tid0; asm volatile("" : "+v"(tq_)); int z2_ = 0; asm volatile("" : "+s"(z2_)); const Ctx C2_{&A, z2_}; \
        cvt_drain(C2_, lds, l + 1, (t0), (nt), (unsigned*)(C2_.ws() + WS_CTL) + CW_CQ + (l * 4 + (k)) * 64, tq_, tq_ & 63, __builtin_amdgcn_readfirstlane(tq_ >> 6)); } } while (0)
constexpr int CVQ7 = 1200, CVQ10 = 200, CVQ11 = CV_TICKETS - CVQ7 - CVQ10;
constexpr int CV0_FIRST = (CV_IN + CV_OUT) / 8;
template <int L>
__device__ __forceinline__ void layer_body(const Args& A, LAS unsigned char* lds, const int tid0, const int G, const int vcu, const bool fused, const XcdBarrier& bar) {
    constexpr int l = L; constexpr bool last = (L == DEPTH - 1); constexpr int nrows = last ? NLAT : NTOK;
    if constexpr (L == 0) {
        if (IN(0)) { PH_BEGIN(); { PT0(); ph_mods(C, lds, tid, G); PT1(1); } { PT0(); cvt_drain(C, lds, 0, 0, CV0_FIRST, (unsigned*)(C.ws() + WS_CTL) + CW_CQ + 15 * 64, tid, lane, wave); PT1(0); } SEAM(); }
        if (IN(1)) { PH_BEGIN(); ph_init(C, lane, wave, G); SEAM(); }
    }
    if (IN(2)) { PH_BEGIN();
        pg8::Gemm g{(const bf16*)(C.ws() + WS_H), (const bf16*)(C.ws() + WS_WIN) + (size_t)l * DINP * D, NTOK, DINP, D};
        int Gp = G, cc = (int)blockIdx.x;
        if constexpr (L == 0) { if (G >= 256) { Gp = 176; if (cc >= Gp) cc = (NTOK / 256) * (DINP / 256); } }
        pg8::StaticOrder S; S.init(NTOK, DINP, Gp, cc);
        EpiCols E{(bf16*)(C.ws() + WS_COLS), (float*)(C.ws() + WS_GATES)};
        PT0(); pg8::gemm_phase<EpiCols, pg8::StaticOrder>(lds, g, S, E, nullptr, tid); PT1(2);
        if constexpr (L == 0) { int tq_ = tid0; asm volatile("" : "+v"(tq_)); int z2_ = 0; asm volatile("" : "+s"(z2_)); const Ctx C2_{&A, z2_};
            cvt_drain(C2_, lds, 0, CV0_FIRST, CV_TICKETS - CV0_FIRST, (unsigned*)(C2_.ws() + WS_CTL) + CW_CQ + 14 * 64, tq_, tq_ & 63, __builtin_amdgcn_readfirstlane(tq_ >> 6)); }
        SEAM();
    }
    if (IN(4)) { PH_BEGIN();
        { PT0(); LAS int* wq = (LAS int*)(lds + MISC_OFF + 512); unsigned* ctr = (unsigned*)(C.ws() + WS_CTL) + CW_PQ + l * 64;
          __syncthreads(); if (tid == 0) wq[0] = (int)atomicAdd(ctr, 1u); __syncthreads();
          for (int u = wq[0]; u < 1088 + 272; ) { int nxt = 0; if (tid == 0) nxt = (int)atomicAdd(ctr, 1u);
              int tq = tid; asm volatile("" : "+v"(tq));
              if (u >= 272) gdn_prep_item(C, l, lds, u - 272, tq, tq & 63, wave); else gla_a_chunk(C, l, lds, tq & 63, wave, u);
              __syncthreads(); if (tid == 0) wq[0] = nxt; __syncthreads(); u = wq[0]; }
          PT1(41); }
        SEAM();
    }
    if (IN(5)) { PH_BEGIN();
        { PT0(); if ((int)blockIdx.x < 128) gdn_scan_chain(C, lds, (int)(blockIdx.x & 7) + 8 * (int)(blockIdx.x >> 5), (int)(blockIdx.x >> 3) & 3, tid, lane, wave); else ph_gla_b(C, tid, blockIdx.x - 128, 128); PT1(50); }
        { PT0(); LAS int* wq = (LAS int*)(lds + MISC_OFF + 512); unsigned* ctr = (unsigned*)(C.ws() + WS_CTL) + CW_NAQ + l * 64; const int nun = last ? 1024 : 1088;
          __syncthreads(); if (tid == 0) wq[0] = (int)atomicAdd(ctr, 1u); __syncthreads();
          for (int u = wq[0]; u < nun; ) { int nxt = 0; if (tid == 0) nxt = (int)atomicAdd(ctr, 1u);
              int tq = tid; asm volatile("" : "+v"(tq));
              if (u < 1024) na_unit<false>(C, l, lds, u, tq, tq & 63, wave); else na_unit<true>(C, l, lds, u - 1024, tq, tq & 63, wave);
              __syncthreads(); if (tid == 0) wq[0] = nxt; __syncthreads(); u = wq[0]; }
          PT1(31); }
        SEAM();
    }
    if (IN(6)) { PH_BEGIN();
        { PT0(); ph_gla_c(C, l, lane, wave, G, last ? 2048 : 2176); PT1(60); }
        { PT0(); ph_gdn_finish(C, l, lane, wave, G, nrows); PT1(61); }
        SEAM();
    }
    if (IN(7)) { PH_BEGIN();
        pg8::Gemm g{(const bf16*)(C.ws() + WS_MIX), (const bf16*)(C.ws() + WS_WOUT) + (size_t)l * D * D, nrows, D, D};
        int Gp = G, cc = (int)blockIdx.x;
        if constexpr (!last) { constexpr int units = (nrows / 256) * (D / 256); const int rounds = (units + G - 1) / G; Gp = min(G, (((units + rounds - 1) / rounds) + 7) & ~7); if (cc >= Gp) cc = units; }
        pg8::StaticOrder S; S.init(nrows, D, Gp, cc);
        EpiOut E{(float*)(C.ws() + WS_X), (const float*)(C.ws() + WS_MODS) + (size_t)l * 5 * 6144};
        PT0(); pg8::gemm_phase<EpiOut, pg8::StaticOrder>(lds, g, S, E, nullptr, tid); PT1(7);
        CVT_TAIL(0, 0, CVQ7);
        SEAM();
    }
    if (IN(8)) { PH_BEGIN(); PT0(); ph_ln1_route(C, l, lds, tid, lane, wave, nrows); PT1(8); SEAM(); }
    if (IN(10)) { PH_BEGIN();
        LAS int* tab = (LAS int*)(lds + MISC_OFF + 1024);
        moe_tables((const unsigned*)(C.ws() + WS_CTL) + CW_CNT + l * 64, tab, tid);
        pg8::Gemm g{(const bf16*)(C.ws() + WS_H), (const bf16*)(C.ws() + WS_WGU) + (size_t)l * NE * 2048 * D, 0, 0, D};
        int Gp = G, cc = vcu; const int units = tab[40] * 8;
        if constexpr (!last) { if (G % 8 == 0) { const int rounds = (units + G - 1) / G; Gp = min(G, (((units + rounds - 1) / rounds) + 7) & ~7); const int gp8 = Gp >> 3, bx = (int)blockIdx.x; cc = (bx >> 3) < gp8 ? (bx & 7) * gp8 + (bx >> 3) : units; } }
        MoeOrder S{tab + 64, units, 8, Gp, cc, tab, (const int*)(C.ws() + WS_ETOK)};
        EpiAct E{(bf16*)(C.ws() + WS_ACT), C.in(IBGU) + (size_t)l * NE * 2048};
        PT0(); pg8::gemm_phase<EpiAct, MoeOrder, true>(lds, g, S, E, nullptr, tid); PT1(10);
        CVT_TAIL(1, CVQ7, CVQ10);
        SEAM();
    }
    if (IN(11)) { PH_BEGIN();
        LAS int* tab = (LAS int*)(lds + MISC_OFF + 1024);
        moe_tables((const unsigned*)(C.ws() + WS_CTL) + CW_CNT + l * 64, tab, tid);
        pg8::Gemm g{(const bf16*)(C.ws() + WS_ACT), (const bf16*)(C.ws() + WS_WD) + (size_t)l * NE * D * D, 0, 0, D};
        int Gp = G, cc = vcu; const int units = tab[40] * 4;
        if constexpr (!last) { if (G % 8 == 0) { const int rounds = (units + G - 1) / G; Gp = min(G, (((units + rounds - 1) / rounds) + 7) & ~7); const int gp8 = Gp >> 3, bx = (int)blockIdx.x; cc = (bx >> 3) < gp8 ? (bx & 7) * gp8 + (bx >> 3) : units; } }
        MoeOrder S{tab + 64, units, 4, Gp, cc, tab, (const int*)(C.ws() + WS_ETOK)};
        EpiY E{(bf16*)(C.ws() + WS_YB), C.in(IBD) + (size_t)l * NE * D};
        PT0(); pg8::gemm_phase<EpiY, MoeOrder>(lds, g, S, E, nullptr, tid); PT1(11);
        CVT_TAIL(2, CVQ7 + CVQ10, CVQ11);
        SEAM();
    }
    if (IN(12)) { PH_BEGIN(); PT0(); ph_combine(C, l, lds, tid, lane, wave, G, nrows); PT1(12); if (!last) SEAM(); }
}
__global__ void __launch_bounds__(NTHR, 2) fwd(Args A) {
    extern __shared__ __attribute__((aligned(16))) unsigned char lds_raw[];
    LAS unsigned char* lds = (LAS unsigned char*)lds_raw;
    const int tid0 = threadIdx.x, G = gridDim.x;
    volatile LAS unsigned* misc = (volatile LAS unsigned*)(lds + MISC_OFF);
    if (tid0 < 64) misc[tid0] = 0u;
    __syncthreads();
    unsigned* ctl = (unsigned*)(A.ws + WS_CTL);
    XcdBarrier bar = xcd_barrier_post(ctl + CW_BAR, misc + 8);
    const bool fused = (A.ph_hi - A.ph_lo) > 1;
    const int vcu = (G % 8 == 0) ? ((int)(blockIdx.x % 8) * (G / 8) + (int)(blockIdx.x / 8)) : (int)blockIdx.x;
    if (A.l_lo <= 0 && 0 < A.l_hi) layer_body<0>(A, lds, tid0, G, vcu, fused, bar);
    if (A.l_lo <= 1 && 1 < A.l_hi) layer_body<1>(A, lds, tid0, G, vcu, fused, bar);
    if (A.l_lo <= 2 && 2 < A.l_hi) layer_body<2>(A, lds, tid0, G, vcu, fused, bar);
    if (A.l_lo <= 3 && 3 < A.l_hi) layer_body<3>(A, lds, tid0, G, vcu, fused, bar);
}
#undef IN
#undef SEAM
#undef PH_BEGIN

extern "C" void kernel_launch(void* const* d_in, const int* in_sizes, int n_in, void* d_out, int out_size, void* d_ws, size_t ws_size, hipStream_t stream) {
    static int grid = 0;
    if (grid == 0) {
        if (n_in != NIN || out_size != NLAT * D || ws_size < WS_END) { fprintf(stderr, "kernel_launch: unexpected problem (n_in %d, out %d, ws %zu)\n", n_in, out_size, ws_size); grid = -1; return; }
        int dev = 0, cus = 0, per_cu = 0;
        if (hipGetDevice(&dev) != hipSuccess || hipDeviceGetAttribute(&cus, hipDeviceAttributeMultiprocessorCount, dev) != hipSuccess) { grid = -1; return; }
        if (hipFuncSetAttribute((const void*)fwd, hipFuncAttributeMaxDynamicSharedMemorySize, LDS_BYTES) != hipSuccess) { fprintf(stderr, "kernel_launch: hipFuncSetAttribute failed\n"); grid = -1; return; }
        if (hipOccupancyMaxActiveBlocksPerMultiprocessor(&per_cu, (const void*)fwd, NTHR, LDS_BYTES) != hipSuccess || per_cu < 1) fprintf(stderr, "kernel_launch: occupancy query says %d\n", per_cu);
        (void)hipGetLastError();
        grid = cus;
    }
    if (grid < 0) return;
    (void)hipMemsetAsync((char*)d_ws + WS_CTL, 0, CTL_BYTES, stream);
    Args a{};
    for (int i = 0; i < NIN; ++i) a.in[i] = (const float*)d_in[i];
    a.out = (float*)d_out; a.ws = (unsigned char*)d_ws;
#if MK_MULTI
    for (int l = 0; l < DEPTH; ++l)
        for (int ph = (l == 0 ? 0 : 2); ph < NPH; ++ph) { a.l_lo = l; a.l_hi = l + 1; a.ph_lo = ph; a.ph_hi = ph + 1;
            hipLaunchKernelGGL(fwd, dim3(grid), dim3(NTHR), LDS_BYTES, stream, a); }
#else
    a.l_lo = 0; a.l_hi = DEPTH; a.ph_lo = 0; a.ph_hi = NPH;
    hipLaunchKernelGGL(fwd, dim3(grid), dim3(NTHR), LDS_BYTES, stream, a);
#endif
}
```

```cpp
#include <hip/hip_runtime.h>
#include <cstdio>
#include <cstdint>

namespace pg8 {
#define PG8_LAS __attribute__((address_space(3)))
typedef unsigned short bf16_t;
typedef short bf16x8 __attribute__((ext_vector_type(8)));
typedef float f32x4 __attribute__((ext_vector_type(4)));
typedef unsigned u32x4 __attribute__((ext_vector_type(4)));
constexpr int BM = 256, BK = 64, HALF = 128, HTB = HALF * BK * 2  , STAGE_BYTES = 8 * HTB, NXCD = 8, WGM = 8;

__host__ __device__ __forceinline__ int lds_byte(int r, int c) { const int st = (r >> 4) * 2 + (c >> 5), rr = r & 15, cc = c & 31, ob = rr * 64 + cc * 2; return st * 1024 + (ob ^ (((ob >> 9) & 1) << 5)); }
__host__ __device__ __forceinline__ void stage_rc(int b, int& R, int& C) { const int st = b / 1024, sb = b % 1024, swz = sb ^ (((sb >> 9) & 1) << 5); R = (st >> 1) * 16 + swz / 64; C = (st & 1) * 32 + (swz % 64) / 2; }
__host__ __device__ __forceinline__ int perm32(int rho) { const int n = rho >> 4, i = rho & 15; return 8 * (i >> 2) + 4 * n + (i & 3); }

struct Unit { int pm, pn; };
struct Gemm { const bf16_t* A; const bf16_t* Bt; int M, N, K; };

struct StaticOrder {
    int nM, nN, nwg, G, c;
    __host__ __device__ void init(int M, int N, int G_, int c_) { nM = M / BM; nN = N / BM; nwg = nM * nN; G = G_; c = c_; }
    __host__ __device__ bool next(int i, Unit& u) const {
        const long L = (long)i * G + c; if (L >= nwg) return false;
        int wgid = (int)L; { const int q = nwg / NXCD, r = nwg % NXCD, xcd = wgid % NXCD, off = wgid / NXCD; wgid = (xcd < r ? xcd * (q + 1) : r * (q + 1) + (xcd - r) * q) + off; }
        const int nig = WGM * nN, gid = wgid / nig, fm = gid * WGM, gsz = (nM - fm) < WGM ? (nM - fm) : WGM;
        u.pm = fm + ((wgid % nig) % gsz); u.pn = (wgid % nig) / gsz; return true;
    }
    __device__ __forceinline__ void a_ready(const Unit&) const {}
    __device__ __forceinline__ void done(const Unit&) const {}
};
__device__ __forceinline__ unsigned cvt_pk_bf16(float lo, float hi) { unsigned r; asm volatile("v_cvt_pk_bf16_f32 %0, %1, %2" : "=v"(r) : "v"(lo), "v"(hi)); return r; }
template <class Epi, class Sched, bool GATHER = false, bool STAMP = false>
__device__ __forceinline__ void gemm_phase(PG8_LAS unsigned char* lds, const Gemm g, const Sched& S, const Epi& E, unsigned long long* stamps, const int tid) {
    const int wid = __builtin_amdgcn_readfirstlane(tid >> 6), lane = tid & 63, wr = wid >> 2, wc = wid & 3, fr = lane & 15, fq = lane >> 4;
    const int K = g.K, nt = K / BK;
    int ts_lo = 0, ts_hi = 0, nts = 0; const unsigned long long rt_entry = STAMP ? (unsigned long long)wall_clock64() : 0ull;
#define PG8_STAMP() do { if (STAMP && wid == 0 && nts < 64) { const unsigned long long _c = (unsigned long long)clock64(); \
        ts_lo = (lane == nts) ? (int)(unsigned)_c : ts_lo; ts_hi = (lane == nts) ? (int)(unsigned)(_c >> 32) : ts_hi; ++nts; } } while (0)
    PG8_STAMP();
    unsigned voffA[2], voffB[2]; int rowA[2];
#pragma unroll
    for (int i = 0; i < 2; ++i) { int R, C; stage_rc(tid * 16 + i * 8192, R, C); const int Rb = Epi::PERM ? ((R & ~31) + perm32(R & 31)) : R;
        voffA[i] = (unsigned)(R * K + C) * 2u; voffB[i] = (unsigned)(Rb * K + C) * 2u; rowA[i] = R; }
    unsigned vAc[2][2], vAn[2][2];
    const size_t kstep = (size_t)(BK * 2);
    const size_t hstep = (size_t)HALF * K * 2;
    const size_t tstep = 2 * hstep;
    const unsigned ldsw = (unsigned)wid * 1024u;
    const int aoff = lds_byte(wr * 64 + fr, fq * 8), boff = lds_byte(wc * 32 + fr, fq * 8);
#define PG8_SA(b, h) (((b) * 2 + (h)) * HTB)
#define PG8_SB(b, h) ((4 + (b) * 2 + (h)) * HTB)
#define PG8_STAGE(bufoff, gbase, voff) do { _Pragma("unroll") for (int _i = 0; _i < 2; ++_i) \
        __builtin_amdgcn_global_load_lds((const unsigned*)((const char*)(gbase) + (voff)[_i]), (PG8_LAS unsigned*)(lds + (bufoff) + ldsw + _i * 8192), 16, 0, 0); } while (0)
#define PG8_GOFF(dstv, u) do { _Pragma("unroll") for (int _h = 0; _h < 2; ++_h) _Pragma("unroll") for (int _i = 0; _i < 2; ++_i) \
        dstv[_h][_i] = (unsigned)S.a_row(u, _h * HALF + rowA[_i]) * (unsigned)(K * 2) + (voffA[_i] - (unsigned)(rowA[_i] * K * 2)); } while (0)
#define PG8_STAGE_A(bufoff, usenext, h, kb) do { if constexpr (GATHER) { const unsigned _o0 = (usenext) ? vAn[h][0] : vAc[h][0], _o1 = (usenext) ? vAn[h][1] : vAc[h][1]; const char* _gb = (const char*)g.A + (kb); \
        __builtin_amdgcn_global_load_lds((const unsigned*)(_gb + _o0), (PG8_LAS unsigned*)(lds + (bufoff) + ldsw), 16, 0, 0); \
        __builtin_amdgcn_global_load_lds((const unsigned*)(_gb + _o1), (PG8_LAS unsigned*)(lds + (bufoff) + ldsw + 8192), 16, 0, 0); } \
    else { const char* _gb = ((usenext) ? nA : cA) + (h) * hstep + (kb); PG8_STAGE(bufoff, _gb, voffA); } } while (0)
#define PG8_LDA(dst, b, h) do { _Pragma("unroll") for (int m = 0; m < 4; ++m) _Pragma("unroll") for (int k = 0; k < 2; ++k) dst[m][k] = *(const PG8_LAS bf16x8*)(lds + PG8_SA(b, h) + aoff + m * 2048 + k * 1024); } while (0)
#define PG8_LDB(dst, b, h) do { _Pragma("unroll") for (int n = 0; n < 2; ++n) _Pragma("unroll") for (int k = 0; k < 2; ++k) dst[n][k] = *(const PG8_LAS bf16x8*)(lds + PG8_SB(b, h) + boff + n * 2048 + k * 1024); } while (0)
#define PG8_MMA(ai, bj, At, Bt) do { __builtin_amdgcn_s_setprio(1); _Pragma("unroll") for (int m = 0; m < 4; ++m) _Pragma("unroll") for (int n = 0; n < 2; ++n) _Pragma("unroll") for (int k = 0; k < 2; ++k) \
        acc[ai][bj][m][n] = __builtin_amdgcn_mfma_f32_16x16x32_bf16(Bt[n][k], At[m][k], acc[ai][bj][m][n], 0, 0, 0); __builtin_amdgcn_s_setprio(0); } while (0)
#define PG8_WAIT_V(n) asm volatile("s_waitcnt vmcnt(" #n ")" ::: "memory")
#define PG8_WAIT_L(n) asm volatile("s_waitcnt lgkmcnt(" #n ")" ::: "memory")
#define PG8_BAR __builtin_amdgcn_s_barrier()
#define PG8_SCHED __builtin_amdgcn_sched_barrier(0)
    Unit cur, nxt; int ui = 0;
    if (!S.next(0, cur)) return;
    f32x4 acc[2][2][4][2];
#pragma unroll
    for (int a = 0; a < 2; ++a)
#pragma unroll
        for (int b = 0; b < 2; ++b)
#pragma unroll
            for (int m = 0; m < 4; ++m)
#pragma unroll
                for (int n = 0; n < 2; ++n) acc[a][b][m][n] = (f32x4){0.f, 0.f, 0.f, 0.f};
    bf16x8 At[4][2], B0[2][2], B1[2][2];
    const char* cA = (const char*)g.A + (size_t)cur.pm * tstep; const char* cB = (const char*)g.Bt + (size_t)cur.pn * tstep; const char* nA = cA;
    S.a_ready(cur);
    if constexpr (GATHER) { PG8_GOFF(vAc, cur); PG8_GOFF(vAn, cur); }
    PG8_STAGE(PG8_SB(0, 0), cB, voffB); PG8_STAGE_A(PG8_SA(0, 0), false, 0, (size_t)0); PG8_STAGE(PG8_SB(0, 1), cB + hstep, voffB); PG8_STAGE_A(PG8_SA(0, 1), false, 1, (size_t)0);
    if (wr == 1) PG8_BAR;
    PG8_WAIT_V(4); PG8_BAR;
    PG8_STAGE(PG8_SB(1, 0), cB + kstep, voffB); PG8_STAGE_A(PG8_SA(1, 0), false, 0, kstep); PG8_STAGE(PG8_SB(1, 1), cB + hstep + kstep, voffB);
    PG8_WAIT_V(6); PG8_BAR;
    PG8_STAMP();
    for (;;) {
        const bool has_next = S.next(ui + 1, nxt);
        nA = has_next ? (const char*)g.A + (size_t)nxt.pm * tstep : cA;
        if constexpr (GATHER) { if (has_next) PG8_GOFF(vAn, nxt); }
        const char* nB = has_next ? (const char*)g.Bt + (size_t)nxt.pn * tstep : cB;
        for (int t = 0; t < nt; t += 2) {
            const bool last = (t == nt - 2);
            const size_t k1 = (size_t)(t + 1) * kstep, k2 = last ? (size_t)0 : (size_t)(t + 2) * kstep;
            const char* b2 = last ? nB : cB + (size_t)(t + 2) * kstep; const char* b3 = b2 + kstep;
            if (last && has_next) S.a_ready(nxt);
            PG8_LDB(B0, 0, 0); PG8_SCHED; PG8_LDA(At, 0, 0); PG8_STAGE_A(PG8_SA(1, 1), false, 1, k1);
            PG8_WAIT_L(8); PG8_BAR; PG8_WAIT_L(0); PG8_MMA(0, 0, At, B0); PG8_BAR; PG8_SCHED;
            PG8_LDB(B1, 0, 1); PG8_STAGE(PG8_SB(0, 0), b2, voffB);
            PG8_BAR; PG8_WAIT_L(0); PG8_MMA(0, 1, At, B1); PG8_BAR;
            PG8_LDA(At, 0, 1); PG8_STAGE_A(PG8_SA(0, 0), last, 0, k2);
            PG8_BAR; PG8_WAIT_L(0); PG8_MMA(1, 0, At, B0); PG8_BAR; PG8_SCHED;
            PG8_STAGE(PG8_SB(0, 1), b2 + hstep, voffB);
            PG8_WAIT_V(6); PG8_BAR; PG8_MMA(1, 1, At, B1); PG8_BAR;
            PG8_LDB(B0, 1, 0); PG8_SCHED; PG8_LDA(At, 1, 0); PG8_STAGE_A(PG8_SA(0, 1), last, 1, k2);
            PG8_WAIT_L(8); PG8_BAR; PG8_WAIT_L(0); PG8_MMA(0, 0, At, B0); PG8_BAR; PG8_SCHED;
            PG8_LDB(B1, 1, 1); PG8_STAGE(PG8_SB(1, 0), b3, voffB);
            PG8_BAR; PG8_WAIT_L(0); PG8_MMA(0, 1, At, B1); PG8_BAR;
            PG8_LDA(At, 1, 1); PG8_STAGE_A(PG8_SA(1, 0), last, 0, k2 + kstep);
            PG8_BAR; PG8_WAIT_L(0); PG8_MMA(1, 0, At, B0); PG8_BAR; PG8_SCHED;
            PG8_STAGE(PG8_SB(1, 1), b3 + hstep, voffB);
            PG8_WAIT_V(6); PG8_BAR; PG8_MMA(1, 1, At, B1); PG8_BAR;
        }
        PG8_STAMP();
        if constexpr (!Epi::AFTER_DRAIN) { E(acc, cur, wr, wc, fr, fq); S.done(cur); }
        PG8_STAMP();
        if (!has_next) break;
#pragma unroll
        for (int a = 0; a < 2; ++a)
#pragma unroll
            for (int b = 0; b < 2; ++b)
#pragma unroll
                for (int m = 0; m < 4; ++m)
#pragma unroll
                    for (int n = 0; n < 2; ++n) acc[a][b][m][n] = (f32x4){0.f, 0.f, 0.f, 0.f};
        cur = nxt; cA = nA; cB = nB; ++ui;
        if constexpr (GATHER) { _Pragma("unroll") for (int _h = 0; _h < 2; ++_h) _Pragma("unroll") for (int _i = 0; _i < 2; ++_i) vAc[_h][_i] = vAn[_h][_i]; }
    }
    PG8_WAIT_V(0);
    if (wr == 0) PG8_BAR;
    PG8_BAR;
    if constexpr (Epi::AFTER_DRAIN) { E.fused(acc, cur, wr, wc, fr, fq, lds, wid, lane); S.done(cur); }
    PG8_STAMP();
    if (STAMP && wid == 0) { stamps[lane] = lane < nts ? (((unsigned long long)(unsigned)ts_hi << 32) | (unsigned)ts_lo) : 0ull;
        if (lane == 62) stamps[62] = rt_entry; if (lane == 63) stamps[63] = (unsigned long long)wall_clock64(); }
#undef PG8_STAMP
#undef PG8_SA
#undef PG8_SB
#undef PG8_STAGE
#undef PG8_GOFF
#undef PG8_STAGE_A
#undef PG8_LDA
#undef PG8_LDB
#undef PG8_MMA
#undef PG8_WAIT_V
#undef PG8_WAIT_L
#undef PG8_BAR
#undef PG8_SCHED
}
}
#define XB_TMO      128
#define XB_XCNT(j)  (256  + 64 * (j))
#define XB_XSUB(j)  (1280 + 64 * (j))
#define XB_XGEN(j)  (2304 + 64 * (j))
#define XB_TOP      3328
#define XB_TOPGEN   3392
#define XCD_BAR_WORDS 3456
#define XB_SPIN_CAP (1u << 18)
#define LAS __attribute__((address_space(3)))

__device__ __forceinline__ unsigned xb_ld(unsigned* p)              { return __hip_atomic_load(p, __ATOMIC_RELAXED, __HIP_MEMORY_SCOPE_AGENT); }
__device__ __forceinline__ unsigned xb_add(unsigned* p, unsigned v) { return __hip_atomic_fetch_add(p, v, __ATOMIC_RELAXED, __HIP_MEMORY_SCOPE_AGENT); }
__device__ __forceinline__ unsigned xb_xcc_id() { return (unsigned)__builtin_amdgcn_s_getreg((3 << 11) | 20) & 0xFu; }
#define XB_SPIN(cond, bar) do { unsigned _sp = 0; while (cond) { __builtin_amdgcn_s_sleep(1); \
    if ((++_sp & 255u) == 0u) { if (xb_ld(&(bar)[XB_TMO])) break; if (_sp > XB_SPIN_CAP) { atomicAdd(&(bar)[XB_TMO], 1u); break; } } } } while (0)

struct XcdBarrier {
    unsigned* bar; unsigned x;
    volatile LAS unsigned* st;
};

__device__ __forceinline__ XcdBarrier xcd_barrier_post(unsigned* bar, volatile LAS unsigned* st) {
    XcdBarrier b; b.bar = bar; b.x = xb_xcc_id(); b.st = st;
    if (threadIdx.x == 0) (void)xb_add(&bar[XB_XCNT(b.x)], 1u);
    return b;
}
__device__ __forceinline__ void xcd_barrier_complete(unsigned* bar, unsigned x, unsigned& nloc, unsigned& nx) {
    const unsigned G = gridDim.x * gridDim.y * gridDim.z;
    unsigned sum, cnt, mine, sp = 0u;
    for (;;) {
        sum = 0u; cnt = 0u; mine = 0u;
#pragma unroll
        for (unsigned j = 0; j < 16; ++j) { const unsigned c = xb_ld(&bar[XB_XCNT(j)]); sum += c; cnt += (c > 0u) ? 1u : 0u; mine = (j == x) ? c : mine; }
        if (sum == G) break;
        __builtin_amdgcn_s_sleep(1);
        if ((++sp & 255u) == 0u) { if (xb_ld(&bar[XB_TMO])) break; if (sp > XB_SPIN_CAP) { atomicAdd(&bar[XB_TMO], 1u); break; } }
    }
    nloc = mine > 0u ? mine : 1u; nx = cnt > 0u ? cnt : 1u;
}

__device__ __forceinline__ void xcd_barrier(const XcdBarrier& b) {
    asm volatile("s_waitcnt vmcnt(0)" ::: "memory");
    __syncthreads();
    if (threadIdx.x == 0) {
        unsigned* bar = b.bar;
        __builtin_amdgcn_s_waitcnt(0);
        unsigned nloc = b.st[0], nx = b.st[1];
        if (nloc == 0u) { xcd_barrier_complete(bar, b.x, nloc, nx); b.st[0] = nloc; b.st[1] = nx; }
        const unsigned old = xb_add(&bar[XB_XSUB(b.x)], 1u);
        const unsigned gen = old / nloc;
        if (old + 1u == (gen + 1u) * nloc) {
            __builtin_amdgcn_fence(__ATOMIC_RELEASE, "agent");
            asm volatile("s_waitcnt vmcnt(0)" ::: "memory");
            const unsigned og = xb_add(&bar[XB_TOP], 1u);
            const unsigned tg = og / nx;
            if (og + 1u == (tg + 1u) * nx) xb_add(&bar[XB_TOPGEN], 1u);
            else XB_SPIN(xb_ld(&bar[XB_TOPGEN]) == tg, bar);
            __builtin_amdgcn_fence(__ATOMIC_ACQUIRE, "agent");
            xb_add(&bar[XB_XGEN(b.x)], 1u);
            asm volatile("s_waitcnt vmcnt(0)" ::: "memory");
        } else {
            XB_SPIN(xb_ld(&bar[XB_XGEN(b.x)]) == gen, bar);
            __builtin_amdgcn_fence(__ATOMIC_ACQUIRE, "agent");
            asm volatile("s_waitcnt vmcnt(0)" ::: "memory");
        }
    }
    __syncthreads();
}


#define GAS __attribute__((address_space(1)))
typedef unsigned short bf16;
typedef short bf16x8 __attribute__((ext_vector_type(8)));
typedef float f32x4 __attribute__((ext_vector_type(4)));
typedef unsigned u32x4 __attribute__((ext_vector_type(4)));
typedef unsigned u32x2 __attribute__((ext_vector_type(2)));

constexpr int D = 1024, NB = 4, SEQ = 4096, CTXL = 256, DEPTH = 4;
constexpr int NLAT = NB * SEQ, NCTX = NB * CTXL, NTOK = NLAT + NCTX;
constexpr int DIN = 3632, DINP = 3840;
constexpr int C_GLA_Q = 0, C_GLA_K = 128, C_GLA_V = 256, C_GLA_A = 512, C_GLA_G = 544;
constexpr int C_NA_Q = 800, C_NA_K = 1056, C_NA_V = 1312;
constexpr int C_GDN_Q = 1568, C_GDN_K = 2080, C_GDN_V = 2592, C_GDN_B = 3104, C_GDN_A = 3112, C_GDN_Z = 3120;
constexpr int NE = 32, TOPK = 4, MAXRB = 304;
constexpr float DN_ALPHA = 1.681792830507429f;
constexpr float LN_EPS = 1e-5f, RMS_EPS = 1e-6f;
constexpr int NWAVES = 8, NTHR = 512;

enum { IX = 0, IC, ICTX, ICCTX, IWADA, IBADA, IWIN, IGLAW, IGLAB, IGLAN, IRPB, ICONV, IALOG, IDTB, IGDNN, IWOUT, ILN1G, ILN1B, IWR, IBR, IWGU, IBGU, IWD, IBD, ILN2G, ILN2B, NIN };

constexpr size_t MiB = 1u << 20;
constexpr size_t WS_CTL = 0, CTL_BYTES = 1 * MiB;
constexpr size_t WS_MODS = 1 * MiB;
constexpr size_t WS_WIN = 2 * MiB;
constexpr size_t WS_WOUT = 32 * MiB;
constexpr size_t WS_WGU = 40 * MiB;
constexpr size_t WS_WD = 552 * MiB;
constexpr size_t WS_X = 808 * MiB;
constexpr size_t WS_H = 876 * MiB;
constexpr size_t WS_COLS = 910 * MiB;
constexpr size_t WS_GATES = 1032 * MiB;
constexpr size_t WS_GQ = 1036 * MiB, WS_GK = 1053 * MiB, WS_GV = 1070 * MiB;
constexpr size_t WS_GG = 1087 * MiB, WS_GB = 1088 * MiB;
constexpr size_t WS_MIX = 1089 * MiB;
constexpr size_t WS_SD = 1123 * MiB;
constexpr size_t WS_SA = 1157 * MiB;
constexpr size_t WS_GU = 1158 * MiB, WS_GW = 1192 * MiB;
constexpr size_t WS_GKT = 1226 * MiB;
constexpr size_t WS_GQKM = 1294 * MiB;
constexpr size_t WS_GCB = 1311 * MiB;
constexpr size_t WS_OG = 1313 * MiB;
constexpr size_t WS_TOKE = 1381 * MiB, WS_TOKP = 1382 * MiB, WS_TOKG = 1383 * MiB, WS_TOKS = 1384 * MiB;
constexpr size_t WS_LG = 1385 * MiB;
constexpr size_t WS_TG = 1419 * MiB;
constexpr size_t WS_XB = 1436 * MiB;
constexpr size_t WS_ACT = 1588 * MiB;
constexpr size_t WS_YB = 1740 * MiB;
constexpr size_t WS_SS = 1892 * MiB;
constexpr size_t WS_OI = 1926 * MiB;
constexpr size_t WS_QTG = 1944 * MiB;
constexpr size_t WS_ROPE = 1953 * MiB;
constexpr size_t WS_WRT = 1953 * MiB + 65536;
constexpr size_t WS_ETOK = 1954 * MiB;
constexpr size_t WS_WRH = 1993 * MiB, WS_WRL = 1993 * MiB + 262144;
constexpr size_t WS_HL = 1959 * MiB;
constexpr size_t WS_DUMMY = 1957 * MiB;
constexpr size_t WS_END = 1994 * MiB;
constexpr int CW_BAR = 4096;
constexpr int CW_NAQ = 20480;
constexpr int CW_PQ = 24576;
constexpr int CW_CQ = 28672;
constexpr int CW_CNT = 16384;

constexpr int LDS_BYTES = 147456;
constexpr int MISC_OFF = 143360;

struct Args { const float* in[NIN]; float* out; unsigned char* ws; int l_lo, l_hi, ph_lo, ph_hi; };
struct Ctx { const Args* a; int z;
    __device__ __forceinline__ const float* in(int i) const { return a->in[i + z]; }
    __device__ __forceinline__ unsigned char* ws() const { return a->ws + z; }
    __device__ __forceinline__ float* out() const { return a->out + z; } };

__device__ __forceinline__ float bf2f(unsigned u) { return __uint_as_float(u << 16); }
typedef __bf16 bf16x2_t __attribute__((ext_vector_type(2)));
typedef float f32x2_t __attribute__((ext_vector_type(2)));
__device__ __forceinline__ unsigned f2bf(float f) { return (unsigned)__builtin_bit_cast(unsigned short, (__bf16)f); }
__device__ __forceinline__ unsigned pk2(float lo, float hi) { const f32x2_t f = {lo, hi}; return __builtin_bit_cast(unsigned, __builtin_convertvector(f, bf16x2_t)); }
template <int CTRL> __device__ __forceinline__ float dppf(float v) { return __int_as_float(__builtin_amdgcn_update_dpp(0, __float_as_int(v), CTRL, 0xF, 0xF, true)); }
__device__ __forceinline__ float row16_sum(float v) { v += dppf<0xB1>(v); v += dppf<0x4E>(v); v += dppf<0x141>(v); v += dppf<0x140>(v); return v; }
__device__ __forceinline__ float row16_max(float v) { v = fmaxf(v, dppf<0xB1>(v)); v = fmaxf(v, dppf<0x4E>(v)); v = fmaxf(v, dppf<0x141>(v)); v = fmaxf(v, dppf<0x140>(v)); return v; }
__device__ __forceinline__ float rows_sum(float v) { return __int_as_float(__builtin_amdgcn_readlane(__float_as_int(v), 0)) + __int_as_float(__builtin_amdgcn_readlane(__float_as_int(v), 16))
                                                          + __int_as_float(__builtin_amdgcn_readlane(__float_as_int(v), 32)) + __int_as_float(__builtin_amdgcn_readlane(__float_as_int(v), 48)); }
__device__ __forceinline__ float wsum(float v) { return rows_sum(row16_sum(v)); }
__device__ __forceinline__ float wmax(float v) { v = row16_max(v); return fmaxf(fmaxf(__int_as_float(__builtin_amdgcn_readlane(__float_as_int(v), 0)), __int_as_float(__builtin_amdgcn_readlane(__float_as_int(v), 16))),
                                                                                   fmaxf(__int_as_float(__builtin_amdgcn_readlane(__float_as_int(v), 32)), __int_as_float(__builtin_amdgcn_readlane(__float_as_int(v), 48)))); }
__device__ __forceinline__ float sigmoidf_(float x) { return __builtin_amdgcn_rcpf(1.f + __expf(-x)); }
__device__ __forceinline__ float siluf_(float x) { return x * __builtin_amdgcn_rcpf(1.f + __expf(-x)); }
__device__ __forceinline__ float softplusf_(float x) { return fmaxf(x, 0.f) + log1pf(__expf(-fabsf(x))); }
__device__ __forceinline__ float logsigmoidf_(float x) { return fminf(x, 0.f) - log1pf(__expf(-fabsf(x))); }
#define WAVE_SYNC() do { asm volatile("s_waitcnt lgkmcnt(0)" ::: "memory"); __builtin_amdgcn_wave_barrier(); } while (0)
#define BLOCK_SYNC() do { __threadfence_block(); __syncthreads(); } while (0)
#define LBAR() do { asm volatile("s_waitcnt lgkmcnt(0)" ::: "memory"); __builtin_amdgcn_s_barrier(); asm volatile("" ::: "memory"); } while (0)

__device__ __forceinline__ bf16x8 lds_frag(const LAS bf16* base, int stride, int row0, int k0, int lane) {
    return *(const LAS bf16x8*)(base + (row0 + (lane & 15)) * stride + k0 + 8 * (lane >> 4));
}
__device__ __forceinline__ f32x4 mma(bf16x8 a, bf16x8 b, f32x4 c) { return __builtin_amdgcn_mfma_f32_16x16x32_bf16(a, b, c, 0, 0, 0); }

__device__ __forceinline__ int mod_row(int m) { return m < NLAT ? (m >> 12) : 4; }

__device__ __forceinline__ void row_ln(f32x4 (&v)[4]) {
    float s = 0.f;
#pragma unroll
    for (int j = 0; j < 4; ++j) s += (v[j].x + v[j].y) + (v[j].z + v[j].w);
    const float mean = wsum(s) * (1.f / D);
    float s2 = 0.f;
#pragma unroll
    for (int j = 0; j < 4; ++j) { v[j] = v[j] - mean; s2 += (v[j].x * v[j].x + v[j].y * v[j].y) + (v[j].z * v[j].z + v[j].w * v[j].w); }
    const float rstd = rsqrtf(wsum(s2) * (1.f / D) + LN_EPS);
#pragma unroll
    for (int j = 0; j < 4; ++j) v[j] = v[j] * rstd;
}
__device__ __forceinline__ void row_store_bf16(bf16* row, const f32x4 (&v)[4], int lane) {
    u32x2* o = (u32x2*)row + lane;
#pragma unroll
    for (int j = 0; j < 4; ++j) { u32x2 w; w.x = pk2(v[j].x, v[j].y); w.y = pk2(v[j].z, v[j].w); o[64 * j] = w; }
}

__device__ __forceinline__ void ph_mods(const Ctx& A, LAS unsigned char* lds, int tid, int G) {
    LAS float* sc = (LAS float*)lds;
    LAS float* red = (LAS float*)(lds + 20480);
    const float* c = A.in(IC); const float* cc = A.in(ICCTX);
    for (int i = tid; i < 5 * D; i += NTHR) { const int r = i >> 10, k = i & 1023; const float v = r < 4 ? c[r * D + k] : cc[k]; sc[i] = siluf_(v); }
    __syncthreads();
    float* mods = (float*)(A.ws() + WS_MODS);
    if (blockIdx.x == 0) { float* rope = (float*)(A.ws() + WS_ROPE); const int pos = tid >> 3, j = tid & 7; float sn, cs;
        sincosf((float)pos * expf(-(float)j * 1.1512925464970229f), &sn, &cs); rope[tid * 2] = cs; rope[tid * 2 + 1] = sn; }
    { bf16* wrh = (bf16*)(A.ws() + WS_WRH); bf16* wrl = (bf16*)(A.ws() + WS_WRL);
      for (int i = blockIdx.x * NTHR + tid; i < DEPTH * D * NE; i += G * NTHR) { const int ll = i >> 15, e = (i >> 10) & 31, k = i & 1023; const float w = A.in(IWR)[((size_t)ll * D + k) * NE + e];
          const unsigned hi = f2bf(w); wrh[i] = (bf16)hi; wrl[i] = (bf16)f2bf(w - bf2f(hi)); } }
    const int col = tid & 63, kg = tid >> 6;
    for (int item = blockIdx.x; item < DEPTH * 96; item += G) {
        const int l = item / 96, n0 = (item % 96) * 64;
        const float* w = A.in(IWADA) + ((size_t)l * D + kg * 128) * 6144 + n0 + col;
        float a0 = 0.f, a1 = 0.f, a2 = 0.f, a3 = 0.f, a4 = 0.f;
#pragma unroll 32
        for (int k = 0; k < 128; ++k) { const float wv = __builtin_nontemporal_load(w + (size_t)k * 6144); const int kk = kg * 128 + k;
            a0 += sc[kk] * wv; a1 += sc[D + kk] * wv; a2 += sc[2 * D + kk] * wv; a3 += sc[3 * D + kk] * wv; a4 += sc[4 * D + kk] * wv; }
        red[(kg * 5 + 0) * 64 + col] = a0; red[(kg * 5 + 1) * 64 + col] = a1; red[(kg * 5 + 2) * 64 + col] = a2; red[(kg * 5 + 3) * 64 + col] = a3; red[(kg * 5 + 4) * 64 + col] = a4;
        __syncthreads();
        if (tid < 320) { const int r = tid >> 6, cl = tid & 63; float s = 0.f;
#pragma unroll
            for (int g = 0; g < 8; ++g) s += red[(g * 5 + r) * 64 + cl];
            mods[((size_t)l * 5 + r) * 6144 + n0 + cl] = s + A.in(IBADA)[l * 6144 + n0 + cl]; }
        __syncthreads();
    }
}

constexpr int CV_IN = 16 * 60, CV_OUT = 16 * 16, CV_GU = NE * 16 * 32, CV_D = NE * 16 * 16, CV_ITEMS = CV_IN + CV_OUT + CV_GU + CV_D, CV_TICKETS = CV_ITEMS / 8;
struct CvtJob { const float* wp; bf16* dst; int N; bool ok; };
__device__ __forceinline__ CvtJob cvt_decode(const Ctx& A, int l, int r, int lane) {
    const float* W; int N, k0, src0; bf16* dst;
    if (r < CV_IN) { const int nb = r % 60, kb = r / 60; W = A.in(IWIN) + (size_t)l * D * DIN; N = DIN; k0 = kb * 64; src0 = nb * 64; dst = (bf16*)(A.ws() + WS_WIN) + ((size_t)l * DINP + nb * 64) * D; }
    else if (r < CV_IN + CV_OUT) { r -= CV_IN; const int nb = r % 16, kb = r / 16; W = A.in(IWOUT) + (size_t)l * D * D; N = D; k0 = kb * 64; src0 = nb * 64; dst = (bf16*)(A.ws() + WS_WOUT) + ((size_t)l * D + nb * 64) * D; }
    else if (r < CV_IN + CV_OUT + CV_GU) { r -= CV_IN + CV_OUT; const int nb = r % 32, kb = (r / 32) % 16, le = l * NE + r / 512; const int j = nb >> 2, q = nb & 3;
        W = A.in(IWGU) + (size_t)le * D * 2048; N = 2048; k0 = kb * 64; src0 = (q < 2) ? (128 * j + 64 * q) : (1024 + 128 * j + 64 * (q - 2)); dst = (bf16*)(A.ws() + WS_WGU) + ((size_t)le * 2048 + nb * 64) * D; }
    else { r -= CV_IN + CV_OUT + CV_GU; const int nb = r % 16, kb = (r / 16) % 16, le = l * NE + r / 256; W = A.in(IWD) + (size_t)le * D * D; N = D; k0 = kb * 64; src0 = nb * 64; dst = (bf16*)(A.ws() + WS_WD) + ((size_t)le * D + nb * 64) * D; }
    CvtJob j; j.ok = (src0 + lane) < N; j.N = N; j.dst = dst + k0;
    j.wp = W + (size_t)k0 * N + (j.ok ? src0 + lane : 0);
    return j;
}
__device__ __forceinline__ void cvt_drain(const Ctx& A, LAS unsigned char* lds, int l, int t0, int nt, unsigned* ctr, int tid, int lane, int wave) {
    LAS int* wq = (LAS int*)(lds + MISC_OFF + 512); LAS float* scr = (LAS float*)(lds + wave * 16640);
    __syncthreads(); if (tid == 0) { const int f = (int)atomicAdd(ctr, 2u); wq[0] = f; wq[1] = f + 1; } __syncthreads();
    int cur = __builtin_amdgcn_readfirstlane(wq[0]), nxt = __builtin_amdgcn_readfirstlane(wq[1]);
    int zv = 0; asm volatile("" : "+v"(zv)); unsigned* ctrv = ctr + zv;
    float v[64]; CvtJob jc = cvt_decode(A, l, (t0 + min(cur, nt - 1)) * 8 + wave, lane);
    if (cur < nt) {
#pragma unroll
        for (int kk = 0; kk < 64; ++kk) v[kk] = __builtin_nontemporal_load(jc.wp + (size_t)kk * jc.N); }
    while (cur < nt) {
        int nn = 0; if (tid == 0) nn = (int)atomicAdd(ctrv, 1u);
#pragma unroll
        for (int kk = 0; kk < 64; ++kk) scr[kk * 65 + lane] = jc.ok ? v[kk] : 0.f;
        bf16* dst = jc.dst;
        if (nxt < nt) { jc = cvt_decode(A, l, (t0 + nxt) * 8 + wave, lane);
#pragma unroll
            for (int kk = 0; kk < 64; ++kk) v[kk] = __builtin_nontemporal_load(jc.wp + (size_t)kk * jc.N); }
        WAVE_SYNC();
        const int c = lane & 7;
#pragma unroll
        for (int j = 0; j < 8; ++j) { const int n = (lane >> 3) + 8 * j; const LAS float* sp = scr + (8 * c) * 65 + n;
            u32x4 o; o.x = pk2(sp[0], sp[65]); o.y = pk2(sp[2 * 65], sp[3 * 65]); o.z = pk2(sp[4 * 65], sp[5 * 65]); o.w = pk2(sp[6 * 65], sp[7 * 65]);
            __builtin_nontemporal_store(o, (u32x4*)(dst + (size_t)n * D + 8 * c)); }
        WAVE_SYNC();
        LBAR(); if (tid == 0) wq[0] = nn; LBAR();
        cur = nxt; nxt = __builtin_amdgcn_readfirstlane(wq[0]);
    }
    __syncthreads();
}

__device__ __forceinline__ void ph_init(const Ctx& A, int lane, int wave, int G) {
    const int gw = blockIdx.x * NWAVES + wave, NGW = G * NWAVES;
    float* X = (float*)(A.ws() + WS_X); bf16* H = (bf16*)(A.ws() + WS_H); const float* mods = (const float*)(A.ws() + WS_MODS);
    for (int m = gw; m < NTOK; m += NGW) {
        const float* src = m < NLAT ? A.in(IX) + (size_t)m * D : A.in(ICTX) + (size_t)(m - NLAT) * D;
        const f32x4* xr = (const f32x4*)src + lane; f32x4* xo = (f32x4*)(X + (size_t)m * D) + lane;
        f32x4 v[4];
#pragma unroll
        for (int j = 0; j < 4; ++j) { v[j] = xr[64 * j]; xo[64 * j] = v[j]; }
        row_ln(v);
        const float* md = mods + (size_t)(0 * 5 + mod_row(m)) * 6144;
#pragma unroll
        for (int j = 0; j < 4; ++j) { const f32x4 sh = ((const f32x4*)md)[lane + 64 * j], scl = ((const f32x4*)(md + D))[lane + 64 * j]; v[j] = v[j] * (scl + 1.f) + sh; }
        row_store_bf16(H + (size_t)m * D, v, lane);
    }
}

struct EpiCols {
    static constexpr bool PERM = true, AFTER_DRAIN = false;
    bf16* C; float* gates;
    __device__ __forceinline__ void operator()(const f32x4 (&acc)[2][2][4][2], const pg8::Unit& u, int wr, int wc, int fr, int fq) const {
        const int row0 = u.pm * 256 + wr * 64 + fr, colb = u.pn * 256 + wc * 32 + 8 * fq;
#pragma unroll
        for (int ai = 0; ai < 2; ++ai)
#pragma unroll
            for (int m = 0; m < 4; ++m) { const int row = row0 + ai * 128 + m * 16;
#pragma unroll
                for (int bj = 0; bj < 2; ++bj) { const int col = colb + bj * 128; const f32x4 v0 = acc[ai][bj][m][0], v1 = acc[ai][bj][m][1];
                    if (col < DIN) { u32x4 w; w.x = pk2(v0[0], v0[1]); w.y = pk2(v0[2], v0[3]); w.z = pk2(v1[0], v1[1]); w.w = pk2(v1[2], v1[3]);
                        *(u32x4*)(C + (size_t)row * DIN + col) = w; }
                    int gc = -1;
                    if (col >= C_GLA_A && col < C_GLA_A + 32) gc = col - C_GLA_A; else if (col >= C_GDN_B && col < C_GDN_B + 16) gc = 32 + col - C_GDN_B;
                    if (gc >= 0) { float* gp = gates + (size_t)row * 48 + gc; *(f32x4*)gp = v0; *(f32x4*)(gp + 4) = v1; } } }
    }
};
struct EpiOut {
    static constexpr bool PERM = false, AFTER_DRAIN = false;
    float* X; const float* mods;
    __device__ __forceinline__ void operator()(const f32x4 (&acc)[2][2][4][2], const pg8::Unit& u, int wr, int wc, int fr, int fq) const {
        const int row0 = u.pm * 256 + wr * 64 + fr, col0 = u.pn * 256 + wc * 32 + 4 * fq;
#pragma unroll
        for (int ai = 0; ai < 2; ++ai)
#pragma unroll
            for (int m = 0; m < 4; ++m) { const int row = row0 + ai * 128 + m * 16; float* xr = X + (size_t)row * D + col0; const float* g = mods + (size_t)mod_row(row) * 6144 + 2 * D + col0;
#pragma unroll
                for (int bj = 0; bj < 2; ++bj)
#pragma unroll
                    for (int n = 0; n < 2; ++n) { const int o = bj * 128 + n * 16; const f32x4 xv = *(const f32x4*)(xr + o), gv = *(const f32x4*)(g + o);
                        *(f32x4*)(xr + o) = xv * DN_ALPHA + gv * acc[ai][bj][m][n]; } }
    }
};
__device__ __forceinline__ f32x4 act4(const f32x4 g, const f32x4 u) {
    const f32x4 lim = {7.f, 7.f, 7.f, 7.f};
    const f32x4 gt = __builtin_elementwise_min(g, lim), up = __builtin_elementwise_min(__builtin_elementwise_max(u, -lim), lim);
    const f32x4 t = gt * (-1.702f * 1.4426950408889634f);
    const f32x4 d = (f32x4){__builtin_amdgcn_exp2f(t[0]), __builtin_amdgcn_exp2f(t[1]), __builtin_amdgcn_exp2f(t[2]), __builtin_amdgcn_exp2f(t[3])} + 1.f;
    const f32x4 r = {__builtin_amdgcn_rcpf(d[0]), __builtin_amdgcn_rcpf(d[1]), __builtin_amdgcn_rcpf(d[2]), __builtin_amdgcn_rcpf(d[3])};
    return (up * gt + gt) * r;
}
struct EpiAct {
    static constexpr bool PERM = true, AFTER_DRAIN = false;
    bf16* O; const float* bias;
    __device__ __forceinline__ void operator()(const f32x4 (&acc)[2][2][4][2], const pg8::Unit& u, int wr, int wc, int fr, int fq) const {
        const int e = u.pn >> 3, j = u.pn & 7;
        const int row0 = u.pm * 256 + wr * 64 + fr, col = j * 128 + wc * 32 + 8 * fq;
        const float* bg = bias + (size_t)e * 2048 + col; const float* bu = bg + 1024;
        const f32x4 bg0 = *(const f32x4*)bg, bg1 = *(const f32x4*)(bg + 4), bu0 = *(const f32x4*)bu, bu1 = *(const f32x4*)(bu + 4);
#pragma unroll
        for (int ai = 0; ai < 2; ++ai)
#pragma unroll
            for (int m = 0; m < 4; ++m) { const int row = row0 + ai * 128 + m * 16;
                const f32x4 a0 = act4(acc[ai][0][m][0] + bg0, acc[ai][1][m][0] + bu0), a1 = act4(acc[ai][0][m][1] + bg1, acc[ai][1][m][1] + bu1);
                u32x4 w; w.x = pk2(a0[0], a0[1]); w.y = pk2(a0[2], a0[3]); w.z = pk2(a1[0], a1[1]); w.w = pk2(a1[2], a1[3]);
                *(u32x4*)(O + (size_t)row * D + col) = w; }
    }
};
struct EpiY {
    static constexpr bool PERM = true, AFTER_DRAIN = false;
    bf16* O; const float* bias;
    __device__ __forceinline__ void operator()(const f32x4 (&acc)[2][2][4][2], const pg8::Unit& u, int wr, int wc, int fr, int fq) const {
        const int e = u.pn >> 2, j = u.pn & 3;
        const int row0 = u.pm * 256 + wr * 64 + fr, colb = j * 256 + wc * 32 + 8 * fq;
#pragma unroll
        for (int bj = 0; bj < 2; ++bj) { const int col = colb + bj * 128; const float* b = bias + (size_t)e * D + col; const f32x4 b0 = *(const f32x4*)b, b1 = *(const f32x4*)(b + 4);
#pragma unroll
            for (int ai = 0; ai < 2; ++ai)
#pragma unroll
                for (int m = 0; m < 4; ++m) { const int row = row0 + ai * 128 + m * 16; const f32x4 v0 = acc[ai][bj][m][0] + b0, v1 = acc[ai][bj][m][1] + b1;
                    u32x4 w; w.x = pk2(v0[0], v0[1]); w.y = pk2(v0[2], v0[3]); w.z = pk2(v1[0], v1[1]); w.w = pk2(v1[2], v1[3]);
                    *(u32x4*)(O + (size_t)row * D + col) = w; } }
    }
};
struct MoeOrder {
    const LAS int* blk_e; int n_units, NT, G, c; const LAS int* tab; const int* etok;
    __device__ __forceinline__ bool next(int i, pg8::Unit& u) const {
        const int L = i * G + c; if (L >= n_units) return false;
        const int rb = L / NT, j = L - rb * NT; u.pm = rb; u.pn = __builtin_amdgcn_readfirstlane(blk_e[rb]) * NT + j; return true;
    }
    __device__ __forceinline__ int a_row(const pg8::Unit& u, int r) const {
        const int e = __builtin_amdgcn_readfirstlane(blk_e[u.pm]), base = u.pm * 256 - __builtin_amdgcn_readfirstlane(tab[e]), cnt = __builtin_amdgcn_readfirstlane(tab[400 + e]);
        const int idx = base + r; return idx < cnt ? etok[(size_t)e * NTOK + idx] : 0; }
    __device__ __forceinline__ void a_ready(const pg8::Unit&) const {}
    __device__ __forceinline__ void done(const pg8::Unit&) const {}
};
__device__ __forceinline__ void moe_tables(const unsigned* cnt, LAS int* tab, int tid) {
    if (tid < 64) {
        const int c = tid < NE ? (int)__hip_atomic_load(cnt + tid, __ATOMIC_RELAXED, __HIP_MEMORY_SCOPE_AGENT) : 0; const int nb = (c + 255) >> 8; int incl = nb;
#pragma unroll
        for (int o = 1; o < 32; o <<= 1) { const int t = __shfl_up(incl, o); if ((tid & 63) >= o) incl += t; }
        const int excl = incl - nb;
        if (tid < NE) { tab[tid] = excl * 256; tab[400 + tid] = c; for (int q = 0; q < nb; ++q) tab[64 + excl + q] = tid; }
        if (tid == NE - 1) { tab[32] = incl * 256; tab[40] = incl; } }
    __syncthreads();
}

__device__ __forceinline__ void wsum2(float& a, float& b) { a = wsum(a); b = wsum(b); }
__device__ __forceinline__ void row_ln1p(f32x4 (&v)[4]) {
    float s = 0.f, s2 = 0.f;
#pragma unroll
    for (int j = 0; j < 4; ++j) { s += (v[j].x + v[j].y) + (v[j].z + v[j].w); s2 += (v[j].x * v[j].x + v[j].y * v[j].y) + (v[j].z * v[j].z + v[j].w * v[j].w); }
    wsum2(s, s2);
    const float mean = s * (1.f / D), rstd = rsqrtf(fmaxf(s2 * (1.f / D) - mean * mean, 0.f) + LN_EPS);
#pragma unroll
    for (int j = 0; j < 4; ++j) v[j] = (v[j] - mean) * rstd;
}
__device__ __forceinline__ void ph_ln1_route(const Ctx& A, int l, LAS unsigned char* lds, int tid, int lane, int wave, int nrows_total) {
    LAS bf16* WH = (LAS bf16*)lds; LAS bf16* WL = (LAS bf16*)(lds + 66048); LAS float* LGT = (LAS float*)(lds + 132096); LAS int* msc = (LAS int*)(lds + MISC_OFF + 1024);
    { const u32x4* srch = (const u32x4*)((const bf16*)(A.ws() + WS_WRH) + (size_t)l * D * NE); const u32x4* srcl = (const u32x4*)((const bf16*)(A.ws() + WS_WRL) + (size_t)l * D * NE);
      for (int i = tid; i < D * NE / 8; i += NTHR) { const int e = i >> 7, part = i & 127; *(LAS u32x4*)(WH + e * 1032 + part * 8) = srch[i]; *(LAS u32x4*)(WL + e * 1032 + part * 8) = srcl[i]; } }
    if (tid < 64) msc[tid] = 0;
    const int RPB = nrows_total / (int)gridDim.x;
    const int rbase = blockIdx.x * RPB;
    float* X = (float*)(A.ws() + WS_X); bf16* H = (bf16*)(A.ws() + WS_H); bf16* HL = (bf16*)(A.ws() + WS_HL); const float* mods = (const float*)(A.ws() + WS_MODS) + (size_t)l * 5 * 6144;
    const float* g1 = A.in(ILN1G) + l * D; const float* b1 = A.in(ILN1B) + l * D;
    f32x4 nv[4], nw[4];
    { const f32x4* xr = (const f32x4*)(X + (size_t)(rbase + wave) * D) + lane; const f32x4* xs = (const f32x4*)(X + (size_t)(rbase + min(wave + NWAVES, RPB - 1)) * D) + lane;
#pragma unroll
      for (int j = 0; j < 4; ++j) { nv[j] = xr[64 * j]; nw[j] = xs[64 * j]; } }
    for (int rl = wave; rl < RPB; rl += NWAVES) {
        const int m = rbase + rl;
        f32x4 v[4];
#pragma unroll
        for (int j = 0; j < 4; ++j) { v[j] = nv[j]; nv[j] = nw[j]; }
        if (rl + 2 * NWAVES < RPB) { const f32x4* xn = (const f32x4*)(X + (size_t)(m + 2 * NWAVES) * D) + lane;
#pragma unroll
            for (int j = 0; j < 4; ++j) nw[j] = xn[64 * j]; }
        row_ln1p(v);
#pragma unroll
        for (int j = 0; j < 4; ++j) v[j] = v[j] * ((const f32x4*)g1)[lane + 64 * j] + ((const f32x4*)b1)[lane + 64 * j];
        row_ln1p(v);
        const float* md = mods + (size_t)mod_row(m) * 6144;
        u32x2* oh = (u32x2*)(H + (size_t)m * D) + lane; u32x2* ol = (u32x2*)(HL + (size_t)m * D) + lane;
#pragma unroll
        for (int j = 0; j < 4; ++j) { const f32x4 sh = ((const f32x4*)(md + 3 * D))[lane + 64 * j], scl = ((const f32x4*)(md + 4 * D))[lane + 64 * j]; const f32x4 hv = v[j] * (scl + 1.f) + sh;
            u32x2 wh; wh.x = pk2(hv.x, hv.y); wh.y = pk2(hv.z, hv.w); oh[64 * j] = wh;
            u32x2 wl; wl.x = pk2(hv.x - bf2f(wh.x & 0xffffu), hv.y - bf2f(wh.x >> 16)); wl.y = pk2(hv.z - bf2f(wh.y & 0xffffu), hv.w - bf2f(wh.y >> 16)); ol[64 * j] = wl; }
    }
    BLOCK_SYNC();
    if (wave * 16 < RPB) { const int g = lane >> 4, c16 = lane & 15; const int row = rbase + min(wave * 16 + c16, RPB - 1);
        const bf16* ph = H + (size_t)row * D + 8 * g; const bf16* pl = HL + (size_t)row * D + 8 * g;
        f32x4 acc0 = {0.f, 0.f, 0.f, 0.f}, acc1 = {0.f, 0.f, 0.f, 0.f};
#pragma unroll 1
        for (int kb = 0; kb < 4; ++kb) { bf16x8 ah[8], al[8];
#pragma unroll
            for (int k8 = 0; k8 < 8; ++k8) { ah[k8] = *(const bf16x8*)(ph + 32 * (8 * kb + k8)); al[k8] = *(const bf16x8*)(pl + 32 * (8 * kb + k8)); }
#pragma unroll
            for (int k8 = 0; k8 < 8; ++k8) { const int k0 = 32 * (8 * kb + k8);
                const bf16x8 h0 = lds_frag(WH, 1032, 0, k0, lane), h1 = lds_frag(WH, 1032, 16, k0, lane), l0 = lds_frag(WL, 1032, 0, k0, lane), l1 = lds_frag(WL, 1032, 16, k0, lane);
                acc0 = mma(ah[k8], h0, acc0); acc0 = mma(ah[k8], l0, acc0); acc0 = mma(al[k8], h0, acc0);
                acc1 = mma(ah[k8], h1, acc1); acc1 = mma(ah[k8], l1, acc1); acc1 = mma(al[k8], h1, acc1); } }
        const float bi0 = A.in(IBR)[l * NE + c16], bi1 = A.in(IBR)[l * NE + 16 + c16];
#pragma unroll
        for (int r = 0; r < 4; ++r) { LGT[(wave * 16 + 4 * g + r) * 32 + c16] = acc0[r] + bi0; LGT[(wave * 16 + 4 * g + r) * 32 + 16 + c16] = acc1[r] + bi1; } }
    __syncthreads();
    if (tid < RPB) { const int rl = tid, m = rbase + rl; float lg[NE];
#pragma unroll
        for (int q = 0; q < 8; ++q) { const f32x4 t4 = *(const LAS f32x4*)(LGT + rl * 32 + 4 * q); lg[4 * q] = t4.x; lg[4 * q + 1] = t4.y; lg[4 * q + 2] = t4.z; lg[4 * q + 3] = t4.w; }
        float tv[4]; int te[4];
#pragma unroll
        for (int k = 0; k < 4; ++k) { float mx = -INFINITY; int mi = 0;
#pragma unroll
            for (int e = 0; e < NE; ++e) { const bool gt = lg[e] > mx; mx = gt ? lg[e] : mx; mi = gt ? e : mi; }
            tv[k] = mx; te[k] = mi;
#pragma unroll
            for (int e = 0; e < NE; ++e) lg[e] = (e == mi) ? -INFINITY : lg[e]; }
        const float e1 = __expf(tv[1] - tv[0]), e2 = __expf(tv[2] - tv[0]), e3 = __expf(tv[3] - tv[0]); const float inv = 1.f / (1.f + e1 + e2 + e3);
        *(f32x4*)((float*)(A.ws() + WS_TOKG) + (size_t)m * 4) = (f32x4){inv, e1 * inv, e2 * inv, e3 * inv};
#pragma unroll
        for (int k = 0; k < 4; ++k) { const int pos = atomicAdd((int*)(msc + te[k]), 1); msc[64 + rl * 4 + k] = te[k] | (pos << 8); }
    }
    __syncthreads();
    unsigned* gcnt = (unsigned*)(A.ws() + WS_CTL) + CW_CNT + l * 64;
    if (tid < NE) msc[32 + tid] = (int)atomicAdd(gcnt + tid, (unsigned)msc[tid]);
    __syncthreads();
    int* toke = (int*)(A.ws() + WS_TOKE); int* tokp = (int*)(A.ws() + WS_TOKP); int* etok = (int*)(A.ws() + WS_ETOK);
    for (int i = tid; i < RPB * 4; i += NTHR) { const int s = msc[64 + i], e = s & 255, idx = msc[32 + e] + (s >> 8);
        toke[(size_t)rbase * 4 + i] = e; tokp[(size_t)rbase * 4 + i] = idx; etok[(size_t)e * NTOK + idx] = rbase + (i >> 2); }
    __syncthreads();
}

__device__ __forceinline__ void ph_combine(const Ctx& A, int l, LAS unsigned char* lds, int tid, int lane, int wave, int G, int nrows_total) {
    LAS int* tab = (LAS int*)(lds + MISC_OFF + 1024);
    moe_tables((const unsigned*)(A.ws() + WS_CTL) + CW_CNT + l * 64, tab, tid);
    const int gw = blockIdx.x * NWAVES + wave, NGW = G * NWAVES;
    float* X = (float*)(A.ws() + WS_X); bf16* H = (bf16*)(A.ws() + WS_H); const bf16* YB = (const bf16*)(A.ws() + WS_YB);
    const float* mods = (const float*)(A.ws() + WS_MODS) + (size_t)l * 5 * 6144;
    const int* toke = (const int*)(A.ws() + WS_TOKE); const int* tokp = (const int*)(A.ws() + WS_TOKP); const float* tokg = (const float*)(A.ws() + WS_TOKG);
    const float* g2 = A.in(ILN2G) + l * D; const float* b2 = A.in(ILN2B) + l * D; const float* g1 = A.in(ILN1G) + l * D; const float* b1 = A.in(ILN1B) + l * D;
    for (int m = gw; m < nrows_total; m += NGW) {
        f32x4 f[4];
#pragma unroll
        for (int j = 0; j < 4; ++j) f[j] = (f32x4){0.f, 0.f, 0.f, 0.f};
#pragma unroll
        for (int k = 0; k < 4; ++k) { const int slot = tab[toke[m * 4 + k]] + tokp[m * 4 + k]; const float g = tokg[m * 4 + k]; const u32x2* y = (const u32x2*)(YB + (size_t)slot * D) + lane;
#pragma unroll
            for (int j = 0; j < 4; ++j) { const u32x2 w = y[64 * j]; f[j].x += g * bf2f(w.x & 0xffffu); f[j].y += g * bf2f(w.x >> 16); f[j].z += g * bf2f(w.y & 0xffffu); f[j].w += g * bf2f(w.y >> 16); } }
        f32x4* xr = (f32x4*)(X + (size_t)m * D) + lane; const float* md = mods + (size_t)mod_row(m) * 6144; f32x4 v[4];
#pragma unroll
        for (int j = 0; j < 4; ++j) v[j] = xr[64 * j];
        row_ln1p(v);
#pragma unroll
        for (int j = 0; j < 4; ++j) { const f32x4 x = v[j] * ((const f32x4*)g1)[lane + 64 * j] + ((const f32x4*)b1)[lane + 64 * j]; v[j] = x * DN_ALPHA + ((const f32x4*)(md + 5 * D))[lane + 64 * j] * f[j]; }
        row_ln(v);
#pragma unroll
        for (int j = 0; j < 4; ++j) v[j] = v[j] * ((const f32x4*)g2)[lane + 64 * j] + ((const f32x4*)b2)[lane + 64 * j];
        if (l == DEPTH - 1) { f32x4* o = (f32x4*)(A.out() + (size_t)m * D) + lane;
#pragma unroll
            for (int j = 0; j < 4; ++j) o[64 * j] = v[j];
        } else {
#pragma unroll
            for (int j = 0; j < 4; ++j) xr[64 * j] = v[j];
            row_ln(v);
            const float* mn = mods + 5 * 6144 + (size_t)mod_row(m) * 6144;
#pragma unroll
            for (int j = 0; j < 4; ++j) { const f32x4 sh = ((const f32x4*)mn)[lane + 64 * j], scl = ((const f32x4*)(mn + D))[lane + 64 * j]; v[j] = v[j] * (scl + 1.f) + sh; }
            row_store_bf16(H + (size_t)m * D, v, lane);
        }
    }
}

__device__ __forceinline__ u32x2 lds_tr16(unsigned addr) { u32x2 r; asm volatile("ds_read_b64_tr_b16 %0, %1" : "=&v"(r) : "v"(addr) : "memory"); return r; }
template <bool CTXQ>
__device__ __forceinline__ void na_unit(const Ctx& A, int l, LAS unsigned char* lds, int unit, int tid, int lane, int wave) {
    constexpr int NKT = CTXQ ? 16 : 48, NTW = NKT / 2, NKEYS = NKT * 16, KST = 72, NCH = NKEYS * 8 / NTHR;
    const bf16* cols = (const bf16*)(A.ws() + WS_COLS); bf16* MIX = (bf16*)(A.ws() + WS_MIX);
    int b, h, r = 0, r0 = 0, qbase;
    if (!CTXQ) { b = unit >> 8; h = (unit >> 6) & 3; r = unit & 63; r0 = min(max(r - 4, 0), 56); qbase = b * SEQ + r * 64; }
    else { b = unit >> 4; h = (unit >> 2) & 3; qbase = NLAT + b * CTXL + (unit & 3) * 64; }
    LAS bf16* Kimg = (LAS bf16*)lds;
    const int mt = wave & 3, kq = wave >> 2, qi = lane & 15, g = lane >> 4;
    const char* cb = (const char*)cols; LAS float* RP = (LAS float*)(lds + 114688 + 256);
    if (!CTXQ && tid < 465) RP[tid] = A.in(IRPB)[(size_t)(l * 4 + h) * 465 + tid];
#define NA_KOFF(k2, n, part) const int q_ = tid + NTHR * (k2), n = q_ >> 3, part = q_ & 7; \
        const int krow_ = (!CTXQ && n < 512) ? (b * SEQ + (r0 + (n >> 6)) * 64 + (n & 63)) : (NLAT + b * CTXL + (CTXQ ? n : n - 512)); const unsigned koff_ = (unsigned)(krow_ * DIN + h * 64 + part * 8) * 2u
#pragma unroll
    for (int k2 = 0; k2 < NCH; ++k2) { NA_KOFF(k2, n, part); *(LAS u32x4*)(Kimg + n * KST + part * 8) = *(const u32x4*)(cb + koff_ + C_NA_K * 2); }
    const int qrow = qbase + mt * 16 + qi;
    bf16x8 qf0 = *(const bf16x8*)(cols + (size_t)qrow * DIN + C_NA_Q + h * 64 + g * 8), qf1 = *(const bf16x8*)(cols + (size_t)qrow * DIN + C_NA_Q + h * 64 + 32 + g * 8);
    LBAR();
    const int cq = mt * 16 + qi, c0 = min(max(cq - 8, 0), 48);
    const int mk0 = 4 * g - c0, bi0 = 4 * g - cq + 15;
    const int ctlo = mt >= 2 ? mt - 1 : 0, cthi = mt <= 1 ? mt + 1 : 3;
#define NA_TILE(t, sv) do { const int kt = kq * NTW + (t); \
        if (!CTXQ && kt < 32 && ((kt & 3) < ctlo || (kt & 3) > cthi)) { sv = (f32x4){-INFINITY, -INFINITY, -INFINITY, -INFINITY}; } \
        else { f32x4 acc_ = {0.f, 0.f, 0.f, 0.f}; \
            acc_ = mma(lds_frag(Kimg, KST, kt * 16, 0, lane), qf0, acc_); acc_ = mma(lds_frag(Kimg, KST, kt * 16, 32, lane), qf1, acc_); \
            if (!CTXQ && kt < 32) { const int ct16_ = (kt & 3) * 16; const LAS float* rp_ = RP + (r0 + (kt >> 2) - r + 7) * 31 + ct16_ + bi0; const int mk_ = ct16_ + mk0; \
                _Pragma("unroll") for (int i_ = 0; i_ < 4; ++i_) sv[i_] = ((unsigned)(mk_ + i_) < 16u) ? acc_[i_] * 0.125f + rp_[i_] : -INFINITY; } \
            else { sv = acc_ * 0.125f; } } } while (0)
    f32x4 s[NTW]; float mloc = -INFINITY;
#pragma unroll
    for (int t = 0; t < NTW; ++t) { f32x4 sv; NA_TILE(t, sv); s[t] = sv; mloc = fmaxf(fmaxf(mloc, fmaxf(sv[0], sv[1])), fmaxf(sv[2], sv[3])); if (t & 1) __builtin_amdgcn_sched_barrier(0); }
    mloc = fmaxf(mloc, __shfl_xor(mloc, 16)); mloc = fmaxf(mloc, __shfl_xor(mloc, 32));
    u32x4 vreg[NCH];
#pragma unroll
    for (int k2 = 0; k2 < NCH; ++k2) { NA_KOFF(k2, n, part); (void)n; vreg[k2] = *(const u32x4*)(cb + koff_ + C_NA_V * 2); }
    float lsum = 0.f; bf16x8 pb[NTW / 2];
#pragma unroll
    for (int tt = 0; tt < NTW / 2; ++tt) { float p[8];
#pragma unroll
        for (int i = 0; i < 4; ++i) { p[i] = __expf(s[2 * tt][i] - mloc); p[4 + i] = __expf(s[2 * tt + 1][i] - mloc); }
#pragma unroll
        for (int i = 0; i < 8; ++i) lsum += p[i];
        u32x4 w; w.x = pk2(p[0], p[1]); w.y = pk2(p[2], p[3]); w.z = pk2(p[4], p[5]); w.w = pk2(p[6], p[7]);
        pb[tt] = __builtin_bit_cast(bf16x8, w); }
#undef NA_TILE
    lsum += __shfl_xor(lsum, 16); lsum += __shfl_xor(lsum, 32);
    LBAR();
#pragma unroll
    for (int k2 = 0; k2 < NCH; ++k2) { const int q_ = tid + NTHR * k2, n = q_ >> 3, part = q_ & 7; *(LAS u32x4*)(Kimg + n * KST + part * 8) = vreg[k2]; }
#undef NA_KOFF
    LBAR();
    f32x4 o[4];
    const unsigned vbase = (unsigned)(size_t)Kimg + (unsigned)(((kq * NTW * 16 + 4 * g + (qi >> 2)) * KST + 4 * (qi & 3)) * 2);
#define NA_OFFL(dt, tt) (((32 * (tt)) * 72 + 16 * (dt)) * 2)
#define NA_OFFH(dt, tt) (((32 * (tt) + 16) * 72 + 16 * (dt)) * 2)
#define NA_PV2(dt, t2) do { u32x2 l0, l1, h0, h1; \
        asm volatile("ds_read_b64_tr_b16 %0, %4 offset:%5\n\tds_read_b64_tr_b16 %2, %4 offset:%6\n\tds_read_b64_tr_b16 %1, %4 offset:%7\n\tds_read_b64_tr_b16 %3, %4 offset:%8\n\ts_waitcnt lgkmcnt(0)" \
                     : "=&v"(l0), "=&v"(l1), "=&v"(h0), "=&v"(h1) : "v"(vbase), "i"(NA_OFFL(dt, t2)), "i"(NA_OFFH(dt, t2)), "i"(NA_OFFL(dt, (t2) + 1)), "i"(NA_OFFH(dt, (t2) + 1)) : "memory"); \
        u32x4 w_; w_.x = l0.x; w_.y = l0.y; w_.z = h0.x; w_.w = h0.y; acc = mma(__builtin_bit_cast(bf16x8, w_), pb[(t2)], acc); \
        w_.x = l1.x; w_.y = l1.y; w_.z = h1.x; w_.w = h1.y; acc = mma(__builtin_bit_cast(bf16x8, w_), pb[(t2) + 1], acc); } while (0)
#define NA_PV(dt, hb) do { NA_PV2(dt, 4 * (hb)); NA_PV2(dt, 4 * (hb) + 2); } while (0)
#define NA_PVD(dt) do { f32x4 acc = {0.f, 0.f, 0.f, 0.f}; NA_PV(dt, 0); if constexpr (NTW / 8 > 1) { NA_PV(dt, 1); NA_PV(dt, 2); } o[dt] = acc; } while (0)
    NA_PVD(0); NA_PVD(1); NA_PVD(2); NA_PVD(3);
#undef NA_PVD
#undef NA_PV
#undef NA_PV2
#undef NA_OFFL
#undef NA_OFFH
    LBAR();
    LAS float* mrg = (LAS float*)lds + mt * 1088;
    if (kq == 1) {
#pragma unroll
        for (int dt = 0; dt < 4; ++dt)
#pragma unroll
            for (int i = 0; i < 4; ++i) mrg[(dt * 16 + 4 * g + i) * 16 + qi] = o[dt][i];
        if (g == 0) { mrg[1024 + qi] = mloc; mrg[1040 + qi] = lsum; } }
    LBAR();
    if (kq == 0) { const float m1 = mrg[1024 + qi], l1 = mrg[1040 + qi], mm = fmaxf(mloc, m1), f0 = __expf(mloc - mm), f1 = __expf(m1 - mm), inv = 1.f / (lsum * f0 + l1 * f1);
#pragma unroll
        for (int dt = 0; dt < 4; ++dt) { float y[4];
#pragma unroll
            for (int i = 0; i < 4; ++i) y[i] = (o[dt][i] * f0 + mrg[(dt * 16 + 4 * g + i) * 16 + qi] * f1) * inv;
            u32x2 w; w.x = pk2(y[0], y[1]); w.y = pk2(y[2], y[3]);
            *(u32x2*)(MIX + (size_t)qrow * D + 256 + h * 64 + dt * 16 + 4 * g) = w; } }
    LBAR();
}
__device__ __forceinline__ void gla_item_info(int item, int& b, int& h, int& cc, int& m0, bool& isctx) {
    const int cidx = item >> 2; h = item & 3;
    if (cidx < 512) { b = cidx >> 7; cc = cidx & 127; m0 = b * SEQ + cc * 32; isctx = false; } else { const int j = cidx - 512; b = j >> 3; cc = j & 7; m0 = NLAT + b * CTXL + cc * 32; isctx = true; }
}
__device__ __forceinline__ int gla_cpos(bool isctx, int cc, int dir) { return isctx ? (dir ? 7 - cc : cc) : 8 + (dir ? 127 - cc : cc); }
__device__ __forceinline__ float fast_logsigmoid(float z) { return fminf(z, 0.f) - __logf(1.f + __expf(-fabsf(z))); }

__device__ __forceinline__ void gla_a_chunk(const Ctx& A, int l, LAS unsigned char* lds, int lane, int wave, int chunk) {
    LAS unsigned char* base = lds + wave * 17664;
    LAS bf16* QT = (LAS bf16*)base; LAS bf16* KT = (LAS bf16*)(base + 2560); LAS bf16* KDT = (LAS bf16*)(base + 5120); LAS bf16* PM = (LAS bf16*)(base + 7680); LAS bf16* VT = (LAS bf16*)(base + 10240); LAS float* GL = (LAS float*)(base + 15360); LAS float* ALR = (LAS float*)(base + 15616);
    const bf16* cols = (const bf16*)(A.ws() + WS_COLS); const float* gates = (const float*)(A.ws() + WS_GATES); const float* rope = (const float*)(A.ws() + WS_ROPE);
    bf16* SD = (bf16*)(A.ws() + WS_SD); float* SA = (float*)(A.ws() + WS_SA); bf16* OI = (bf16*)(A.ws() + WS_OI); bf16* QTG = (bf16*)(A.ws() + WS_QTG);
    const int d = lane & 31, dr = lane >> 5, g = lane >> 4, c16 = lane & 15;
    { const int item = chunk * NWAVES + wave;
        int b, h, cc, m0; bool isctx; gla_item_info(item, b, h, cc, m0, isctx);
#pragma unroll 8
        for (int t = 0; t < 32; ++t) VT[lane * 40 + t] = cols[(size_t)(m0 + t) * DIN + C_GLA_V + h * 64 + lane];
        f32x4 o[2][4];
#pragma unroll
        for (int i = 0; i < 2; ++i)
#pragma unroll
            for (int j = 0; j < 4; ++j) o[i][j] = (f32x4){0.f, 0.f, 0.f, 0.f};
#pragma unroll 1
        for (int dir = 0; dir < 2; ++dir) {
            const float* w2 = A.in(IGLAW) + ((size_t)(l * 2 + dir) * 16) * 128 + h * 32 + d; float w[16];
#pragma unroll
            for (int r = 0; r < 16; ++r) w[r] = w2[r * 128];
            float Gr = 0.f; const float bias = A.in(IGLAB)[(l * 2 + dir) * 128 + h * 32 + d];
            const float xs = dr ? 1.f : 0.17677669529663687f;
            { const int t = lane >> 1, part = lane & 1; const f32x4* ap = (const f32x4*)(gates + (size_t)(m0 + t) * 48 + dir * 16 + part * 8);
              const f32x4 v0 = ap[0], v1 = ap[1]; *(LAS f32x4*)(ALR + t * 16 + part * 8) = v0; *(LAS f32x4*)(ALR + t * 16 + part * 8 + 4) = v1; }
#pragma unroll
            for (int k2 = 0; k2 < 2; ++k2) { const int c = lane + 64 * k2, row = c >> 2, part = c & 3; const bf16* src = cols + (size_t)(m0 + row) * DIN + h * 32 + part * 8;
                *(LAS u32x4*)(QT + row * 40 + part * 8) = *(const u32x4*)(src + C_GLA_Q); *(LAS u32x4*)(KT + row * 40 + part * 8) = *(const u32x4*)(src + C_GLA_K); }
            WAVE_SYNC();
            LAS bf16* XI = dr ? KT : QT;
            float rc = 1.f, rs = 0.f, rcd = 1.f, rsd = 0.f;
            if (!isctx) { const int t0 = dir ? 31 : 0, tpos0 = cc * 32 + t0, pos0 = (d & 16) ? (tpos0 & 63) : (tpos0 >> 6); rc = rope[(pos0 * 8 + (d & 7)) * 2]; rs = rope[(pos0 * 8 + (d & 7)) * 2 + 1];
                if (d & 16) { rcd = rope[(8 + (d & 7)) * 2]; rsd = rope[(8 + (d & 7)) * 2 + 1]; if (dir) rsd = -rsd; } }
#pragma unroll 4
            for (int i = 0; i < 32; ++i) { const int t = dir ? 31 - i : i;
                const LAS f32x4* ap = (const LAS f32x4*)(ALR + t * 16); const f32x4 a0 = ap[0], a1 = ap[1], a2 = ap[2], a3 = ap[3];
                const float z = bias + a0.x * w[0] + a0.y * w[1] + a0.z * w[2] + a0.w * w[3] + a1.x * w[4] + a1.y * w[5] + a1.z * w[6] + a1.w * w[7]
                                     + a2.x * w[8] + a2.y * w[9] + a2.z * w[10] + a2.w * w[11] + a3.x * w[12] + a3.y * w[13] + a3.z * w[14] + a3.w * w[15];
                Gr += fast_logsigmoid(z) * (1.f / 16.f);
                float x = bf2f(XI[t * 40 + d]) * xs; const float y = dppf<0x128>(x);
                if (!isctx) { x = (d & 8) ? (x * rc + y * rs) : (x * rc - y * rs);
                    const float nc = rc * rcd - rs * rsd, ns = rs * rcd + rc * rsd; rc = nc; rs = ns; }
                if (dr == 0) QT[t * 40 + d] = (bf16)f2bf(x * __expf(Gr));
                else { const bf16 kv = (bf16)f2bf(x * __expf(-Gr)); KT[t * 40 + d] = kv; KDT[d * 40 + t] = kv; } }
            const float glast = Gr;
            if (dr == 0) GL[d] = __expf(glast);
            WAVE_SYNC();
#pragma unroll
            for (int ti = 0; ti < 2; ++ti) { const bf16x8 a = lds_frag(QT, 40, 16 * ti, 0, lane);
#pragma unroll
                for (int sj = 0; sj < 2; ++sj) { f32x4 acc = {0.f, 0.f, 0.f, 0.f}; acc = mma(a, lds_frag(KT, 40, 16 * sj, 0, lane), acc);
#pragma unroll
                    for (int r = 0; r < 4; ++r) { const int t = 16 * ti + 4 * g + r, s = 16 * sj + c16; const bool keep = dir ? (s >= t) : (s <= t);
                        PM[t * 40 + s] = (bf16)f2bf(keep ? acc[r] : 0.f); } } }
            WAVE_SYNC();
            const int chain = (b * 4 + h) * 2 + dir, cpos = gla_cpos(isctx, cc, dir);
            bf16* sd = SD + ((size_t)chain * 136 + cpos) * 2048;
#pragma unroll
            for (int j = 0; j < 4; ++j) { const bf16x8 vb = lds_frag(VT, 40, 16 * j, 0, lane);
#pragma unroll
                for (int ti = 0; ti < 2; ++ti) { o[ti][j] = mma(lds_frag(PM, 40, 16 * ti, 0, lane), vb, o[ti][j]);
                    f32x4 acc = {0.f, 0.f, 0.f, 0.f}; acc = mma(lds_frag(KDT, 40, 16 * ti, 0, lane), vb, acc);
#pragma unroll
                    for (int r = 0; r < 4; ++r) sd[(16 * ti + 4 * g + r) * 64 + 16 * j + c16] = (bf16)f2bf(acc[r] * GL[16 * ti + 4 * g + r]); } }
            if (dr == 0) SA[((size_t)chain * 136 + cpos) * 32 + d] = GL[d];
            { bf16* qg = QTG + ((size_t)item * 2 + dir) * 1024;
#pragma unroll
              for (int k2 = 0; k2 < 2; ++k2) { const int c = lane + 64 * k2, row = c >> 2, part = c & 3; *(u32x4*)(qg + row * 32 + part * 8) = *(const LAS u32x4*)(QT + row * 40 + part * 8); } }
            WAVE_SYNC();
        }
        bf16* oi = OI + (size_t)item * 2048;
#pragma unroll
        for (int ti = 0; ti < 2; ++ti)
#pragma unroll
            for (int j = 0; j < 4; ++j)
#pragma unroll
                for (int r = 0; r < 4; ++r) oi[(16 * ti + 4 * g + r) * 64 + 16 * j + c16] = (bf16)f2bf(o[ti][j][r]);
    }
}
__device__ __forceinline__ void ph_gla_b(const Ctx& A, int tid, int blk, int nblk) {
    const bf16* __restrict__ SD = (const bf16*)(A.ws() + WS_SD); const float* __restrict__ SA = (const float*)(A.ws() + WS_SA); bf16* __restrict__ SS = (bf16*)(A.ws() + WS_SS);
    for (int idx = blk * NTHR + tid; idx < 32 * 2048; idx += nblk * NTHR) {
        const int chain = idx >> 11, e = idx & 2047, d = e >> 6;
        const bf16* sd = SD + (size_t)chain * 136 * 2048 + e; const float* sa = SA + (size_t)chain * 136 * 32 + d; bf16* ss = SS + (size_t)chain * 136 * 2048 + e;
        float S = 0.f;
#pragma unroll 1
        for (int p0 = 0; p0 < 136; p0 += 17) { float inc[17], a[17];
#pragma unroll
            for (int k = 0; k < 17; ++k) { inc[k] = bf2f(sd[(size_t)(p0 + k) * 2048]); a[k] = sa[(p0 + k) * 32]; }
#pragma unroll
            for (int k = 0; k < 17; ++k) { ss[(size_t)(p0 + k) * 2048] = (bf16)f2bf(S); S = a[k] * S + inc[k]; } }
    }
}
__device__ __forceinline__ void ph_gla_c(const Ctx& A, int l, int lane, int wave, int G, int nitems) {
    const bf16* cols = (const bf16*)(A.ws() + WS_COLS); const bf16* SS = (const bf16*)(A.ws() + WS_SS); bf16* MIX = (bf16*)(A.ws() + WS_MIX);
    const bf16* OI = (const bf16*)(A.ws() + WS_OI); const bf16* QTG = (const bf16*)(A.ws() + WS_QTG);
    const int gw = blockIdx.x * NWAVES + wave, NGW = G * NWAVES; const int g = lane >> 4, c16 = lane & 15;
    for (int item = gw; item < nitems; item += NGW) {
        int b, h, cc, m0; bool isctx; gla_item_info(item, b, h, cc, m0, isctx);
        f32x4 o[2][4]; const bf16* oi = OI + (size_t)item * 2048;
#pragma unroll
        for (int ti = 0; ti < 2; ++ti)
#pragma unroll
            for (int j = 0; j < 4; ++j)
#pragma unroll
                for (int r = 0; r < 4; ++r) o[ti][j][r] = bf2f(oi[(16 * ti + 4 * g + r) * 64 + 16 * j + c16]);
#pragma unroll
        for (int dir = 0; dir < 2; ++dir) {
            const int chain = (b * 4 + h) * 2 + dir, cpos = gla_cpos(isctx, cc, dir);
            const bf16* sd = SS + ((size_t)chain * 136 + cpos) * 2048; const bf16* qg = QTG + ((size_t)item * 2 + dir) * 1024;
            const bf16x8 qa0 = *(const bf16x8*)(qg + c16 * 32 + 8 * g), qa1 = *(const bf16x8*)(qg + (16 + c16) * 32 + 8 * g);
#pragma unroll
            for (int j = 0; j < 4; ++j) { unsigned sv[8];
#pragma unroll
                for (int jj = 0; jj < 8; ++jj) sv[jj] = sd[(8 * g + jj) * 64 + 16 * j + c16];
                u32x4 w; w.x = sv[0] | (sv[1] << 16); w.y = sv[2] | (sv[3] << 16); w.z = sv[4] | (sv[5] << 16); w.w = sv[6] | (sv[7] << 16);
                const bf16x8 sb = __builtin_bit_cast(bf16x8, w);
                o[0][j] = mma(qa0, sb, o[0][j]); o[1][j] = mma(qa1, sb, o[1][j]); } }
        const float* ng = A.in(IGLAN) + l * 64;
#pragma unroll
        for (int ti = 0; ti < 2; ++ti)
#pragma unroll
            for (int r = 0; r < 4; ++r) { float ss = 0.f;
#pragma unroll
                for (int j = 0; j < 4; ++j) ss += o[ti][j][r] * o[ti][j][r];
                ss = row16_sum(ss);
                const float rs = rsqrtf(ss * (1.f / 64.f) + RMS_EPS); const int t = 16 * ti + 4 * g + r;
#pragma unroll
                for (int j = 0; j < 4; ++j) { const int dv = 16 * j + c16; const float gt = bf2f(cols[(size_t)(m0 + t) * DIN + C_GLA_G + h * 64 + dv]);
                    MIX[(size_t)(m0 + t) * D + h * 64 + dv] = (bf16)f2bf(o[ti][j][r] * rs * ng[dv] * siluf_(gt)); } }
    }
}

__device__ __forceinline__ int gdn_m0(int ci) { return ci < 256 ? ((ci >> 6) * SEQ + (ci & 63) * 64) : (NLAT + ((ci - 256) >> 2) * CTXL + ((ci - 256) & 3) * 64); }

__device__ __forceinline__ void gdn_solve(const LAS bf16* LB, LAS float* Ld, LAS bf16* TT, LAS bf16* DA, LAS bf16* TBv, LAS bf16* TBw, const LAS float* gc, int dir, int lane) {
    const int g = lane >> 4, c16 = lane & 15;
    { const LAS float* ld = Ld + g * 320; float dc[16];
#pragma unroll
      for (int r = 0; r < 16; ++r) { float a = (r == c16) ? 1.f : 0.f;
#pragma unroll
          for (int j4 = 0; j4 < (r + 3) / 4; ++j4) { const f32x4 lv = *(const LAS f32x4*)(ld + r * 20 + 4 * j4);
              if (4 * j4 + 0 < r) a -= lv.x * dc[4 * j4 + 0];
              if (4 * j4 + 1 < r) a -= lv.y * dc[4 * j4 + 1];
              if (4 * j4 + 2 < r) a -= lv.z * dc[4 * j4 + 2];
              if (4 * j4 + 3 < r) a -= lv.w * dc[4 * j4 + 3]; }
          dc[r] = a; }
#pragma unroll
      for (int r = 0; r < 16; ++r) { DA[(16 * g + r) * 32 + c16] = (bf16)f2bf(dc[r]); DA[(16 * g + r) * 32 + 16 + c16] = 0; } }
    WAVE_SYNC();
    LAS bf16* XT = (LAS bf16*)Ld;
#pragma unroll
    for (int q = 0; q < 5; ++q) ((LAS u32x4*)XT)[lane + 64 * q] = (u32x4){0u, 0u, 0u, 0u};
    float sv[4], sw[4]; int tc[4];
#pragma unroll
    for (int nt = 0; nt < 4; ++nt) { const int c = 16 * nt + c16; const float be = gc[64 + c]; sv[nt] = be; sw[nt] = -be * __expf(gc[c]); tc[nt] = dir ? 63 - c : c; }
    WAVE_SYNC();
#pragma unroll 1
    for (int ib = 0; ib < 4; ++ib) {
        f32x4 x[4];
#pragma unroll
        for (int nt = 0; nt < 4; ++nt) x[nt] = (f32x4){0.f, 0.f, 0.f, 0.f};
        if (ib > 0) { const bf16x8 a0 = lds_frag(LB, 72, 16 * ib, 0, lane), a1 = lds_frag(LB, 72, 16 * ib, 32, lane);
#pragma unroll
            for (int nt = 0; nt < 4; ++nt) { x[nt] = mma(a0, lds_frag(TT, 72, 16 * nt, 0, lane), x[nt]); x[nt] = mma(a1, lds_frag(TT, 72, 16 * nt, 32, lane), x[nt]); } }
#pragma unroll
        for (int nt = 0; nt < 4; ++nt) { f32x4 v = x[nt];
#pragma unroll
            for (int r = 0; r < 4; ++r) if (nt == ib && 4 * g + r == c16) v[r] += 1.f;
            u32x2 w; w.x = pk2(v[0], v[1]); w.y = pk2(v[2], v[3]); *(LAS u32x2*)(XT + (16 * nt + c16) * 40 + 4 * g) = w; }
        WAVE_SYNC();
        const bf16x8 da = lds_frag(DA, 32, 16 * ib, 0, lane);
#pragma unroll
        for (int nt = 0; nt < 4; ++nt) { f32x4 t = {0.f, 0.f, 0.f, 0.f}; t = mma(da, lds_frag(XT, 40, 16 * nt, 0, lane), t);
            u32x2 w; w.x = pk2(t[0], t[1]); w.y = pk2(t[2], t[3]); *(LAS u32x2*)(TT + (16 * nt + c16) * 72 + 16 * ib + 4 * g) = w;
#pragma unroll
            for (int r = 0; r < 4; ++r) { TBv[(16 * ib + 4 * g + r) * 72 + tc[nt]] = (bf16)f2bf(t[r] * sv[nt]); TBw[(16 * ib + 4 * g + r) * 72 + tc[nt]] = (bf16)f2bf(t[r] * sw[nt]); } }
        WAVE_SYNC();
    }
}

__device__ __forceinline__ void gdn_prep_item(const Ctx& A, int l, LAS unsigned char* lds, int item, int tid, int lane, int wave) {
    LAS bf16* QN = (LAS bf16*)lds; LAS bf16* KN = (LAS bf16*)(lds + 17408);
    LAS bf16* LB = (LAS bf16*)lds; LAS float* Ld = (LAS float*)(lds + 18432);
    LAS bf16* TT = (LAS bf16*)(lds + 109568); LAS float* RB = (LAS float*)(lds + 128000);
    LAS bf16* VT = (LAS bf16*)(lds + 34816); LAS bf16* KNT = (LAS bf16*)(lds + 53248);
    LAS float* KK = (LAS float*)(lds + 71680); LAS float* QK = (LAS float*)(lds + 88320);
    LAS bf16* TB = (LAS bf16*)(lds + 71680);
    LAS float* GC = (LAS float*)(lds + 108544);
    const int ci = item >> 2, h = item & 3, m0 = gdn_m0(ci);
    { const bf16* cols = (const bf16*)(A.ws() + WS_COLS); const float* cw = A.in(ICONV) + (size_t)l * 5 * 1536; bf16* GQ = (bf16*)(A.ws() + WS_GQ);
      LAS bf16* VS = (LAS bf16*)(lds + 71680 + wave * 2176);
      const int part = lane >> 4, c8 = (lane & 15) * 8; const bool isctx = ci >= 256; const int slen = isctx ? CTXL : SEQ, cpos = (isctx ? ((ci - 256) & 3) : (ci & 63)) * 64, tseq0 = cpos + wave * 8, mseq0 = m0 - cpos;
      if (part < 3) { const int ch = part * 512 + h * 128 + c8;
          u32x4 xin[12];
#pragma unroll
          for (int i = 0; i < 12; ++i) { const int tt = tseq0 + i - 2, tc = min(max(tt, 0), slen - 1); const u32x4 x = *(const u32x4*)(cols + (size_t)(mseq0 + tc) * DIN + C_GDN_Q + ch);
              const bool ok = tt == tc; xin[i].x = ok ? x.x : 0u; xin[i].y = ok ? x.y : 0u; xin[i].z = ok ? x.z : 0u; xin[i].w = ok ? x.w : 0u; }
          f32x4 w0[5], w1[5];
#pragma unroll
          for (int j = 0; j < 5; ++j) { w0[j] = *(const f32x4*)(cw + j * 1536 + ch); w1[j] = *(const f32x4*)(cw + j * 1536 + ch + 4); }
#pragma unroll
          for (int r = 0; r < 8; ++r) { f32x4 a0 = {0.f, 0.f, 0.f, 0.f}, a1 = {0.f, 0.f, 0.f, 0.f};
#pragma unroll
              for (int j = 0; j < 5; ++j) { const u32x4 w = xin[r + j];
                  a0 += (f32x4){bf2f(w.x & 0xffffu), bf2f(w.x >> 16), bf2f(w.y & 0xffffu), bf2f(w.y >> 16)} * w0[j]; a1 += (f32x4){bf2f(w.z & 0xffffu), bf2f(w.z >> 16), bf2f(w.w & 0xffffu), bf2f(w.w >> 16)} * w1[j]; }
              { const f32x4 t0 = a0 * -1.4426950408889634f, t1 = a1 * -1.4426950408889634f;
                const f32x4 d0 = (f32x4){__builtin_amdgcn_exp2f(t0[0]), __builtin_amdgcn_exp2f(t0[1]), __builtin_amdgcn_exp2f(t0[2]), __builtin_amdgcn_exp2f(t0[3])} + 1.f, d1 = (f32x4){__builtin_amdgcn_exp2f(t1[0]), __builtin_amdgcn_exp2f(t1[1]), __builtin_amdgcn_exp2f(t1[2]), __builtin_amdgcn_exp2f(t1[3])} + 1.f;
                a0 = a0 * (f32x4){__builtin_amdgcn_rcpf(d0[0]), __builtin_amdgcn_rcpf(d0[1]), __builtin_amdgcn_rcpf(d0[2]), __builtin_amdgcn_rcpf(d0[3])}; a1 = a1 * (f32x4){__builtin_amdgcn_rcpf(d1[0]), __builtin_amdgcn_rcpf(d1[1]), __builtin_amdgcn_rcpf(d1[2]), __builtin_amdgcn_rcpf(d1[3])}; }
              float scale = 1.f;
              if (part < 2) { const f32x4 q = a0 * a0 + a1 * a1; const float ss = row16_sum((q[0] + q[1]) + (q[2] + q[3])); scale = rsqrtf(ss + 1e-6f) * (part == 0 ? 0.08838834764831845f : 1.f); }
              a0 = a0 * scale; a1 = a1 * scale;
              u32x4 o; o.x = pk2(a0[0], a0[1]); o.y = pk2(a0[2], a0[3]); o.z = pk2(a1[0], a1[1]); o.w = pk2(a1[2], a1[3]);
              const int t = wave * 8 + r;
              if (part == 0) { *(LAS u32x4*)(QN + t * 136 + c8) = o; *(u32x4*)(GQ + (size_t)(m0 + t) * 512 + h * 128 + c8) = o; }
              else if (part == 1) *(LAS u32x4*)(KN + t * 136 + c8) = o;
              else *(LAS u32x4*)(VS + r * 136 + c8) = o; } }
      WAVE_SYNC();
#pragma unroll
      for (int q = 0; q < 4; ++q) { const int chq = lane + 64 * (q & 1); const bool isk = q < 2; const LAS bf16* src = isk ? (KN + (wave * 8) * 136 + chq) : (VS + chq); unsigned hh[8];
#pragma unroll
          for (int e = 0; e < 8; ++e) hh[e] = src[e * 136];
          u32x4 w; w.x = hh[0] | (hh[1] << 16); w.y = hh[2] | (hh[3] << 16); w.z = hh[4] | (hh[5] << 16); w.w = hh[6] | (hh[7] << 16);
          *(LAS u32x4*)((isk ? KNT : VT) + chq * 72 + wave * 8) = w; }
      if (tid < 128) { const int dir = tid >> 6, i = tid & 63, t = dir ? 63 - i : i; const float* gp = (const float*)(A.ws() + WS_GATES) + (size_t)(m0 + t) * 48; const int c = dir * 4 + h;
          GC[dir * 128 + i] = -__expf(A.in(IALOG)[l * 8 + c]) * softplusf_(gp[40 + c] + A.in(IDTB)[l * 8 + c]); GC[dir * 128 + 64 + i] = sigmoidf_(gp[32 + c]); } }
    LBAR();
    const int g = lane >> 4, c16 = lane & 15;
#pragma unroll
    for (int x = 0; x < 4; ++x) { const int id = wave * 4 + x, ti = (id >> 2) & 3, tj = id & 3; const bool isq = id >= 16;
        f32x4 acc = {0.f, 0.f, 0.f, 0.f};
#pragma unroll
        for (int ks = 0; ks < 4; ++ks) acc = mma(lds_frag(isq ? QN : KN, 136, 16 * ti, 32 * ks, lane), lds_frag(KN, 136, 16 * tj, 32 * ks, lane), acc);
        LAS float* dst = isq ? QK : KK;
#pragma unroll
        for (int r = 0; r < 4; ++r) dst[(16 * ti + 4 * g + r) * 65 + 16 * tj + c16] = acc[r]; }
    float myg = 0.f;
    if (tid < 128) { myg = GC[(tid >> 6) * 128 + (tid & 63)];
#pragma unroll
        for (int o = 1; o < 64; o <<= 1) { const float t = __shfl_up(myg, o); if ((tid & 63) >= o) myg += t; } }
    LBAR();
    if (tid < 128) { const int dir = tid >> 6, i = tid & 63; GC[dir * 128 + i] = myg; float* gcb = (float*)(A.ws() + WS_GCB) + (size_t)(item * 2 + dir) * 128; gcb[i] = myg; gcb[64 + i] = GC[dir * 128 + 64 + i]; }
    LBAR();
    for (int q4 = tid; q4 < 2048; q4 += NTHR) { const int dir = q4 >> 10, i = (q4 >> 4) & 63, j0 = (q4 & 15) * 4, ti = dir ? 63 - i : i;
        const LAS float* gc = GC + dir * 128; const f32x4 gj = *(const LAS f32x4*)(gc + j0); const float gi = gc[i], bi = gc[64 + i];
        const f32x4 tt = __builtin_elementwise_min((f32x4){gi, gi, gi, gi} - gj, (f32x4){0.f, 0.f, 0.f, 0.f}) * 1.4426950408889634f;
        const f32x4 dec = {__builtin_amdgcn_exp2f(tt[0]), __builtin_amdgcn_exp2f(tt[1]), __builtin_amdgcn_exp2f(tt[2]), __builtin_amdgcn_exp2f(tt[3])};
        const LAS float* kr = KK + ti * 65; const LAS float* qr = QK + ti * 65; f32x4 kk, qk;
#pragma unroll
        for (int c = 0; c < 4; ++c) { const int tj = dir ? 63 - (j0 + c) : j0 + c; kk[c] = kr[tj]; qk[c] = qr[tj]; }
        f32x4 lv = kk * dec * bi, qv = qk * dec;
#pragma unroll
        for (int c = 0; c < 4; ++c) { lv[c] = (j0 + c < i) ? lv[c] : 0.f; qv[c] = (j0 + c <= i) ? qv[c] : 0.f; }
        const bool diag = (i >> 4) == (j0 >> 4);
        { u32x2 w; w.x = diag ? 0u : pk2(-lv[0], -lv[1]); w.y = diag ? 0u : pk2(-lv[2], -lv[3]); *(LAS u32x2*)(LB + dir * 4608 + i * 72 + j0) = w; }
        if (diag) *(LAS f32x4*)(Ld + dir * 1280 + (i >> 4) * 320 + (i & 15) * 20 + (j0 & 15)) = lv;
        { u32x2 w; w.x = pk2(qv[0], qv[1]); w.y = pk2(qv[2], qv[3]); *(u32x2*)((bf16*)(A.ws() + WS_GQKM) + (size_t)(item * 2 + dir) * 4096 + i * 64 + j0) = w; } }
    for (int idx = tid; idx < 2 * 64 * 72 / 2; idx += NTHR) ((LAS unsigned*)TT)[idx] = 0u;
    LBAR();
    if (wave < 2) { const int dir = wave; const LAS float* gc = GC + dir * 128;
        gdn_solve(LB + dir * 4608, Ld + dir * 1280, TT + dir * 4608, (LAS bf16*)(RB + dir * 1088), TB + (dir * 2) * 4608, TB + (dir * 2 + 1) * 4608, gc, dir, lane);
    } else { bf16* GKT = (bf16*)(A.ws() + WS_GKT) + (size_t)item * 8192;
        for (int c = tid - 128; c < 1024; c += NTHR - 128) { const int row = c >> 3, part = c & 7; *(u32x4*)(GKT + row * 64 + part * 8) = *(const LAS u32x4*)(KNT + row * 72 + part * 8); } }
    LBAR();
    { const int o = wave >> 1, dir = o >> 1, isw = o & 1; const LAS bf16* Xt = isw ? KNT : VT; const LAS bf16* Tb = TB + o * 4608;
      bf16* O = (bf16*)(A.ws() + (isw ? WS_GW : WS_GU)) + (size_t)(item * 2 + dir) * 8192;
#pragma unroll
      for (int mi = 0; mi < 2; ++mi) { const int mt = (wave & 1) * 2 + mi; const bf16x8 t0 = lds_frag(Tb, 72, 16 * mt, 0, lane), t1 = lds_frag(Tb, 72, 16 * mt, 32, lane);
#pragma unroll
          for (int nt = 0; nt < 8; ++nt) { f32x4 acc = {0.f, 0.f, 0.f, 0.f}; const bf16x8 x0 = lds_frag(Xt, 72, 16 * nt, 0, lane), x1 = lds_frag(Xt, 72, 16 * nt, 32, lane);
              if (isw) { acc = mma(x0, t0, acc); acc = mma(x1, t1, acc); }
              else { acc = mma(t0, x0, acc); acc = mma(t1, x1, acc); }
              u32x2 w; w.x = pk2(acc[0], acc[1]); w.y = pk2(acc[2], acc[3]);
              if (isw) *(u32x2*)(O + (16 * mt + c16) * 128 + 16 * nt + 4 * g) = w; else *(u32x2*)(O + (16 * nt + c16) * 64 + 16 * mt + 4 * g) = w; } } }
    LBAR();
}
#define GDN_BAR() do { asm volatile("s_waitcnt lgkmcnt(0)" ::: "memory"); __builtin_amdgcn_s_barrier(); asm volatile("" ::: "memory"); } while (0)
#if defined(PROBE_ID) && (PROBE_ID == 52 || PROBE_ID == 53)
#define GDN_BARP(id) do { if ((id) == PROBE_ID) { const unsigned long long t0_ = __builtin_amdgcn_s_memrealtime(); GDN_BAR(); const unsigned long long t1_ = __builtin_amdgcn_s_memrealtime(), dt_ = (t1_ - t0_) * 3ull; \
        while (__builtin_amdgcn_s_memrealtime() - t1_ < dt_) __builtin_amdgcn_s_sleep(4); } else GDN_BAR(); } while (0)
#else
#define GDN_BARP(id) GDN_BAR()
#endif
__device__ __forceinline__ void gdn_step_ids(int p, int b, int h, int dir, int& item, int& m0) {
    int ci; if (p < 4) ci = 256 + b * 4 + (dir ? 3 - p : p); else { const int q = p - 4; ci = b * 64 + (dir ? 63 - q : q); }
    item = ci * 4 + h; m0 = gdn_m0(ci);
}
constexpr int GNT = 2;
struct GdnS { bf16x8 w[4], k[4]; u32x2 ut[GNT]; f32x4 gc; float gl; };
struct GdnO { bf16x8 q[4], p[2]; f32x4 gc; };
__device__ __forceinline__ void gdn_load_s(const Ctx& A, GdnS& o, int p, int b, int h, int dir, unsigned offw, unsigned offk, unsigned offu, unsigned offgc) {
    int item, m0; gdn_step_ids(p, b, h, dir, item, m0); const int oi = item * 2 + dir; const char* ws = (const char*)A.ws();
    const char* bw = ws + WS_GW + (size_t)oi * 16384; const char* bk = ws + WS_GKT + (size_t)item * 16384; const char* bu = ws + WS_GU + (size_t)oi * 16384; const char* bg = ws + WS_GCB + (size_t)oi * 512;
#pragma unroll
    for (int ks = 0; ks < 4; ++ks) o.w[ks] = *(const bf16x8*)(bw + offw + 64 * ks);
    o.k[0] = *(const bf16x8*)(bk + offk); o.k[1] = *(const bf16x8*)(bk + offk + 64); o.k[2] = *(const bf16x8*)(bk + offk + 2048); o.k[3] = *(const bf16x8*)(bk + offk + 2048 + 64);
#pragma unroll
    for (int nt = 0; nt < GNT; ++nt) o.ut[nt] = *(const u32x2*)(bu + offu + 2048 * nt);
    o.gc = *(const f32x4*)(bg + offgc); o.gl = *(const float*)(bg + 252);
}
__device__ __forceinline__ void gdn_load_o(const Ctx& A, GdnO& o, int p, int b, int h, int dir, unsigned offq, unsigned offp, unsigned offgc) {
    int item, m0; gdn_step_ids(p, b, h, dir, item, m0); const int oi = item * 2 + dir; const char* ws = (const char*)A.ws();
    const char* bq = ws + WS_GQ + ((size_t)m0 * 512 + h * 128) * 2; const char* bp = ws + WS_GQKM + (size_t)oi * 8192; const char* bg = ws + WS_GCB + (size_t)oi * 512;
#pragma unroll
    for (int ks = 0; ks < 4; ++ks) o.q[ks] = *(const bf16x8*)(bq + offq + 64 * ks);
    o.p[0] = *(const bf16x8*)(bp + offp); o.p[1] = *(const bf16x8*)(bp + offp + 64);
    o.gc = *(const f32x4*)(bg + offgc);
}
__device__ __forceinline__ void gdn_step_s(const GdnS& o, f32x4 (&accs)[2][GNT], LAS bf16* ST, LAS bf16* VNO, LAS bf16* VNS, int dir, int w, int lane, int g, int c16) {
    const float gl = o.gl; const float e0 = __expf(gl - o.gc.x), e1 = __expf(gl - o.gc.y), e2 = __expf(gl - o.gc.z), e3 = __expf(gl - o.gc.w);
#pragma unroll
    for (int nt = 0; nt < GNT; ++nt) {
        f32x4 acc = {bf2f(o.ut[nt].x & 0xffffu), bf2f(o.ut[nt].x >> 16), bf2f(o.ut[nt].y & 0xffffu), bf2f(o.ut[nt].y >> 16)};
#pragma unroll
        for (int ks = 0; ks < 4; ++ks) acc = mma(o.w[ks], lds_frag(ST, 136, 16 * nt, 32 * ks, lane), acc);
        u32x2 v; v.x = pk2(acc[0], acc[1]); v.y = pk2(acc[2], acc[3]);
        *(LAS u32x2*)(VNO + (16 * nt + c16) * 72 + 16 * w + 4 * g) = v;
        const float s0 = acc[0] * e0, s1 = acc[1] * e1, s2 = acc[2] * e2, s3 = acc[3] * e3;
        if (dir) { v.x = pk2(s3, s2); v.y = pk2(s1, s0); *(LAS u32x2*)(VNS + (16 * nt + c16) * 72 + 60 - 16 * w - 4 * g) = v; }
        else { v.x = pk2(s0, s1); v.y = pk2(s2, s3); *(LAS u32x2*)(VNS + (16 * nt + c16) * 72 + 16 * w + 4 * g) = v; } }
    GDN_BARP(52);
    const float al = __expf(gl);
#pragma unroll
    for (int nt = 0; nt < GNT; ++nt) {
        const bf16x8 v0 = lds_frag(VNS, 72, 16 * nt, 0, lane), v1 = lds_frag(VNS, 72, 16 * nt, 32, lane);
#pragma unroll
        for (int x = 0; x < 2; ++x) { f32x4 s = accs[x][nt] * al; s = mma(o.k[2 * x], v0, s); s = mma(o.k[2 * x + 1], v1, s); accs[x][nt] = s;
            u32x2 v; v.x = pk2(s[0], s[1]); v.y = pk2(s[2], s[3]); *(LAS u32x2*)(ST + (16 * nt + c16) * 136 + 32 * w + 16 * x + 4 * g) = v; } }
    GDN_BARP(52);
}
__device__ __forceinline__ void gdn_step_o(const Ctx& A, const GdnO& o, LAS bf16* ST, LAS bf16* VNO, int p, int b, int h, int dir, const unsigned (&offo)[4], int lane) {
    f32x4 acc[GNT]; const float e0 = __expf(o.gc.x), e1 = __expf(o.gc.y), e2 = __expf(o.gc.z), e3 = __expf(o.gc.w);
#pragma unroll
    for (int nt = 0; nt < GNT; ++nt) { f32x4 a = {0.f, 0.f, 0.f, 0.f};
#pragma unroll
        for (int ks = 0; ks < 4; ++ks) a = mma(o.q[ks], lds_frag(ST, 136, 16 * nt, 32 * ks, lane), a);
        a[0] *= e0; a[1] *= e1; a[2] *= e2; a[3] *= e3; acc[nt] = a; }
    GDN_BARP(53);
    int item, m0; gdn_step_ids(p, b, h, dir, item, m0);
    char* og = (char*)A.ws() + WS_OG + (((size_t)dir * NTOK + m0) * 512 + h * 128) * 2;
#pragma unroll
    for (int nt = 0; nt < GNT; ++nt) { f32x4 a = acc[nt]; a = mma(o.p[0], lds_frag(VNO, 72, 16 * nt, 0, lane), a); a = mma(o.p[1], lds_frag(VNO, 72, 16 * nt, 32, lane), a);
#pragma unroll
        for (int r = 0; r < 4; ++r) *(bf16*)(og + offo[r] + 32 * nt) = (bf16)f2bf(a[r]); }
    GDN_BARP(53);
}
__device__ __forceinline__ void gdn_scan_chain(const Ctx& A, LAS unsigned char* lds, int chain, int sl, int tid, int lane, int wave) {
    LAS bf16* ST = (LAS bf16*)lds; LAS bf16* VNO = (LAS bf16*)(lds + 34816); LAS bf16* VNS = (LAS bf16*)(lds + 53248);
    const int g = lane >> 4, c16 = lane & 15, b = chain >> 3, h = (chain >> 1) & 3, dir = chain & 1, w4 = wave & 3;
    for (int i = tid; i < 16 * GNT * 136 / 2; i += NTHR) ((LAS unsigned*)ST)[i] = 0u;
    const unsigned offgc = (unsigned)(16 * w4 + 4 * g) * 4u;
    GDN_BAR();
    if (wave < 4) {
        const unsigned offw = (unsigned)((16 * w4 + c16) * 128 + 8 * g) * 2u, offk = (unsigned)((32 * w4 + c16) * 64 + 8 * g) * 2u, offu = (unsigned)((16 * GNT * sl + c16) * 64 + 16 * w4 + 4 * g) * 2u;
        f32x4 accs[2][GNT];
#pragma unroll
        for (int x = 0; x < 2; ++x)
#pragma unroll
            for (int nt = 0; nt < GNT; ++nt) accs[x][nt] = (f32x4){0.f, 0.f, 0.f, 0.f};
        GdnS o0, o1, o2;
        gdn_load_s(A, o0, 0, b, h, dir, offw, offk, offu, offgc); gdn_load_s(A, o1, 1, b, h, dir, offw, offk, offu, offgc);
#pragma unroll 1
        for (int p = 0; p < 66; p += 3) {
            gdn_load_s(A, o2, p + 2, b, h, dir, offw, offk, offu, offgc); gdn_step_s(o0, accs, ST, VNO, VNS, dir, w4, lane, g, c16);
            gdn_load_s(A, o0, p + 3, b, h, dir, offw, offk, offu, offgc); gdn_step_s(o1, accs, ST, VNO, VNS, dir, w4, lane, g, c16);
            gdn_load_s(A, o1, p + 4, b, h, dir, offw, offk, offu, offgc); gdn_step_s(o2, accs, ST, VNO, VNS, dir, w4, lane, g, c16);
        }
        gdn_step_s(o0, accs, ST, VNO, VNS, dir, w4, lane, g, c16); gdn_step_s(o1, accs, ST, VNO, VNS, dir, w4, lane, g, c16);
    } else {
        const int i = 16 * w4 + c16, t = dir ? 63 - i : i;
        const unsigned offq = (unsigned)(t * 512 + 8 * g) * 2u, offp = (unsigned)(i * 64 + 8 * g) * 2u; unsigned offo[4];
#pragma unroll
        for (int r = 0; r < 4; ++r) { const int io = 16 * w4 + 4 * g + r, to = dir ? 63 - io : io; offo[r] = (unsigned)(to * 512 + 16 * GNT * sl + c16) * 2u; }
        GdnO o0, o1, o2;
        gdn_load_o(A, o0, 0, b, h, dir, offq, offp, offgc); gdn_load_o(A, o1, 1, b, h, dir, offq, offp, offgc);
#pragma unroll 1
        for (int p = 0; p < 66; p += 3) {
            gdn_load_o(A, o2, p + 2, b, h, dir, offq, offp, offgc); gdn_step_o(A, o0, ST, VNO, p, b, h, dir, offo, lane);
            gdn_load_o(A, o0, p + 3, b, h, dir, offq, offp, offgc); gdn_step_o(A, o1, ST, VNO, p + 1, b, h, dir, offo, lane);
            gdn_load_o(A, o1, p + 4, b, h, dir, offq, offp, offgc); gdn_step_o(A, o2, ST, VNO, p + 2, b, h, dir, offo, lane);
        }
        gdn_step_o(A, o0, ST, VNO, 66, b, h, dir, offo, lane); gdn_step_o(A, o1, ST, VNO, 67, b, h, dir, offo, lane);
    }
    asm volatile("s_waitcnt vmcnt(0)" ::: "memory"); __syncthreads();
}
__device__ __forceinline__ void ph_gdn_finish(const Ctx& A, int l, int lane, int wave, int G, int nrows) {
    const int gw = blockIdx.x * NWAVES + wave, NGW = G * NWAVES;
    const bf16* OG = (const bf16*)(A.ws() + WS_OG); const bf16* cols = (const bf16*)(A.ws() + WS_COLS); bf16* MIX = (bf16*)(A.ws() + WS_MIX);
    const float* ng = A.in(IGDNN) + l * 128 + (lane & 15) * 8;
    const f32x4 n0 = *(const f32x4*)ng, n1 = *(const f32x4*)(ng + 4);
    for (int m0 = gw * 4; m0 < nrows; m0 += NGW * 4) {
        u32x4 fw[4], bw[4], zw[4];
#pragma unroll
        for (int q = 0; q < 4; ++q) { const int m = m0 + q; fw[q] = *(const u32x4*)(OG + (size_t)m * 512 + 8 * lane); bw[q] = *(const u32x4*)(OG + ((size_t)NTOK + m) * 512 + 8 * lane);
            zw[q] = *(const u32x4*)(cols + (size_t)m * DIN + C_GDN_Z + 8 * lane); }
#pragma unroll
        for (int q = 0; q < 4; ++q) { const int m = m0 + q; const u32x4 f = fw[q], b = bw[q];
            const f32x4 v0 = {bf2f(f.x & 0xffffu) + bf2f(b.x & 0xffffu), bf2f(f.x >> 16) + bf2f(b.x >> 16), bf2f(f.y & 0xffffu) + bf2f(b.y & 0xffffu), bf2f(f.y >> 16) + bf2f(b.y >> 16)};
            const f32x4 v1 = {bf2f(f.z & 0xffffu) + bf2f(b.z & 0xffffu), bf2f(f.z >> 16) + bf2f(b.z >> 16), bf2f(f.w & 0xffffu) + bf2f(b.w & 0xffffu), bf2f(f.w >> 16) + bf2f(b.w >> 16)};
            float ss = v0.x * v0.x + v0.y * v0.y + v0.z * v0.z + v0.w * v0.w + v1.x * v1.x + v1.y * v1.y + v1.z * v1.z + v1.w * v1.w;
            ss = row16_sum(ss);
            const float rs = rsqrtf(ss * (1.f / 128.f) + RMS_EPS); const u32x4 z = zw[q];
            float y[8];
            y[0] = v0.x * rs * n0.x * siluf_(bf2f(z.x & 0xffffu)); y[1] = v0.y * rs * n0.y * siluf_(bf2f(z.x >> 16));
            y[2] = v0.z * rs * n0.z * siluf_(bf2f(z.y & 0xffffu)); y[3] = v0.w * rs * n0.w * siluf_(bf2f(z.y >> 16));
            y[4] = v1.x * rs * n1.x * siluf_(bf2f(z.z & 0xffffu)); y[5] = v1.y * rs * n1.y * siluf_(bf2f(z.z >> 16));
            y[6] = v1.z * rs * n1.z * siluf_(bf2f(z.w & 0xffffu)); y[7] = v1.w * rs * n1.w * siluf_(bf2f(z.w >> 16));
            u32x4 o; o.x = pk2(y[0], y[1]); o.y = pk2(y[2], y[3]); o.z = pk2(y[4], y[5]); o.w = pk2(y[6], y[7]);
            *(u32x4*)(MIX + (size_t)m * D + 512 + 8 * lane) = o; }
    }
}

constexpr int NPH = 13;
#ifndef MK_MULTI
#define MK_MULTI 0
#endif
#ifndef PHMASK
#define PHMASK 0x1fff
#endif
#define IN(k) (((PHMASK >> (k)) & 1) && A.ph_lo <= (k) && (k) < A.ph_hi)
#define SEAM() do { if (fused) xcd_barrier(bar); } while (0)
#define PH_BEGIN() int tid = tid0; asm volatile("" : "+v"(tid)); int zz = 0; asm volatile("" : "+s"(zz)); const int lane = tid & 63, wave = __builtin_amdgcn_readfirstlane(tid >> 6); const Ctx C{&A, zz}; (void)lane; (void)wave
#ifdef PROBE_ID
#ifndef PROBE_ID2
#define PROBE_ID2 -1
#endif
#ifndef PROBE_ID3
#define PROBE_ID3 -1
#endif
#define PT0() const unsigned long long pt0_ = __builtin_amdgcn_s_memrealtime()
#define PT1(id) do { if ((id) == PROBE_ID || (id) == PROBE_ID2 || (id) == PROBE_ID3) { const unsigned long long pt1_ = __builtin_amdgcn_s_memrealtime(), dt_ = (pt1_ - pt0_) * 3ull; while (__builtin_amdgcn_s_memrealtime() - pt1_ < dt_) __builtin_amdgcn_s_sleep(16); } } while (0)
#else
#define PT0() do {} while (0)
#define PT1(id) do {} while (0)
#endif
#define CVT_TAIL(k, t0, nt) do { if constexpr (!last) { int tq_ = tid0; asm volatile("" : "+v"(tq_)); int z2_ = 0; asm volatile("" : "+s"(z2_)); const Ctx C2_{&A, z2_}; \
        cvt_drain(C2_, lds, l + 1, (t0), (nt), (unsigned*)(C2_.ws() + WS_CTL) + CW_CQ + (l * 4 + (k)) * 64, tq_, tq_ & 63, __builtin_amdgcn_readfirstlane(tq_ >> 6)); } } while (0)
constexpr int CVQ7 = 1200, CVQ10 = 200, CVQ11 = CV_TICKETS - CVQ7 - CVQ10;
constexpr int CV0_FIRST = (CV_IN + CV_OUT) / 8;
template <int L>
__device__ __forceinline__ void layer_body(const Args& A, LAS unsigned char* lds, const int tid0, const int G, const int vcu, const bool fused, const XcdBarrier& bar) {
    constexpr int l = L; constexpr bool last = (L == DEPTH - 1); constexpr int nrows = last ? NLAT : NTOK;
    if constexpr (L == 0) {
        if (IN(0)) { PH_BEGIN(); { PT0(); ph_mods(C, lds, tid, G); PT1(1); } { PT0(); cvt_drain(C, lds, 0, 0, CV0_FIRST, (unsigned*)(C.ws() + WS_CTL) + CW_CQ + 15 * 64, tid, lane, wave); PT1(0); } SEAM(); }
        if (IN(1)) { PH_BEGIN(); ph_init(C, lane, wave, G); SEAM(); }
    }
    if (IN(2)) { PH_BEGIN();
        pg8::Gemm g{(const bf16*)(C.ws() + WS_H), (const bf16*)(C.ws() + WS_WIN) + (size_t)l * DINP * D, NTOK, DINP, D};
        int Gp = G, cc = (int)blockIdx.x;
        if constexpr (L == 0) { if (G >= 256) { Gp = 176; if (cc >= Gp) cc = (NTOK / 256) * (DINP / 256); } }
        pg8::StaticOrder S; S.init(NTOK, DINP, Gp, cc);
        EpiCols E{(bf16*)(C.ws() + WS_COLS), (float*)(C.ws() + WS_GATES)};
        PT0(); pg8::gemm_phase<EpiCols, pg8::StaticOrder>(lds, g, S, E, nullptr, tid); PT1(2);
        if constexpr (L == 0) { int tq_ = tid0; asm volatile("" : "+v"(tq_)); int z2_ = 0; asm volatile("" : "+s"(z2_)); const Ctx C2_{&A, z2_};
            cvt_drain(C2_, lds, 0, CV0_FIRST, CV_TICKETS - CV0_FIRST, (unsigned*)(C2_.ws() + WS_CTL) + CW_CQ + 14 * 64, tq_, tq_ & 63, __builtin_amdgcn_readfirstlane(tq_ >> 6)); }
        SEAM();
    }
    if (IN(4)) { PH_BEGIN();
        { PT0(); LAS int* wq = (LAS int*)(lds + MISC_OFF + 512); unsigned* ctr = (unsigned*)(C.ws() + WS_CTL) + CW_PQ + l * 64;
          __syncthreads(); if (tid == 0) wq[0] = (int)atomicAdd(ctr, 1u); __syncthreads();
          for (int u = wq[0]; u < 1088 + 272; ) { int nxt = 0; if (tid == 0) nxt = (int)atomicAdd(ctr, 1u);
              int tq = tid; asm volatile("" : "+v"(tq));
              if (u >= 272) gdn_prep_item(C, l, lds, u - 272, tq, tq & 63, wave); else gla_a_chunk(C, l, lds, tq & 63, wave, u);
              __syncthreads(); if (tid == 0) wq[0] = nxt; __syncthreads(); u = wq[0]; }
          PT1(41); }
        SEAM();
    }
    if (IN(5)) { PH_BEGIN();
        { PT0(); if ((int)blockIdx.x < 128) gdn_scan_chain(C, lds, (int)(blockIdx.x & 7) + 8 * (int)(blockIdx.x >> 5), (int)(blockIdx.x >> 3) & 3, tid, lane, wave); else ph_gla_b(C, tid, blockIdx.x - 128, 128); PT1(50); }
        { PT0(); LAS int* wq = (LAS int*)(lds + MISC_OFF + 512); unsigned* ctr = (unsigned*)(C.ws() + WS_CTL) + CW_NAQ + l * 64; const int nun = last ? 1024 : 1088;
          __syncthreads(); if (tid == 0) wq[0] = (int)atomicAdd(ctr, 1u); __syncthreads();
          for (int u = wq[0]; u < nun; ) { int nxt = 0; if (tid == 0) nxt = (int)atomicAdd(ctr, 1u);
              int tq = tid; asm volatile("" : "+v"(tq));
              if (u < 1024) na_unit<false>(C, l, lds, u, tq, tq & 63, wave); else na_unit<true>(C, l, lds, u - 1024, tq, tq & 63, wave);
              __syncthreads(); if (tid == 0) wq[0] = nxt; __syncthreads(); u = wq[0]; }
          PT1(31); }
        SEAM();
    }
    if (IN(6)) { PH_BEGIN();
        { PT0(); ph_gla_c(C, l, lane, wave, G, last ? 2048 : 2176); PT1(60); }
        { PT0(); ph_gdn_finish(C, l, lane, wave, G, nrows); PT1(61); }
        SEAM();
    }
    if (IN(7)) { PH_BEGIN();
        pg8::Gemm g{(const bf16*)(C.ws() + WS_MIX), (const bf16*)(C.ws() + WS_WOUT) + (size_t)l * D * D, nrows, D, D};
        int Gp = G, cc = (int)blockIdx.x;
        if constexpr (!last) { constexpr int units = (nrows / 256) * (D / 256); const int rounds = (units + G - 1) / G; Gp = min(G, (((units + rounds - 1) / rounds) + 7) & ~7); if (cc >= Gp) cc = units; }
        pg8::StaticOrder S; S.init(nrows, D, Gp, cc);
        EpiOut E{(float*)(C.ws() + WS_X), (const float*)(C.ws() + WS_MODS) + (size_t)l * 5 * 6144};
        PT0(); pg8::gemm_phase<EpiOut, pg8::StaticOrder>(lds, g, S, E, nullptr, tid); PT1(7);
        CVT_TAIL(0, 0, CVQ7);
        SEAM();
    }
    if (IN(8)) { PH_BEGIN(); PT0(); ph_ln1_route(C, l, lds, tid, lane, wave, nrows); PT1(8); SEAM(); }
    if (IN(10)) { PH_BEGIN();
        LAS int* tab = (LAS int*)(lds + MISC_OFF + 1024);
        moe_tables((const unsigned*)(C.ws() + WS_CTL) + CW_CNT + l * 64, tab, tid);
        pg8::Gemm g{(const bf16*)(C.ws() + WS_H), (const bf16*)(C.ws() + WS_WGU) + (size_t)l * NE * 2048 * D, 0, 0, D};
        int Gp = G, cc = vcu; const int units = tab[40] * 8;
        if constexpr (!last) { if (G % 8 == 0) { const int rounds = (units + G - 1) / G; Gp = min(G, (((units + rounds - 1) / rounds) + 7) & ~7); const int gp8 = Gp >> 3, bx = (int)blockIdx.x; cc = (bx >> 3) < gp8 ? (bx & 7) * gp8 + (bx >> 3) : units; } }
        MoeOrder S{tab + 64, units, 8, Gp, cc, tab, (const int*)(C.ws() + WS_ETOK)};
        EpiAct E{(bf16*)(C.ws() + WS_ACT), C.in(IBGU) + (size_t)l * NE * 2048};
        PT0(); pg8::gemm_phase<EpiAct, MoeOrder, true>(lds, g, S, E, nullptr, tid); PT1(10);
        CVT_TAIL(1, CVQ7, CVQ10);
        SEAM();
    }
    if (IN(11)) { PH_BEGIN();
        LAS int* tab = (LAS int*)(lds + MISC_OFF + 1024);
        moe_tables((const unsigned*)(C.ws() + WS_CTL) + CW_CNT + l * 64, tab, tid);
        pg8::Gemm g{(const bf16*)(C.ws() + WS_ACT), (const bf16*)(C.ws() + WS_WD) + (size_t)l * NE * D * D, 0, 0, D};
        int Gp = G, cc = vcu; const int units = tab[40] * 4;
        if constexpr (!last) { if (G % 8 == 0) { const int rounds = (units + G - 1) / G; Gp = min(G, (((units + rounds - 1) / rounds) + 7) & ~7); const int gp8 = Gp >> 3, bx = (int)blockIdx.x; cc = (bx >> 3) < gp8 ? (bx & 7) * gp8 + (bx >> 3) : units; } }
        MoeOrder S{tab + 64, units, 4, Gp, cc, tab, (const int*)(C.ws() + WS_ETOK)};
        EpiY E{(bf16*)(C.ws() + WS_YB), C.in(IBD) + (size_t)l * NE * D};
        PT0(); pg8::gemm_phase<EpiY, MoeOrder>(lds, g, S, E, nullptr, tid); PT1(11);
        CVT_TAIL(2, CVQ7 + CVQ10, CVQ11);
        SEAM();
    }
    if (IN(12)) { PH_BEGIN(); PT0(); ph_combine(C, l, lds, tid, lane, wave, G, nrows); PT1(12); if (!last) SEAM(); }
}
__global__ void __launch_bounds__(NTHR, 2) fwd(Args A) {
    extern __shared__ __attribute__((aligned(16))) unsigned char lds_raw[];
    LAS unsigned char* lds = (LAS unsigned char*)lds_raw;
    const int tid0 = threadIdx.x, G = gridDim.x;
    volatile LAS unsigned* misc = (volatile LAS unsigned*)(lds + MISC_OFF);
    if (tid0 < 64) misc[tid0] = 0u;
    __syncthreads();
    unsigned* ctl = (unsigned*)(A.ws + WS_CTL);
    XcdBarrier bar = xcd_barrier_post(ctl + CW_BAR, misc + 8);
    const bool fused = (A.ph_hi - A.ph_lo) > 1;
    const int vcu = (G % 8 == 0) ? ((int)(blockIdx.x % 8) * (G / 8) + (int)(blockIdx.x / 8)) : (int)blockIdx.x;
    if (A.l_lo <= 0 && 0 < A.l_hi) layer_body<0>(A, lds, tid0, G, vcu, fused, bar);
    if (A.l_lo <= 1 && 1 < A.l_hi) layer_body<1>(A, lds, tid0, G, vcu, fused, bar);
    if (A.l_lo <= 2 && 2 < A.l_hi) layer_body<2>(A, lds, tid0, G, vcu, fused, bar);
    if (A.l_lo <= 3 && 3 < A.l_hi) layer_body<3>(A, lds, tid0, G, vcu, fused, bar);
}
#undef IN
#undef SEAM
#undef PH_BEGIN

extern "C" void kernel_launch(void* const* d_in, const int* in_sizes, int n_in, void* d_out, int out_size, void* d_ws, size_t ws_size, hipStream_t stream) {
    static int grid = 0;
    if (grid == 0) {
        if (n_in != NIN || out_size != NLAT * D || ws_size < WS_END) { fprintf(stderr, "kernel_launch: unexpected problem (n_in %d, out %d, ws %zu)\n", n_in, out_size, ws_size); grid = -1; return; }
        int dev = 0, cus = 0, per_cu = 0;
        if (hipGetDevice(&dev) != hipSuccess || hipDeviceGetAttribute(&cus, hipDeviceAttributeMultiprocessorCount, dev) != hipSuccess) { grid = -1; return; }
        if (hipFuncSetAttribute((const void*)fwd, hipFuncAttributeMaxDynamicSharedMemorySize, LDS_BYTES) != hipSuccess) { fprintf(stderr, "kernel_launch: hipFuncSetAttribute failed\n"); grid = -1; return; }
        if (hipOccupancyMaxActiveBlocksPerMultiprocessor(&per_cu, (const void*)fwd, NTHR, LDS_BYTES) != hipSuccess || per_cu < 1) fprintf(stderr, "kernel_launch: occupancy query says %d\n", per_cu);
        (void)hipGetLastError();
        grid = cus;
    }
    if (grid < 0) return;
    (void)hipMemsetAsync((char*)d_ws + WS_CTL, 0, CTL_BYTES, stream);
    Args a{};
    for (int i = 0; i < NIN; ++i) a.in[i] = (const float*)d_in[i];
    a.out = (float*)d_out; a.ws = (unsigned char*)d_ws;
#if MK_MULTI
    for (int l = 0; l < DEPTH; ++l)
        for (int ph = (l == 0 ? 0 : 2); ph < NPH; ++ph) { a.l_lo = l; a.l_hi = l + 1; a.ph_lo = ph; a.ph_hi = ph + 1;
            hipLaunchKernelGGL(fwd, dim3(grid), dim3(NTHR), LDS_BYTES, stream, a); }
#else
    a.l_lo = 0; a.l_hi = DEPTH; a.ph_lo = 0; a.ph_hi = NPH;
    hipLaunchKernelGGL(fwd, dim3(grid), dim3(NTHR), LDS_BYTES, stream, a);
#endif
}
```
